# Optimizing an MI355X kernel written in HIP

```python
import math
import jax, jax.numpy as jnp
from jax import lax
import numpy as np

D_MODEL = 1024
BATCH = 4
SEQ = 4096
DEPTH = 2

GRID_W = 64
CTX_LEN = 256
HEAD_DIM = 64
D_HYENA = 256
D_FNET = 256
D_NA = 512
N_NA_HEADS = D_NA // HEAD_DIM
FNET_GROUPS = 4
FNET_GROUP_DIM = D_FNET // FNET_GROUPS
HYENA_ORDER = 2
POS_EMB_DIM = 33
POS_BANDS = (POS_EMB_DIM - 1) // 2
FILTER_HIDDEN = 64
HYENA_DECAY_TARGET = 1e-2
HYENA_FAST_PCT = 0.3
HYENA_SLOW_PCT = 1.5
NA_KH = 8
NA_KW = 16
D_FF = -(-8 * D_MODEL // (3 * 256)) * 256
EPS = 1e-6

OFF_HY = 0
OFF_FN = OFF_HY + 3 * D_HYENA
OFF_Q = OFF_FN + D_FNET
OFF_K = OFF_Q + D_NA
OFF_V = OFF_K + D_NA
D_PROJ = OFF_V + D_NA

kernel_name = "hybrid_hyena_fnet_natten_dit"


def rmsnorm(x, g):
    x32 = x.astype(jnp.float32)
    y = x32 * lax.rsqrt(jnp.mean(x32 * x32, axis=-1, keepdims=True) + EPS)
    return (y * g.astype(jnp.float32)).astype(x.dtype)


def modulate(x, g, shift, scale):
    return rmsnorm(x, g) * (1 + scale) + shift


def split_heads(t):
    return t.reshape(t.shape[0], t.shape[1], N_NA_HEADS, HEAD_DIM)


def short_conv(u, w, b):
    L = u.shape[1]
    up = jnp.pad(u, ((0, 0), (1, 1), (0, 0)))
    return up[:, :L] * w[0] + up[:, 1:L + 1] * w[1] + up[:, 2:L + 2] * w[2] + b


def hyena_filters(L, w1, b1, freq, w2, b2, w3):
    f32 = jnp.float32
    t = jnp.linspace(0.0, 1.0, L, dtype=f32)[:, None]
    w = 2.0 * math.pi * jnp.arange(L, dtype=f32)[:, None] / L
    f = jnp.linspace(1e-4, POS_BANDS - 1, POS_BANDS, dtype=f32)[None]
    z = jnp.concatenate([t, jnp.cos(f * w), -jnp.sin(f * w)], axis=-1)
    h = jnp.sin(freq[0].astype(f32) * (z @ w1.astype(f32) + b1.astype(f32)))
    h = jnp.sin(freq[1].astype(f32) * (h @ w2.astype(f32) + b2.astype(f32)))
    k = (h @ w3.astype(f32)).reshape(L, HYENA_ORDER, 2, D_HYENA)
    max_decay = math.log(HYENA_DECAY_TARGET) / HYENA_FAST_PCT
    min_decay = math.log(HYENA_DECAY_TARGET) / HYENA_SLOW_PCT
    deltas = jnp.linspace(min_decay, max_decay, D_HYENA, dtype=f32)
    decay = jnp.exp(-t * jnp.abs(deltas))
    k = k * decay[:, None, None, :]
    k_fwd, k_bwd = k[:, :, 0], k[:, :, 1]
    k_circ = jnp.concatenate([k_fwd, jnp.zeros_like(k_fwd[:1]), k_bwd[:0:-1]], axis=0)
    k_circ = k_circ / jnp.sum(jnp.abs(k_circ), axis=0, keepdims=True)
    return jnp.fft.rfft(k_circ, axis=0)


def long_conv(u, k_f, skip):
    L = u.shape[1]
    u32 = u.astype(jnp.float32)
    y = jnp.fft.irfft(jnp.fft.rfft(u32, n=2 * L, axis=1) * k_f[None], n=2 * L, axis=1)[:, :L]
    return (y + u32 * skip.astype(jnp.float32)).astype(u.dtype)


def hyena_mixer(u, conv_w, conv_b, w1, b1, freq, w2, b2, w3, skip):
    u = short_conv(u, conv_w, conv_b)
    x1, x2, v = jnp.split(u, 3, axis=-1)
    k_f = hyena_filters(u.shape[1], w1, b1, freq, w2, b2, w3)
    z = x1 * long_conv(v, k_f[:, 0], skip[0])
    return x2 * long_conv(z, k_f[:, 1], skip[1])


def fourier_mix(g):
    B, L, _ = g.shape
    g4 = g.astype(jnp.float32).reshape(B, L, FNET_GROUPS, FNET_GROUP_DIM)
    y = jnp.real(jnp.fft.fft2(g4, axes=(1, 3), norm="ortho"))
    return y.reshape(B, L, D_FNET).astype(g.dtype)


def context_attention(q, k, v):
    s = jnp.einsum('bqhd,bkhd->bhqk', q, k).astype(jnp.float32) / math.sqrt(HEAD_DIM)
    p = jax.nn.softmax(s, axis=-1).astype(v.dtype)
    return jnp.einsum('bhqk,bkhd->bqhd', p, v)


def neighbourhood_attention(q, k, v, k_ctx, v_ctx, rpb):
    B, L, H, Dh = q.shape
    rows = L // GRID_W
    kh = min(NA_KH, rows)
    kw = NA_KW
    scale = 1.0 / math.sqrt(Dh)
    qg = q.reshape(B, rows, GRID_W, H, Dh)
    kg = k.reshape(B, rows, GRID_W, H, Dh)
    vg = v.reshape(B, rows, GRID_W, H, Dh)
    col = jnp.arange(GRID_W)
    col_start = jnp.clip(col - kw // 2, 0, GRID_W - kw)
    col_idx = col_start[:, None] + jnp.arange(kw)[None]
    col_bias_idx = (col_idx - col[:, None] + (NA_KW - 1))[:, None, :]

    def row_block(args):
        r, q_r = args
        r_start = jnp.clip(r - kh // 2, 0, rows - kh)
        k_rows = lax.dynamic_slice_in_dim(kg, r_start, kh, axis=1)
        v_rows = lax.dynamic_slice_in_dim(vg, r_start, kh, axis=1)
        k_win = jnp.take(k_rows, col_idx, axis=2)
        v_win = jnp.take(v_rows, col_idx, axis=2)
        row_bias_idx = (r_start + jnp.arange(kh) - r + (NA_KH - 1))[None, :, None]
        bias = rpb[:, row_bias_idx, col_bias_idx].astype(jnp.float32)
        s_loc = jnp.einsum('bqhd,biqjhd->bhqij', q_r, k_win).astype(jnp.float32) * scale + bias[None]
        s_ctx = jnp.einsum('bqhd,bchd->bhqc', q_r, k_ctx).astype(jnp.float32) * scale
        s = jnp.concatenate([s_loc.reshape(B, H, GRID_W, kh * kw), s_ctx], axis=-1)
        p = jax.nn.softmax(s, axis=-1).astype(v.dtype)
        p_loc = p[..., :kh * kw].reshape(B, H, GRID_W, kh, kw)
        p_ctx = p[..., kh * kw:]
        return (jnp.einsum('bhqij,biqjhd->bqhd', p_loc, v_win)
                + jnp.einsum('bhqc,bchd->bqhd', p_ctx, v_ctx))

    out = lax.map(row_block, (jnp.arange(rows), jnp.moveaxis(qg, 1, 0)))
    return jnp.moveaxis(out, 0, 1).reshape(B, L, H, Dh)


def swiglu(h, w_gate, w_up, w_down):
    return (jax.nn.silu(h @ w_gate) * (h @ w_up)) @ w_down


def setup_inputs(seed: int = 0) -> dict:
    key = jax.random.key(seed)
    ks = jax.random.split(key, 32)
    f32 = jnp.float32

    def nrm(k, shape, s):
        return jax.random.normal(k, shape, f32) * s

    L = DEPTH
    return {
        "x": nrm(ks[0], (BATCH, SEQ, D_MODEL), 1.0),
        "c": nrm(ks[1], (BATCH, D_MODEL), 1.0),
        "ctx": nrm(ks[2], (BATCH, CTX_LEN, D_MODEL), 1.0),
        "c_ctx": nrm(ks[3], (D_MODEL,), 1.0),
        "w_mod": nrm(ks[4], (L, D_MODEL, 6 * D_MODEL), D_MODEL ** -0.5),
        "b_mod": nrm(ks[5], (L, 6 * D_MODEL), 0.01),
        "norm1_g": 1.0 + nrm(ks[6], (L, D_MODEL), 0.01),
        "norm2_g": 1.0 + nrm(ks[7], (L, D_MODEL), 0.01),
        "w_in": nrm(ks[8], (L, D_MODEL, D_PROJ), D_MODEL ** -0.5),
        "w_out": nrm(ks[9], (L, D_MODEL, D_MODEL), D_MODEL ** -0.5),
        "hy_conv_w": nrm(ks[10], (L, 3, 3 * D_HYENA), 3 ** -0.5),
        "hy_conv_b": nrm(ks[11], (L, 3 * D_HYENA), 0.01),
        "filt_w1": nrm(ks[12], (L, POS_EMB_DIM, FILTER_HIDDEN), POS_EMB_DIM ** -0.5),
        "filt_b1": nrm(ks[13], (L, FILTER_HIDDEN), 0.01),
        "filt_freq": 1.0 + nrm(ks[14], (L, 2, FILTER_HIDDEN), 0.05),
        "filt_w2": nrm(ks[15], (L, FILTER_HIDDEN, FILTER_HIDDEN), FILTER_HIDDEN ** -0.5),
        "filt_b2": nrm(ks[16], (L, FILTER_HIDDEN), 0.01),
        "filt_w3": nrm(ks[17], (L, FILTER_HIDDEN, HYENA_ORDER * 2 * D_HYENA), FILTER_HIDDEN ** -0.5),
        "hy_skip": nrm(ks[18], (L, HYENA_ORDER, D_HYENA), 1.0),
        "na_rpb": nrm(ks[19], (L, N_NA_HEADS, 2 * NA_KH - 1, 2 * NA_KW - 1), 0.1),
        "w_gate": nrm(ks[20], (L, D_MODEL, D_FF), D_MODEL ** -0.5),
        "w_up": nrm(ks[21], (L, D_MODEL, D_FF), D_MODEL ** -0.5),
        "w_down": nrm(ks[22], (L, D_FF, D_MODEL), D_FF ** -0.5),
        "final_g": 1.0 + nrm(ks[23], (D_MODEL,), 0.01),
    }


def reference(x, c, ctx, c_ctx, w_mod, b_mod, norm1_g, norm2_g, w_in, w_out,
              hy_conv_w, hy_conv_b, filt_w1, filt_b1, filt_freq, filt_w2, filt_b2,
              filt_w3, hy_skip, na_rpb, w_gate, w_up, w_down, final_g):
    silu_c = jax.nn.silu(c)
    silu_cc = jax.nn.silu(c_ctx)
    for l in range(DEPTH):
        last = l == DEPTH - 1
        hy_params = (hy_conv_w[l], hy_conv_b[l], filt_w1[l], filt_b1[l], filt_freq[l],
                     filt_w2[l], filt_b2[l], filt_w3[l], hy_skip[l])
        mod = silu_c @ w_mod[l] + b_mod[l]
        sh1, sc1, g1, sh2, sc2, g2 = [m[:, None] for m in jnp.split(mod, 6, axis=-1)]
        mod_c = silu_cc @ w_mod[l] + b_mod[l]
        csh1, csc1, cg1, csh2, csc2, cg2 = jnp.split(mod_c, 6, axis=-1)

        h = modulate(x, norm1_g[l], sh1, sc1)
        hc = modulate(ctx, norm1_g[l], csh1, csc1)
        proj = h @ w_in[l]
        if last:
            proj_c_kv = hc @ w_in[l][:, OFF_K:]
            k_c = split_heads(proj_c_kv[..., :D_NA])
            v_c = split_heads(proj_c_kv[..., D_NA:])
        else:
            proj_c = hc @ w_in[l]
            k_c = split_heads(proj_c[..., OFF_K:OFF_V])
            v_c = split_heads(proj_c[..., OFF_V:])

        y_hy = hyena_mixer(proj[..., OFF_HY:OFF_FN], *hy_params)
        y_fn = fourier_mix(proj[..., OFF_FN:OFF_Q])
        y_na = neighbourhood_attention(split_heads(proj[..., OFF_Q:OFF_K]),
                                       split_heads(proj[..., OFF_K:OFF_V]),
                                       split_heads(proj[..., OFF_V:]), k_c, v_c, na_rpb[l])
        mix = jnp.concatenate([y_hy, y_fn, y_na.reshape(x.shape[0], x.shape[1], D_NA)], axis=-1) @ w_out[l]
        x = x + g1 * mix

        x = x + g2 * swiglu(modulate(x, norm2_g[l], sh2, sc2), w_gate[l], w_up[l], w_down[l])

        if not last:
            cy_hy = hyena_mixer(proj_c[..., OFF_HY:OFF_FN], *hy_params)
            cy_fn = fourier_mix(proj_c[..., OFF_FN:OFF_Q])
            cy_na = context_attention(split_heads(proj_c[..., OFF_Q:OFF_K]), k_c, v_c)
            mix_c = jnp.concatenate([cy_hy, cy_fn, cy_na.reshape(ctx.shape[0], ctx.shape[1], D_NA)], axis=-1) @ w_out[l]
            ctx = ctx + cg1 * mix_c
            ctx = ctx + cg2 * swiglu(modulate(ctx, norm2_g[l], csh2, csc2), w_gate[l], w_up[l], w_down[l])
    return rmsnorm(x, final_g)
```

```cpp
#include <hip/hip_runtime.h>
#include <hip/hip_cooperative_groups.h>
#include <cstdio>
namespace cg = cooperative_groups;
namespace pg8 {
#define PG8_LAS __attribute__((address_space(3)))
typedef unsigned short bf16_t;
typedef short bf16x8 __attribute__((ext_vector_type(8)));
typedef float f32x4 __attribute__((ext_vector_type(4)));
typedef unsigned u32x4 __attribute__((ext_vector_type(4)));
constexpr int BM = 256, BK = 64, HALF = 128, HTB = HALF * BK * 2  , STAGE_BYTES = 8 * HTB, NXCD = 8, WGM = 8;

__host__ __device__ __forceinline__ int lds_byte(int r, int c) { const int st = (r >> 4) * 2 + (c >> 5), rr = r & 15, cc = c & 31, ob = rr * 64 + cc * 2; return st * 1024 + (ob ^ (((ob >> 9) & 1) << 5)); }
__host__ __device__ __forceinline__ void stage_rc(int b, int& R, int& C) { const int st = b / 1024, sb = b % 1024, swz = sb ^ (((sb >> 9) & 1) << 5); R = (st >> 1) * 16 + swz / 64; C = (st & 1) * 32 + (swz % 64) / 2; }
__host__ __device__ __forceinline__ int perm32(int rho) { const int n = rho >> 4, i = rho & 15; return 8 * (i >> 2) + 4 * n + (i & 3); }

struct Unit { int pm, pn; };
struct Gemm { const bf16_t* A; const bf16_t* Bt; int M, N, K; };

struct StaticOrder {
    int nM, nN, nwg, G, c;
    __host__ __device__ void init(int M, int N, int G_, int c_) { nM = M / BM; nN = N / BM; nwg = nM * nN; G = G_; c = c_; }
    __host__ __device__ bool next(int i, Unit& u) const {
        const long L = (long)i * G + c; if (L >= nwg) return false;
        int wgid = (int)L; { const int q = nwg / NXCD, r = nwg % NXCD, xcd = wgid % NXCD, off = wgid / NXCD; wgid = (xcd < r ? xcd * (q + 1) : r * (q + 1) + (xcd - r) * q) + off; }
        const int nig = WGM * nN, gid = wgid / nig, fm = gid * WGM, gsz = (nM - fm) < WGM ? (nM - fm) : WGM;
        u.pm = fm + ((wgid % nig) % gsz); u.pn = (wgid % nig) / gsz; return true;
    }
    __device__ __forceinline__ void a_ready(const Unit&) const {}
    __device__ __forceinline__ void done(const Unit&) const {}
};
__device__ __forceinline__ unsigned cvt_pk_bf16(float lo, float hi) { unsigned r; asm volatile("v_cvt_pk_bf16_f32 %0, %1, %2" : "=v"(r) : "v"(lo), "v"(hi)); return r; }
typedef float f32x2 __attribute__((ext_vector_type(2)));
template <class Epi, class Sched, bool STAMP = false>
__device__ __forceinline__ void gemm_phase(PG8_LAS unsigned char* lds, const Gemm g, const Sched& S, const Epi& E, unsigned long long* stamps) {
    int tid_ = threadIdx.x; asm volatile("" : "+v"(tid_)); const int tid = tid_, wid = __builtin_amdgcn_readfirstlane(tid >> 6), lane = tid & 63, wr = wid >> 2, wc = wid & 3, fr = lane & 15, fq = lane >> 4;
    int K_ = g.K; asm volatile("" : "+s"(K_)); const int K = K_, nt = K / BK;
    int ts_lo = 0, ts_hi = 0, nts = 0; const unsigned long long rt_entry = STAMP ? (unsigned long long)wall_clock64() : 0ull;
#define PG8_STAMP() do { if (STAMP && wid == 0 && nts < 64) { const unsigned long long _c = (unsigned long long)clock64(); \
        ts_lo = (lane == nts) ? (int)(unsigned)_c : ts_lo; ts_hi = (lane == nts) ? (int)(unsigned)(_c >> 32) : ts_hi; ++nts; } } while (0)
    PG8_STAMP();
    unsigned voffA[2], voffB[2];
#pragma unroll
    for (int i = 0; i < 2; ++i) { int R, C; stage_rc(tid * 16 + i * 8192, R, C); const int Rb = Epi::PERM ? ((R & ~31) + perm32(R & 31)) : R;
        voffA[i] = (unsigned)(R * K + C) * 2u; voffB[i] = (unsigned)(Rb * K + C) * 2u; }
    const size_t kstep = (size_t)(BK * 2);
    const size_t hstep = (size_t)HALF * K * 2;
    const size_t tstep = 2 * hstep;
    const unsigned ldsw = (unsigned)wid * 1024u;
    const int aoff = lds_byte(wr * 64 + fr, fq * 8), boff = lds_byte(wc * 32 + fr, fq * 8);
#define PG8_SA(b, h) (((b) * 2 + (h)) * HTB)
#define PG8_SB(b, h) ((4 + (b) * 2 + (h)) * HTB)
#define PG8_STAGE(bufoff, gbase, voff) do { _Pragma("unroll") for (int _i = 0; _i < 2; ++_i) \
        __builtin_amdgcn_global_load_lds((const unsigned*)((const char*)(gbase) + (voff)[_i]), (PG8_LAS unsigned*)(lds + (bufoff) + ldsw + _i * 8192), 16, 0, 0); } while (0)
#define PG8_LDA(dst, b, h) do { _Pragma("unroll") for (int m = 0; m < 4; ++m) _Pragma("unroll") for (int k = 0; k < 2; ++k) dst[m][k] = *(const PG8_LAS bf16x8*)(lds + PG8_SA(b, h) + aoff + m * 2048 + k * 1024); } while (0)
#define PG8_LDB(dst, b, h) do { _Pragma("unroll") for (int n = 0; n < 2; ++n) _Pragma("unroll") for (int k = 0; k < 2; ++k) dst[n][k] = *(const PG8_LAS bf16x8*)(lds + PG8_SB(b, h) + boff + n * 2048 + k * 1024); } while (0)
#define PG8_MMA(ai, bj, At, Bt) do { __builtin_amdgcn_s_setprio(1); _Pragma("unroll") for (int m = 0; m < 4; ++m) _Pragma("unroll") for (int n = 0; n < 2; ++n) _Pragma("unroll") for (int k = 0; k < 2; ++k) \
        acc[ai][bj][m][n] = __builtin_amdgcn_mfma_f32_16x16x32_bf16(Bt[n][k], At[m][k], acc[ai][bj][m][n], 0, 0, 0); __builtin_amdgcn_s_setprio(0); } while (0)
#define PG8_WAIT_V(n) asm volatile("s_waitcnt vmcnt(" #n ")" ::: "memory")
#define PG8_WAIT_L(n) asm volatile("s_waitcnt lgkmcnt(" #n ")" ::: "memory")
#define PG8_BAR __builtin_amdgcn_s_barrier()
#define PG8_SCHED __builtin_amdgcn_sched_barrier(0)
    Unit cur, nxt; int ui = 0;
    if (!S.next(0, cur)) return;
    f32x4 acc[2][2][4][2];
#pragma unroll
    for (int a = 0; a < 2; ++a)
#pragma unroll
        for (int b = 0; b < 2; ++b)
#pragma unroll
            for (int m = 0; m < 4; ++m)
#pragma unroll
                for (int n = 0; n < 2; ++n) acc[a][b][m][n] = (f32x4){0.f, 0.f, 0.f, 0.f};
    bf16x8 At[4][2], B0[2][2], B1[2][2];
    const char* cA = (const char*)g.A + (size_t)cur.pm * tstep; const char* cB = (const char*)g.Bt + (size_t)cur.pn * tstep;
    S.a_ready(cur);
    PG8_STAGE(PG8_SB(0, 0), cB, voffB); PG8_STAGE(PG8_SA(0, 0), cA, voffA); PG8_STAGE(PG8_SB(0, 1), cB + hstep, voffB); PG8_STAGE(PG8_SA(0, 1), cA + hstep, voffA);
    if (wr == 1) PG8_BAR;
    PG8_WAIT_V(4); PG8_BAR;
    PG8_STAGE(PG8_SB(1, 0), cB + kstep, voffB); PG8_STAGE(PG8_SA(1, 0), cA + kstep, voffA); PG8_STAGE(PG8_SB(1, 1), cB + hstep + kstep, voffB);
    PG8_WAIT_V(6); PG8_BAR;
    PG8_STAMP();
    for (;;) {
        const bool has_next = S.next(ui + 1, nxt);
        const char* nA = has_next ? (const char*)g.A + (size_t)nxt.pm * tstep : cA; const char* nB = has_next ? (const char*)g.Bt + (size_t)nxt.pn * tstep : cB;
        for (int t = 0; t < nt; t += 2) {
            const bool last = (t == nt - 2);
            const char* a1 = cA + (size_t)(t + 1) * kstep;
            const char* a2 = last ? nA : cA + (size_t)(t + 2) * kstep; const char* b2 = last ? nB : cB + (size_t)(t + 2) * kstep;
            const char* a3 = a2 + kstep; const char* b3 = b2 + kstep;
            if (last && has_next) S.a_ready(nxt);
            PG8_LDB(B0, 0, 0); PG8_SCHED; PG8_LDA(At, 0, 0); PG8_STAGE(PG8_SA(1, 1), a1 + hstep, voffA);
            PG8_WAIT_L(8); PG8_BAR; PG8_WAIT_L(0); PG8_MMA(0, 0, At, B0); PG8_BAR; PG8_SCHED;
            PG8_LDB(B1, 0, 1); PG8_STAGE(PG8_SB(0, 0), b2, voffB);
            PG8_BAR; PG8_WAIT_L(0); PG8_MMA(0, 1, At, B1); PG8_BAR;
            PG8_LDA(At, 0, 1); PG8_STAGE(PG8_SA(0, 0), a2, voffA);
            PG8_BAR; PG8_WAIT_L(0); PG8_MMA(1, 0, At, B0); PG8_BAR; PG8_SCHED;
            PG8_STAGE(PG8_SB(0, 1), b2 + hstep, voffB);
            PG8_WAIT_V(6); PG8_BAR; PG8_MMA(1, 1, At, B1); PG8_BAR;
            PG8_LDB(B0, 1, 0); PG8_SCHED; PG8_LDA(At, 1, 0); PG8_STAGE(PG8_SA(0, 1), a2 + hstep, voffA);
            PG8_WAIT_L(8); PG8_BAR; PG8_WAIT_L(0); PG8_MMA(0, 0, At, B0); PG8_BAR; PG8_SCHED;
            PG8_LDB(B1, 1, 1); PG8_STAGE(PG8_SB(1, 0), b3, voffB);
            PG8_BAR; PG8_WAIT_L(0); PG8_MMA(0, 1, At, B1); PG8_BAR;
            PG8_LDA(At, 1, 1); PG8_STAGE(PG8_SA(1, 0), a3, voffA);
            PG8_BAR; PG8_WAIT_L(0); PG8_MMA(1, 0, At, B0); PG8_BAR; PG8_SCHED;
            PG8_STAGE(PG8_SB(1, 1), b3 + hstep, voffB);
            PG8_WAIT_V(6); PG8_BAR; PG8_MMA(1, 1, At, B1); PG8_BAR;
        }
        PG8_STAMP();
        if constexpr (!Epi::AFTER_DRAIN) { E(acc, cur, wr, wc, fr, fq); S.done(cur); }
        PG8_STAMP();
        if (!has_next) break;
#pragma unroll
        for (int a = 0; a < 2; ++a)
#pragma unroll
            for (int b = 0; b < 2; ++b)
#pragma unroll
                for (int m = 0; m < 4; ++m)
#pragma unroll
                    for (int n = 0; n < 2; ++n) acc[a][b][m][n] = (f32x4){0.f, 0.f, 0.f, 0.f};
        cur = nxt; cA = nA; cB = nB; ++ui;
    }
    PG8_WAIT_V(0);
    if (wr == 0) PG8_BAR;
    PG8_BAR;
    if constexpr (Epi::AFTER_DRAIN) { E.fused(acc, cur, wr, wc, fr, fq, lds, wid, lane); S.done(cur); }
    PG8_STAMP();
    if (STAMP && wid == 0) { stamps[lane] = lane < nts ? (((unsigned long long)(unsigned)ts_hi << 32) | (unsigned)ts_lo) : 0ull;
        if (lane == 62) stamps[62] = rt_entry; if (lane == 63) stamps[63] = (unsigned long long)wall_clock64(); }
#undef PG8_STAMP
#undef PG8_SA
#undef PG8_SB
#undef PG8_STAGE
#undef PG8_LDA
#undef PG8_LDB
#undef PG8_MMA
#undef PG8_WAIT_V
#undef PG8_WAIT_L
#undef PG8_BAR
#undef PG8_SCHED
}
}

using pg8::bf16_t; using pg8::bf16x8; using pg8::f32x4; using pg8::u32x4; using pg8::Unit; using pg8::cvt_pk_bf16;
typedef unsigned u32x2 __attribute__((ext_vector_type(2)));
#define LAS3 __attribute__((address_space(3)))

constexpr int DM = 1024, SEQL = 4096, NB = 4, CTXL = 256, DFF = 2816, NPROJ = 2816  ;
constexpr int MMAIN = NB * SEQL  , MCTX = NB * CTXL  , MALL = MMAIN + MCTX  ;
constexpr int LDS_BYTES = 131072;

struct Params {
    const float *x, *c, *ctx, *c_ctx, *w_mod, *b_mod, *norm1_g, *norm2_g, *w_in, *w_out, *hy_conv_w, *hy_conv_b, *filt_w1, *filt_b1, *filt_freq, *filt_w2, *filt_b2, *filt_w3,
        *hy_skip, *na_rpb, *w_gate, *w_up, *w_down, *final_g;
    float* out;
    bf16_t *WIN, *WOUT, *WGU, *WDN;
    bf16_t *DFT, *DFTC;
    float *MOD, *H2F, *H2C, *XRC;
    bf16_t *HB;
    bf16_t *HYU, *HYUC, *FNB, *FNBC, *QK, *VT, *VTC, *ACT;
};

__device__ __forceinline__ float silu_f(float x) { return x / (1.0f + __expf(-x)); }
__device__ __forceinline__ bf16_t f2bf(float f) { unsigned u = __float_as_uint(f); u += 0x7FFFu + ((u >> 16) & 1u); return (bf16_t)(u >> 16); }
__device__ __forceinline__ float bf2f(bf16_t b) { return __uint_as_float(((unsigned)b) << 16); }

struct EpiIn {
    static constexpr bool PERM = false, AFTER_DRAIN = false;
    bf16_t *hyu, *hyuc, *fnb, *fnbc, *qk, *vt, *vtc;
    __device__ __forceinline__ void operator()(const f32x4 (&acc)[2][2][4][2], const Unit& u, int wr, int wc, int fr, int fq) const {
        const bool isctx = u.pm >= 64; const int L = isctx ? CTXL : SEQL;
        const int b = isctx ? (u.pm - 64) : (u.pm >> 4), posbase = isctx ? 0 : (u.pm & 15) * 256;
        const int pn = u.pn;
        if (pn >= 5 && pn < 9) {
            const int row0 = u.pm * 256 + wr * 64 + fr, col0 = (pn - 5) * 256 + wc * 32 + 4 * fq;
#pragma unroll
            for (int ai = 0; ai < 2; ++ai)
#pragma unroll
                for (int m = 0; m < 4; ++m) { bf16_t* rowp = qk + (size_t)(row0 + ai * 128 + m * 16) * 1024 + col0;
#pragma unroll
                    for (int bj = 0; bj < 2; ++bj)
#pragma unroll
                        for (int n = 0; n < 2; ++n) { const f32x4 v = acc[ai][bj][m][n]; u32x2 w; w.x = cvt_pk_bf16(v[0], v[1]); w.y = cvt_pk_bf16(v[2], v[3]); *(u32x2*)(rowp + bj * 128 + n * 16) = w; } }
        } else {
            unsigned stride; int chan0, off;
            unsigned long long bh = (unsigned long long)(isctx ? hyuc : hyu), bf = (unsigned long long)(isctx ? fnbc : fnb), bv = (unsigned long long)(isctx ? vtc : vt);
            asm volatile("" : "+s"(bh), "+s"(bf), "+s"(bv));
            unsigned long long bsel = bv;
            if (pn < 3) { bsel = bh; chan0 = b * 768 + pn * 256; stride = (unsigned)L; off = 0; }
            else if (pn < 5) { bsel = bf; chan0 = b * 256; stride = (unsigned)(2 * L); off = (pn - 3) * L; }
            else { chan0 = b * 512 + (pn - 9) * 256; stride = (unsigned)L; off = 0; }
            asm volatile("" : "+s"(bsel));
            bf16_t* base = (bf16_t*)bsel;
            const unsigned eoff = (unsigned)(chan0 + wc * 32 + 4 * fq) * stride + (unsigned)(posbase + wr * 64 + fr + off);
#pragma unroll
            for (int bj = 0; bj < 2; ++bj)
#pragma unroll
                for (int n = 0; n < 2; ++n)
#pragma unroll
                    for (int e = 0; e < 4; ++e) { unsigned eo = eoff + (unsigned)(bj * 128 + n * 16 + e) * stride; asm volatile("" : "+v"(eo)); bf16_t* cp = base + eo;
#pragma unroll
                        for (int ai = 0; ai < 2; ++ai)
#pragma unroll
                            for (int m = 0; m < 4; ++m) cp[ai * 128 + m * 16] = f2bf(acc[ai][bj][m][n][e]); }
        }
    }
};
struct EpiRes {
    static constexpr bool PERM = false, AFTER_DRAIN = false;
    const float *res_main, *res_ctx; float *dst_main, *dst_ctx; const float* gate;
    __device__ __forceinline__ void operator()(const f32x4 (&acc)[2][2][4][2], const Unit& u, int wr, int wc, int fr, int fq) const {
        const bool isctx = u.pm >= 64; const int bi = isctx ? 4 : (u.pm >> 4);
        const float* res = isctx ? res_ctx + (size_t)(u.pm - 64) * 256 * 1024 : res_main + (size_t)u.pm * 256 * 1024;
        float* dst = isctx ? dst_ctx + (size_t)(u.pm - 64) * 256 * 1024 : dst_main + (size_t)u.pm * 256 * 1024;
        const int col0 = u.pn * 256 + wc * 32 + 4 * fq; const float* gp = gate + bi * 6144 + col0;
        f32x4 gv[2][2];
#pragma unroll
        for (int bj = 0; bj < 2; ++bj)
#pragma unroll
            for (int n = 0; n < 2; ++n) gv[bj][n] = *(const f32x4*)(gp + bj * 128 + n * 16);
#pragma unroll
        for (int ai = 0; ai < 2; ++ai)
#pragma unroll
            for (int m = 0; m < 4; ++m) { const size_t ro = (size_t)(ai * 128 + wr * 64 + m * 16 + fr) * 1024 + col0;
#pragma unroll
                for (int bj = 0; bj < 2; ++bj)
#pragma unroll
                    for (int n = 0; n < 2; ++n) { const f32x4 r = *(const f32x4*)(res + ro + bj * 128 + n * 16); *(f32x4*)(dst + ro + bj * 128 + n * 16) = r + gv[bj][n] * acc[ai][bj][m][n]; } }
    }
};
struct EpiGU {
    static constexpr bool PERM = false, AFTER_DRAIN = false;
    bf16_t* act;
    __device__ __forceinline__ void operator()(const f32x4 (&acc)[2][2][4][2], const Unit& u, int wr, int wc, int fr, int fq) const {
        const int row0 = u.pm * 256 + wr * 64 + fr, col0 = u.pn * 128 + wc * 32 + 8 * fq;
#pragma unroll
        for (int ai = 0; ai < 2; ++ai)
#pragma unroll
            for (int m = 0; m < 4; ++m) { bf16_t* rowp = act + (size_t)(row0 + ai * 128 + m * 16) * DFF + col0;
                float v[8];
#pragma unroll
                for (int n = 0; n < 2; ++n)
#pragma unroll
                    for (int e = 0; e < 4; ++e) v[n * 4 + e] = silu_f(acc[ai][0][m][n][e]) * acc[ai][1][m][n][e];
                u32x4 w; w.x = cvt_pk_bf16(v[0], v[1]); w.y = cvt_pk_bf16(v[2], v[3]); w.z = cvt_pk_bf16(v[4], v[5]); w.w = cvt_pk_bf16(v[6], v[7]);
                *(u32x4*)rowp = w; }
    }
};
struct EpiFn {
    static constexpr bool PERM = false, AFTER_DRAIN = false;
    bf16_t* mix; int rowbase, Lr;
    __device__ __forceinline__ void operator()(const f32x4 (&acc)[2][2][4][2], const Unit& u, int wr, int wc, int fr, int fq) const {
        const int row0 = rowbase + u.pn * Lr + u.pm * 256 + wr * 64 + fr, col0 = 256 + wc * 32 + 4 * fq;
#pragma unroll
        for (int ai = 0; ai < 2; ++ai)
#pragma unroll
            for (int m = 0; m < 4; ++m) { bf16_t* rowp = mix + (size_t)(row0 + ai * 128 + m * 16) * 1024 + col0;
#pragma unroll
                for (int bj = 0; bj < 2; ++bj)
#pragma unroll
                    for (int n = 0; n < 2; ++n) { const f32x4 v = acc[ai][bj][m][n]; u32x2 w; w.x = cvt_pk_bf16(v[0], v[1]); w.y = cvt_pk_bf16(v[2], v[3]); *(u32x2*)(rowp + bj * 128 + n * 16) = w; } }
    }
};

template <class Epi> __device__ __forceinline__ void run_gemm(unsigned char* smem, const bf16_t* A, const bf16_t* Bt, int M, int N, int K, const Epi& E) {
    pg8::Gemm g; g.A = A; g.Bt = Bt; g.M = M; g.N = N; g.K = K;
    pg8::StaticOrder S; S.init(M, N, (int)gridDim.x, (int)blockIdx.x);
    pg8::gemm_phase<Epi, pg8::StaticOrder, false>((PG8_LAS unsigned char*)smem, g, S, E, nullptr);
}

__device__ void prep_phase(const Params& p, unsigned char* smem) {
    int tid_ = threadIdx.x; asm volatile("" : "+v"(tid_)); const int tid = tid_, lane = tid & 63, w = tid >> 6;
    float* tab = (float*)smem;
    float* tab64 = (float*)(smem + 16384);
    float* sv = (float*)(smem + 20480);
    float* red = (float*)(smem + 40960);
    for (int i = tid; i < 4096; i += 512) tab[i] = cospif((float)i * (1.0f / 2048.0f));
    if (tid < 64) tab64[tid] = cospif((float)tid * (1.0f / 32.0f));
    for (int i = tid; i < 5120; i += 512) { const int v = i >> 10, k = i & 1023; const float xv = v < 4 ? p.c[v * 1024 + k] : p.c_ctx[k]; sv[i] = xv / (1.0f + expf(-xv)); }
    __syncthreads();
    {
        const int nl = lane, kg = w;
        for (int t = blockIdx.x; t < 6144; t += gridDim.x) {
            const int l = t / 3072, r = t % 3072;
            float v[8]; bf16_t* dst;
            if (r < 704) {
                const int nt = r >> 4, kt = r & 15, n = nt * 64 + nl, k0 = kt * 64 + kg * 8; const float* W = p.w_in + (size_t)l * 1024 * 2560;
                if (n < 768 || n >= 1280) { const int src = n < 768 ? n : n - 256;
#pragma unroll
                    for (int e = 0; e < 8; ++e) v[e] = W[(size_t)(k0 + e) * 2560 + src];
                } else { int cp = n - 768; const bool isq = cp >= 256; cp &= 255; const int g = cp >> 6, j = cp & 63;
#pragma unroll
                    for (int e = 0; e < 8; ++e) v[e] = 0.f;
                    for (int m = 0; m < 64; ++m) { int idx = (j * m) & 63; if (isq) idx = (idx - 16) & 63; const float tv = tab64[idx];
#pragma unroll
                        for (int e = 0; e < 8; ++e) v[e] += W[(size_t)(k0 + e) * 2560 + 768 + g * 64 + m] * tv; }
                }
                dst = p.WIN + (size_t)l * NPROJ * 1024 + (size_t)n * 1024 + k0;
            } else if (r < 960) {
                const int rr = r - 704, nt = rr >> 4, kt = rr & 15, n = nt * 64 + nl, k0 = kt * 64 + kg * 8; const float* W = p.w_out + (size_t)l * 1024 * 1024;
#pragma unroll
                for (int e = 0; e < 8; ++e) v[e] = W[(size_t)(k0 + e) * 1024 + n];
                dst = p.WOUT + (size_t)l * 1024 * 1024 + (size_t)n * 1024 + k0;
            } else if (r < 2368) {
                const int rr = r - 960, nt = rr >> 4, kt = rr & 15, n = nt * 64 + nl, k0 = kt * 64 + kg * 8;
                const int pn = n >> 8, lc = n & 255, bj = lc >> 7, wc = (lc >> 5) & 3, nn = (lc >> 4) & 1, fq = (lc >> 2) & 3, e4 = lc & 3;
                const int j = 128 * pn + 32 * wc + 8 * fq + 4 * nn + e4;
                const float* W = (bj ? p.w_up : p.w_gate) + (size_t)l * 1024 * DFF;
#pragma unroll
                for (int e = 0; e < 8; ++e) v[e] = W[(size_t)(k0 + e) * DFF + j];
                dst = p.WGU + (size_t)l * 5632 * 1024 + (size_t)n * 1024 + k0;
            } else {
                const int rr = r - 2368, nt = rr / 44, kt = rr % 44, n = nt * 64 + nl, k0 = kt * 64 + kg * 8; const float* W = p.w_down + (size_t)l * DFF * 1024;
#pragma unroll
                for (int e = 0; e < 8; ++e) v[e] = W[(size_t)(k0 + e) * 1024 + n];
                dst = p.WDN + (size_t)l * 1024 * DFF + (size_t)n * DFF + k0;
            }
            u32x4 o; o.x = cvt_pk_bf16(v[0], v[1]); o.y = cvt_pk_bf16(v[2], v[3]); o.z = cvt_pk_bf16(v[4], v[5]); o.w = cvt_pk_bf16(v[6], v[7]);
            *(u32x4*)dst = o;
        }
    }
    for (int task = blockIdx.x; task < 192; task += gridDim.x) {
        const int l = task / 96, n = (task % 96) * 64 + lane;
        float a0 = 0.f, a1 = 0.f, a2 = 0.f, a3 = 0.f, a4 = 0.f;
        const float* W = p.w_mod + (size_t)l * 1024 * 6144 + n;
        for (int kk = 0; kk < 128; ++kk) { const int k = w * 128 + kk; const float wv = W[(size_t)k * 6144];
            a0 += sv[k] * wv; a1 += sv[1024 + k] * wv; a2 += sv[2048 + k] * wv; a3 += sv[3072 + k] * wv; a4 += sv[4096 + k] * wv; }
        red[(w * 5 + 0) * 64 + lane] = a0; red[(w * 5 + 1) * 64 + lane] = a1; red[(w * 5 + 2) * 64 + lane] = a2; red[(w * 5 + 3) * 64 + lane] = a3; red[(w * 5 + 4) * 64 + lane] = a4;
        __syncthreads();
        if (w < 5) { float s = p.b_mod[l * 6144 + n]; for (int ww = 0; ww < 8; ++ww) s += red[(ww * 5 + w) * 64 + lane]; p.MOD[(size_t)(l * 5 + w) * 6144 + n] = s; }
        __syncthreads();
    }
    {
        const int gw = blockIdx.x * 8 + w, nw = gridDim.x * 8;
        for (int pid = gw; pid < 8448; pid += nw) {
            int l, t, L; float* outp;
            if (pid < 8192) { l = pid >> 12; t = pid & 4095; L = 4096; outp = p.H2F + (size_t)pid * 64; } else { l = 0; t = pid - 8192; L = 256; outp = p.H2C + (size_t)t * 64; }
            const float tt = (float)t / (float)(L - 1), wa = 6.283185307179586f * (float)t / (float)L;
            const float* w1 = p.filt_w1 + l * 33 * 64; const float* w2 = p.filt_w2 + l * 64 * 64;
            float a = p.filt_b1[l * 64 + lane] + tt * w1[lane];
            for (int bnd = 0; bnd < 16; ++bnd) { const float f = 1e-4f + (float)bnd * ((15.0f - 1e-4f) / 15.0f); const float ang = f * wa;
                a += cosf(ang) * w1[(1 + bnd) * 64 + lane] - sinf(ang) * w1[(17 + bnd) * 64 + lane]; }
            const float h1 = sinf(p.filt_freq[l * 128 + lane] * a);
            float a2 = p.filt_b2[l * 64 + lane];
            for (int i = 0; i < 64; ++i) a2 += __shfl(h1, i) * w2[i * 64 + lane];
            outp[lane] = sinf(p.filt_freq[l * 128 + 64 + lane] * a2);
        }
    }
    {
        const size_t gt = (size_t)blockIdx.x * 512 + tid, gs = (size_t)gridDim.x * 512;
        for (size_t idx = gt; idx < (size_t)4096 * 1024; idx += gs) {
            const int k = (int)(idx >> 10), kk0 = (int)(idx & 1023) * 8; float v[8];
#pragma unroll
            for (int e = 0; e < 8; ++e) { const int kk = kk0 + e, n = kk & 4095, ii = (k * n) & 4095; v[e] = (kk < 4096 ? tab[ii] : -tab[(ii - 1024) & 4095]) * (1.0f / 512.0f); }
            u32x4 o; o.x = cvt_pk_bf16(v[0], v[1]); o.y = cvt_pk_bf16(v[2], v[3]); o.z = cvt_pk_bf16(v[4], v[5]); o.w = cvt_pk_bf16(v[6], v[7]);
            *(u32x4*)(p.DFT + idx * 8) = o;
        }
        for (size_t idx = gt; idx < (size_t)256 * 64; idx += gs) {
            const int k = (int)(idx >> 6), kk0 = (int)(idx & 63) * 8; float v[8];
#pragma unroll
            for (int e = 0; e < 8; ++e) { const int kk = kk0 + e, n = kk & 255, ii = ((k * n) & 255) * 16; v[e] = (kk < 256 ? tab[ii] : -tab[(ii - 1024) & 4095]) * (1.0f / 128.0f); }
            u32x4 o; o.x = cvt_pk_bf16(v[0], v[1]); o.y = cvt_pk_bf16(v[2], v[3]); o.z = cvt_pk_bf16(v[4], v[5]); o.w = cvt_pk_bf16(v[6], v[7]);
            *(u32x4*)(p.DFTC + idx * 8) = o;
        }
    }
}

__device__ void norm_phase(const Params& p, int l, int which, int Mrows, bool from_input) {
    int tid_ = threadIdx.x; asm volatile("" : "+v"(tid_)); const int tid = tid_, lane = tid & 63, w = tid >> 6;
    const float* gam = (which ? p.norm2_g : p.norm1_g) + l * 1024;
    const int moff = which ? 3072 : 0;
    for (int row = blockIdx.x * 8 + w; row < Mrows; row += gridDim.x * 8) {
        const bool isctx = row >= MMAIN; const int bi = isctx ? 4 : (row >> 12);
        const float* src = from_input ? (isctx ? p.ctx + (size_t)(row - MMAIN) * 1024 : p.x + (size_t)row * 1024) : (isctx ? p.XRC + (size_t)(row - MMAIN) * 1024 : p.out + (size_t)row * 1024);
        f32x4 v[4]; float ss = 0.f;
#pragma unroll
        for (int i = 0; i < 4; ++i) { v[i] = *(const f32x4*)(src + i * 256 + lane * 4); ss += v[i][0] * v[i][0] + v[i][1] * v[i][1] + v[i][2] * v[i][2] + v[i][3] * v[i][3]; }
#pragma unroll
        for (int o = 32; o >= 1; o >>= 1) ss += __shfl_xor(ss, o);
        const float rstd = rsqrtf(ss * (1.0f / 1024.0f) + 1e-6f);
        const float* mod = p.MOD + (size_t)(l * 5 + bi) * 6144 + moff;
#pragma unroll
        for (int i = 0; i < 4; ++i) { const int col = i * 256 + lane * 4;
            const f32x4 g = *(const f32x4*)(gam + col), sh = *(const f32x4*)(mod + col), sc = *(const f32x4*)(mod + 1024 + col);
            f32x4 y = v[i] * rstd * g * (sc + 1.0f) + sh;
            u32x2 o; o.x = cvt_pk_bf16(y[0], y[1]); o.y = cvt_pk_bf16(y[2], y[3]);
            *(u32x2*)(p.HB + (size_t)row * 1024 + col) = o; }
    }
}
__device__ void final_norm(const Params& p) {
    int tid_ = threadIdx.x; asm volatile("" : "+v"(tid_)); const int tid = tid_, lane = tid & 63, w = tid >> 6;
    for (int row = blockIdx.x * 8 + w; row < MMAIN; row += gridDim.x * 8) {
        float* src = p.out + (size_t)row * 1024;
        f32x4 v[4]; float ss = 0.f;
#pragma unroll
        for (int i = 0; i < 4; ++i) { v[i] = *(const f32x4*)(src + i * 256 + lane * 4); ss += v[i][0] * v[i][0] + v[i][1] * v[i][1] + v[i][2] * v[i][2] + v[i][3] * v[i][3]; }
#pragma unroll
        for (int o = 32; o >= 1; o >>= 1) ss += __shfl_xor(ss, o);
        const float rstd = rsqrtf(ss * (1.0f / 1024.0f) + 1e-6f);
#pragma unroll
        for (int i = 0; i < 4; ++i) { const int col = i * 256 + lane * 4; const f32x4 g = *(const f32x4*)(p.final_g + col); *(f32x4*)(src + col) = v[i] * rstd * g; }
    }
}

__device__ __forceinline__ float short_conv_at(const bf16_t* base, int t, int L, float w0, float w1, float w2, float bb) {
    const float um = t > 0 ? bf2f(base[t - 1]) : 0.f, u0 = bf2f(base[t]), up = t < L - 1 ? bf2f(base[t + 1]) : 0.f;
    return um * w0 + u0 * w1 + up * w2 + bb;
}
template <int L> __device__ void hyena_naive(const Params& p, int l, int c, unsigned char* smem) {
    constexpr bool ISCTX = (L == CTXL); constexpr int NI = (L + 511) / 512;
    int tid_ = threadIdx.x; asm volatile("" : "+v"(tid_)); const int tid = tid_, lane = tid & 63, w = tid >> 6;
    float* Kf = (float*)smem;
    float* Uf = (float*)(smem + 32768);
    float* red = (float*)(smem + 32768 + 65536);
    const bf16_t* hy = ISCTX ? p.HYUC : p.HYU;
    const float* H2 = ISCTX ? p.H2C : p.H2F + (size_t)l * 4096 * 64;
    const float* cw = p.hy_conv_w + l * 3 * 768; const float* cb = p.hy_conv_b + l * 768;
    const float min_decay = -4.605170185988091f / 1.5f, max_decay = -4.605170185988091f / 0.3f;
    const float delta = fabsf(min_decay + (float)c * ((max_decay - min_decay) / 255.0f));
    const int rowbase = ISCTX ? MMAIN : 0;
    for (int o = 0; o < 2; ++o) {
        float part = 0.f;
        const float* w3 = p.filt_w3 + (size_t)l * 64 * 1024 + o * 512 + c;
        for (int t = tid; t < L; t += 512) {
            const float* hr = H2 + (size_t)t * 64; float kf = 0.f, kb = 0.f;
            for (int j = 0; j < 64; ++j) { const float hv = hr[j]; kf += hv * w3[j * 1024]; kb += hv * w3[j * 1024 + 256]; }
            const float dec = expf(-((float)t / (float)(L - 1)) * delta); kf *= dec; kb *= dec;
            Kf[L + t] = kf; part += fabsf(kf);
            if (t >= 1) { Kf[L - t] = kb; part += fabsf(kb); } else Kf[0] = 0.f;
        }
#pragma unroll
        for (int s = 32; s >= 1; s >>= 1) part += __shfl_xor(part, s);
        if (lane == 0) red[w] = part;
        if (o == 0) {
            const int ch = 512 + c; const float w0 = cw[ch], w1 = cw[768 + ch], w2 = cw[1536 + ch], bb = cb[ch];
            for (int idx = tid; idx < 4 * L; idx += 512) { const int b = idx / L, s = idx % L; Uf[s * 4 + b] = short_conv_at(hy + (size_t)(b * 768 + ch) * L, s, L, w0, w1, w2, bb); }
        }
        __syncthreads();
        float nrm = 0.f;
#pragma unroll
        for (int i = 0; i < 8; ++i) nrm += red[i];
        const float inv = 1.0f / nrm;
        float acc[NI][4];
#pragma unroll
        for (int i = 0; i < NI; ++i) { acc[i][0] = 0.f; acc[i][1] = 0.f; acc[i][2] = 0.f; acc[i][3] = 0.f; }
        if (tid < L) {
            const float* kp = Kf + L + tid;
            for (int s = 0; s < L; ++s) { const f32x4 u4 = *(const f32x4*)(Uf + s * 4);
#pragma unroll
                for (int i = 0; i < NI; ++i) { const float kv = kp[i * 512 - s]; acc[i][0] += kv * u4[0]; acc[i][1] += kv * u4[1]; acc[i][2] += kv * u4[2]; acc[i][3] += kv * u4[3]; } }
        }
        __syncthreads();
        if (tid < L) {
            const float sk = p.hy_skip[(l * 2 + o) * 256 + c];
            const int ch = o == 0 ? c : 256 + c; const float w0 = cw[ch], w1 = cw[768 + ch], w2 = cw[1536 + ch], bb = cb[ch];
#pragma unroll
            for (int i = 0; i < NI; ++i) { const int t = tid + i * 512;
#pragma unroll
                for (int b = 0; b < 4; ++b) { const float y = acc[i][b] * inv + sk * Uf[t * 4 + b];
                    const float xg = short_conv_at(hy + (size_t)(b * 768 + ch) * L, t, L, w0, w1, w2, bb);
                    if (o == 0) Uf[t * 4 + b] = xg * y; else p.HB[(size_t)(rowbase + b * L + t) * 1024 + c] = f2bf(xg * y); } }
        }
        __syncthreads();
    }
}

template <bool LOCAL> __device__ void attn_wave(const Params& p, int l, int b, int r, int h, int qt, const float* rpbl  ) {
    int tid_ = threadIdx.x; asm volatile("" : "+v"(tid_)); const int lane = tid_ & 63, q = lane & 15, g = lane >> 4;
    const int qrow = LOCAL ? (b * SEQL + r * 64 + qt * 16 + q) : (MMAIN + b * CTXL + qt * 16 + q);
    constexpr int T0 = LOCAL ? 0 : 16;
    bf16x8 Qf[2];
#pragma unroll
    for (int ds = 0; ds < 2; ++ds) Qf[ds] = *(const bf16x8*)(p.QK + (size_t)qrow * 1024 + h * 64 + ds * 32 + 8 * g);
    f32x4 S[32];
    const int c0 = qt == 0 ? 0 : (qt == 1 ? 8 : (qt == 2 ? 24 : 32));
    const int rs = min(max(r - 4, 0), 56);
    const int ki = 8 * (q >> 2) + (q & 3);
    if (LOCAL) {
#pragma unroll
        for (int T = 0; T < 16; ++T) { const int kr = T >> 1, hh = T & 1; const int krow = b * SEQL + (rs + kr) * 64 + c0 + ki + 4 * hh;
            const bf16_t* kp = p.QK + (size_t)krow * 1024 + 512 + h * 64 + 8 * g;
            const bf16x8 k0 = *(const bf16x8*)kp, k1 = *(const bf16x8*)(kp + 32);
            f32x4 a = {0.f, 0.f, 0.f, 0.f};
            a = __builtin_amdgcn_mfma_f32_16x16x32_bf16(k0, Qf[0], a, 0, 0, 0); a = __builtin_amdgcn_mfma_f32_16x16x32_bf16(k1, Qf[1], a, 0, 0, 0); S[T] = a; }
    }
#pragma unroll
    for (int T = 16; T < 32; ++T) { const int cc = (T - 16) >> 1, hh = T & 1; const int krow = MMAIN + b * CTXL + 32 * cc + ki + 4 * hh;
        const bf16_t* kp = p.QK + (size_t)krow * 1024 + 512 + h * 64 + 8 * g;
        const bf16x8 k0 = *(const bf16x8*)kp, k1 = *(const bf16x8*)(kp + 32);
        f32x4 a = {0.f, 0.f, 0.f, 0.f};
        a = __builtin_amdgcn_mfma_f32_16x16x32_bf16(k0, Qf[0], a, 0, 0, 0); a = __builtin_amdgcn_mfma_f32_16x16x32_bf16(k1, Qf[1], a, 0, 0, 0); S[T] = a; }
    float mx = -1e30f;
    if (LOCAL) {
        const int qc = qt * 16 + q, cs = min(max(qc - 8, 0), 48);
#pragma unroll
        for (int T = 0; T < 16; ++T) { const int kr = T >> 1, hh = T & 1; const int brow = (rs + kr - r + 7) * 31;
#pragma unroll
            for (int e = 0; e < 4; ++e) { const int kc = c0 + 8 * g + 4 * hh + e; const bool valid = (kc >= cs) && (kc < cs + 16);
                const int bidx = min(max(kc - qc + 15, 0), 30);
                const float sval = valid ? S[T][e] * 0.125f + rpbl[brow + bidx] : -1e30f; S[T][e] = sval; mx = fmaxf(mx, sval); } }
    }
#pragma unroll
    for (int T = 16; T < 32; ++T)
#pragma unroll
        for (int e = 0; e < 4; ++e) { const float sval = S[T][e] * 0.125f; S[T][e] = sval; mx = fmaxf(mx, sval); }
    mx = fmaxf(mx, __shfl_xor(mx, 16)); mx = fmaxf(mx, __shfl_xor(mx, 32));
    float sum = 0.f;
#pragma unroll
    for (int T = T0; T < 32; ++T)
#pragma unroll
        for (int e = 0; e < 4; ++e) { const float pv = __expf(S[T][e] - mx); S[T][e] = pv; sum += pv; }
    sum += __shfl_xor(sum, 16); sum += __shfl_xor(sum, 32);
    const float inv = 1.0f / sum;
    f32x4 O[4];
#pragma unroll
    for (int dt = 0; dt < 4; ++dt) O[dt] = (f32x4){0.f, 0.f, 0.f, 0.f};
#pragma unroll
    for (int ch = T0 / 2; ch < 16; ++ch) {
        union { u32x4 u; bf16x8 v; } pf;
        pf.u.x = cvt_pk_bf16(S[2 * ch][0], S[2 * ch][1]); pf.u.y = cvt_pk_bf16(S[2 * ch][2], S[2 * ch][3]);
        pf.u.z = cvt_pk_bf16(S[2 * ch + 1][0], S[2 * ch + 1][1]); pf.u.w = cvt_pk_bf16(S[2 * ch + 1][2], S[2 * ch + 1][3]);
#pragma unroll
        for (int dt = 0; dt < 4; ++dt) { const int d = h * 64 + 16 * dt + q;
            const bf16_t* vp = (ch < 8) ? p.VT + ((size_t)(b * 512 + d) * SEQL + (rs + ch) * 64 + c0 + 8 * g) : p.VTC + ((size_t)(b * 512 + d) * CTXL + 32 * (ch - 8) + 8 * g);
            const bf16x8 vf = *(const bf16x8*)vp;
            O[dt] = __builtin_amdgcn_mfma_f32_16x16x32_bf16(vf, pf.v, O[dt], 0, 0, 0); }
    }
#pragma unroll
    for (int dt = 0; dt < 4; ++dt) { u32x2 o; o.x = cvt_pk_bf16(O[dt][0] * inv, O[dt][1] * inv); o.y = cvt_pk_bf16(O[dt][2] * inv, O[dt][3] * inv);
        *(u32x2*)(p.HB + (size_t)qrow * 1024 + 512 + h * 64 + 16 * dt + 4 * g) = o; }
}

__device__ void attn_phase(const Params& p, int l, unsigned char* smem) {
    int tid_ = threadIdx.x; asm volatile("" : "+v"(tid_)); const int tid = tid_, lane = tid & 63, w = tid >> 6;
    float* rp = (float*)smem + w * 512;
    for (int bt = blockIdx.x; bt < 1024; bt += gridDim.x) {
        const int wt = bt * 8 + w, qt = wt & 3, h = (wt >> 2) & 7, r = (wt >> 5) & 63, b = wt >> 11;
        __syncthreads();
        for (int i = lane; i < 465; i += 64) rp[i] = p.na_rpb[(size_t)(l * 8 + h) * 465 + i];
        __syncthreads();
        attn_wave<true>(p, l, b, r, h, qt, rp);
    }
    if (l == 0) {
        for (int bt = blockIdx.x; bt < 64; bt += gridDim.x) {
            const int wt = bt * 8 + w, qt = wt & 15, h = (wt >> 4) & 7, b = wt >> 7;
            attn_wave<false>(p, l, b, 0, h, qt, rp);
        }
    }
}

__global__ __launch_bounds__(512, 2) void mega_kernel(Params p) {
    extern __shared__ __attribute__((aligned(16))) unsigned char smem[];
    cg::grid_group grid = cg::this_grid();
#ifndef NO_PREP
    prep_phase(p, smem);
#endif
    grid.sync();
    for (int l = 0; l < 2; ++l) {
        const int Mff = (l == 0) ? MALL : MMAIN;
        const float* modl = p.MOD + (size_t)l * 5 * 6144;
        norm_phase(p, l, 0, MALL, l == 0);
        grid.sync();
        { EpiIn E; E.hyu = p.HYU; E.hyuc = p.HYUC; E.fnb = p.FNB; E.fnbc = p.FNBC; E.qk = p.QK; E.vt = p.VT; E.vtc = p.VTC;
          run_gemm(smem, p.HB, p.WIN + (size_t)l * NPROJ * 1024, MALL, NPROJ, 1024, E); }
        grid.sync();
        { EpiFn E; E.mix = p.HB; E.rowbase = 0; E.Lr = SEQL; run_gemm(smem, p.DFT, p.FNB, SEQL, 1024, 8192, E); }
        if (l == 0) { EpiFn E; E.mix = p.HB; E.rowbase = MMAIN; E.Lr = CTXL; run_gemm(smem, p.DFTC, p.FNBC, CTXL, 1024, 512, E); }
        __syncthreads();
        for (int task = blockIdx.x; task < (l == 0 ? 512 : 256); task += gridDim.x) {
#ifndef NO_HY
            if (task < 256) hyena_naive<SEQL>(p, l, task, smem); else hyena_naive<CTXL>(p, l, task - 256, smem);
#endif
        }
        __syncthreads();
#ifndef NO_ATTN
        attn_phase(p, l, smem);
#endif
        grid.sync();
        { EpiRes E; E.res_main = (l == 0) ? p.x : p.out; E.res_ctx = (l == 0) ? p.ctx : p.XRC; E.dst_main = p.out; E.dst_ctx = p.XRC; E.gate = modl + 2048;
          run_gemm(smem, p.HB, p.WOUT + (size_t)l * 1024 * 1024, Mff, 1024, 1024, E); }
        grid.sync();
        norm_phase(p, l, 1, Mff, false);
        grid.sync();
        { EpiGU E; E.act = p.ACT; run_gemm(smem, p.HB, p.WGU + (size_t)l * 5632 * 1024, Mff, 5632, 1024, E); }
        grid.sync();
        { EpiRes E; E.res_main = p.out; E.res_ctx = p.XRC; E.dst_main = p.out; E.dst_ctx = p.XRC; E.gate = modl + 5120;
          run_gemm(smem, p.ACT, p.WDN + (size_t)l * 1024 * DFF, Mff, 1024, DFF, E); }
        grid.sync();
    }
    final_norm(p);
}

extern "C" void kernel_launch(void* const* d_in, const int* in_sizes, int n_in, void* d_out, int out_size, void* d_ws, size_t ws_size, hipStream_t stream) {
    (void)in_sizes; (void)n_in; (void)out_size;
    static int grid_blocks = 0;
    if (!grid_blocks) {
        int dev = 0, cus = 0, per_cu = 0;
        hipGetDevice(&dev);
        hipDeviceGetAttribute(&cus, hipDeviceAttributeMultiprocessorCount, dev);
        hipFuncSetAttribute((const void*)mega_kernel, hipFuncAttributeMaxDynamicSharedMemorySize, LDS_BYTES);
        hipOccupancyMaxActiveBlocksPerMultiprocessor(&per_cu, mega_kernel, 512, LDS_BYTES);
        if (per_cu < 1) per_cu = 1;
        if (per_cu > 1) per_cu = 1;
        grid_blocks = cus * per_cu;
    }
    Params p{};
    const float* const* in = (const float* const*)d_in;
    p.x = in[0]; p.c = in[1]; p.ctx = in[2]; p.c_ctx = in[3]; p.w_mod = in[4]; p.b_mod = in[5]; p.norm1_g = in[6]; p.norm2_g = in[7]; p.w_in = in[8]; p.w_out = in[9];
    p.hy_conv_w = in[10]; p.hy_conv_b = in[11]; p.filt_w1 = in[12]; p.filt_b1 = in[13]; p.filt_freq = in[14]; p.filt_w2 = in[15]; p.filt_b2 = in[16]; p.filt_w3 = in[17];
    p.hy_skip = in[18]; p.na_rpb = in[19]; p.w_gate = in[20]; p.w_up = in[21]; p.w_down = in[22]; p.final_g = in[23];
    p.out = (float*)d_out;
    unsigned char* ws = (unsigned char*)d_ws; size_t off = 0;
    auto take = [&](size_t bytes) { unsigned char* r = ws + off; off += (bytes + 255) & ~(size_t)255; return r; };
    p.WIN = (bf16_t*)take((size_t)2 * NPROJ * 1024 * 2);
    p.WOUT = (bf16_t*)take((size_t)2 * 1024 * 1024 * 2);
    p.WGU = (bf16_t*)take((size_t)2 * 5632 * 1024 * 2);
    p.WDN = (bf16_t*)take((size_t)2 * 1024 * DFF * 2);
    p.DFT = (bf16_t*)take((size_t)4096 * 8192 * 2);
    p.DFTC = (bf16_t*)take((size_t)256 * 512 * 2);
    p.MOD = (float*)take((size_t)2 * 5 * 6144 * 4);
    p.H2F = (float*)take((size_t)2 * 4096 * 64 * 4);
    p.H2C = (float*)take((size_t)256 * 64 * 4);
    p.XRC = (float*)take((size_t)MCTX * 1024 * 4);
    p.HB = (bf16_t*)take((size_t)MALL * 1024 * 2);
    unsigned char* big = ws + off;
    p.ACT = (bf16_t*)big;
    size_t boff = 0;
    auto takeb = [&](size_t bytes) { unsigned char* r = big + boff; boff += (bytes + 255) & ~(size_t)255; return r; };
    p.HYU = (bf16_t*)takeb((size_t)NB * 768 * SEQL * 2);
    p.HYUC = (bf16_t*)takeb((size_t)NB * 768 * CTXL * 2);
    p.FNB = (bf16_t*)takeb((size_t)1024 * 8192 * 2);
    p.FNBC = (bf16_t*)takeb((size_t)1024 * 512 * 2);
    p.QK = (bf16_t*)takeb((size_t)MALL * 1024 * 2);
    p.VT = (bf16_t*)takeb((size_t)NB * 512 * SEQL * 2);
    p.VTC = (bf16_t*)takeb((size_t)NB * 512 * CTXL * 2);
    const size_t actb = (size_t)MALL * DFF * 2;
    const size_t need = off + (boff > actb ? boff : actb);
    if (need > ws_size) { fprintf(stderr, "workspace too small: need %zu have %zu\n", need, ws_size); return; }
    void* args[] = {&p};
    hipError_t e = hipLaunchCooperativeKernel((const void*)mega_kernel, dim3(grid_blocks), dim3(512), args, LDS_BYTES, stream);
    if (e != hipSuccess) fprintf(stderr, "cooperative launch failed: %s (grid %d)\n", hipGetErrorString(e), grid_blocks);
}
```

```cpp
#include <hip/hip_runtime.h>
#include <hip/hip_cooperative_groups.h>
#include <cstdio>
namespace cg = cooperative_groups;
#include <cstdint>

#define XB_TMO      128
#define XB_XCNT(j)  (256  + 64 * (j))
#define XB_XSUB(j)  (1280 + 64 * (j))
#define XB_XGEN(j)  (2304 + 64 * (j))
#define XB_TOP      3328
#define XB_TOPGEN   3392
#define XCD_BAR_WORDS 3456
#define XB_SPIN_CAP (1u << 18)
#define LAS __attribute__((address_space(3)))

__device__ __forceinline__ unsigned xb_ld(unsigned* p)              { return __hip_atomic_load(p, __ATOMIC_RELAXED, __HIP_MEMORY_SCOPE_AGENT); }
__device__ __forceinline__ unsigned xb_add(unsigned* p, unsigned v) { return __hip_atomic_fetch_add(p, v, __ATOMIC_RELAXED, __HIP_MEMORY_SCOPE_AGENT); }
__device__ __forceinline__ unsigned xb_xcc_id() { return (unsigned)__builtin_amdgcn_s_getreg((3 << 11) | 20) & 0xFu; }
#define XB_SPIN(cond, bar) do { unsigned _sp = 0; while (cond) { __builtin_amdgcn_s_sleep(1); \
    if ((++_sp & 255u) == 0u) { if (xb_ld(&(bar)[XB_TMO])) break; if (_sp > XB_SPIN_CAP) { atomicAdd(&(bar)[XB_TMO], 1u); break; } } } } while (0)

struct XcdBarrier {
    unsigned* bar; unsigned x;
    volatile LAS unsigned* st;
};

__device__ __forceinline__ XcdBarrier xcd_barrier_post(unsigned* bar, volatile LAS unsigned* st) {
    XcdBarrier b; b.bar = bar; b.x = xb_xcc_id(); b.st = st;
    if (threadIdx.x == 0) (void)xb_add(&bar[XB_XCNT(b.x)], 1u);
    return b;
}
__device__ __forceinline__ void xcd_barrier_complete(unsigned* bar, unsigned x, unsigned& nloc, unsigned& nx) {
    const unsigned G = gridDim.x * gridDim.y * gridDim.z;
    unsigned sum, cnt, mine, sp = 0u;
    for (;;) {
        sum = 0u; cnt = 0u; mine = 0u;
#pragma unroll
        for (unsigned j = 0; j < 16; ++j) { const unsigned c = xb_ld(&bar[XB_XCNT(j)]); sum += c; cnt += (c > 0u) ? 1u : 0u; mine = (j == x) ? c : mine; }
        if (sum == G) break;
        __builtin_amdgcn_s_sleep(1);
        if ((++sp & 255u) == 0u) { if (xb_ld(&bar[XB_TMO])) break; if (sp > XB_SPIN_CAP) { atomicAdd(&bar[XB_TMO], 1u); break; } }
    }
    nloc = mine > 0u ? mine : 1u; nx = cnt > 0u ? cnt : 1u;
}
__device__ __forceinline__ void xcd_barrier(const XcdBarrier& b, int wid_s) {
    asm volatile("s_waitcnt vmcnt(0)" ::: "memory");
    __syncthreads();
    int ln; asm volatile("v_mbcnt_lo_u32_b32 %0, -1, 0\n\tv_mbcnt_hi_u32_b32 %0, -1, %0" : "=v"(ln));
    if (wid_s == 0 && ln == 0) {
        unsigned* bar = b.bar; unsigned bx = b.x; asm volatile("" : "+s"(bar), "+s"(bx));
        __builtin_amdgcn_s_waitcnt(0);
        unsigned nloc = b.st[0], nx = b.st[1];
        if (nloc == 0u) { xcd_barrier_complete(bar, bx, nloc, nx); b.st[0] = nloc; b.st[1] = nx; }
        const unsigned old = xb_add(&bar[XB_XSUB(bx)], 1u);
        const unsigned gen = old / nloc;
        if (old + 1u == (gen + 1u) * nloc) {
            __builtin_amdgcn_fence(__ATOMIC_RELEASE, "agent");
            asm volatile("s_waitcnt vmcnt(0)" ::: "memory");
            const unsigned og = xb_add(&bar[XB_TOP], 1u);
            const unsigned tg = og / nx;
            if (og + 1u == (tg + 1u) * nx) xb_add(&bar[XB_TOPGEN], 1u);
            else XB_SPIN(xb_ld(&bar[XB_TOPGEN]) == tg, bar);
            __builtin_amdgcn_fence(__ATOMIC_ACQUIRE, "agent");
            xb_add(&bar[XB_XGEN(bx)], 1u);
            asm volatile("s_waitcnt vmcnt(0)" ::: "memory");
        } else {
            XB_SPIN(xb_ld(&bar[XB_XGEN(bx)]) == gen, bar);
            __builtin_amdgcn_fence(__ATOMIC_ACQUIRE, "agent");
            asm volatile("s_waitcnt vmcnt(0)" ::: "memory");
        }
    }
    __syncthreads();
}
namespace pg8 {
#define PG8_LAS __attribute__((address_space(3)))
typedef unsigned short bf16_t;
typedef short bf16x8 __attribute__((ext_vector_type(8)));
typedef float f32x4 __attribute__((ext_vector_type(4)));
typedef unsigned u32x4 __attribute__((ext_vector_type(4)));
constexpr int BM = 256, BK = 64, HALF = 128, HTB = HALF * BK * 2  , STAGE_BYTES = 8 * HTB, NXCD = 8, WGM = 8;

__host__ __device__ __forceinline__ int lds_byte(int r, int c) { const int st = (r >> 4) * 2 + (c >> 5), rr = r & 15, cc = c & 31, ob = rr * 64 + cc * 2; return st * 1024 + (ob ^ (((ob >> 9) & 1) << 5)); }
__host__ __device__ __forceinline__ void stage_rc(int b, int& R, int& C) { const int st = b / 1024, sb = b % 1024, swz = sb ^ (((sb >> 9) & 1) << 5); R = (st >> 1) * 16 + swz / 64; C = (st & 1) * 32 + (swz % 64) / 2; }
__host__ __device__ __forceinline__ int perm32(int rho) { const int n = rho >> 4, i = rho & 15; return 8 * (i >> 2) + 4 * n + (i & 3); }

struct Unit { int pm, pn, pk; };
struct Gemm { const bf16_t* A; const bf16_t* Bt; int M, N, K, wid_s, ld; };

struct StaticOrder {
    int nM, nN, nwg, G, c;
    __host__ __device__ void init(int M, int N, int G_, int c_) { nM = M / BM; nN = N / BM; nwg = nM * nN; G = G_; c = c_; }
    __host__ __device__ bool next(int i, Unit& u) const {
        const long L = (long)i * G + c; if (L >= nwg) return false;
        int wgid = (int)L; { const int q = nwg / NXCD, r = nwg % NXCD, xcd = wgid % NXCD, off = wgid / NXCD; wgid = (xcd < r ? xcd * (q + 1) : r * (q + 1) + (xcd - r) * q) + off; }
        const int nig = WGM * nN, gid = wgid / nig, fm = gid * WGM, gsz = (nM - fm) < WGM ? (nM - fm) : WGM;
        u.pm = fm + ((wgid % nig) % gsz); u.pn = (wgid % nig) / gsz; u.pk = 0; return true;
    }
    __device__ __forceinline__ void a_ready(const Unit&) const {}
    __device__ __forceinline__ void done(const Unit&) const {}
};
struct SplitOrder {
    int nM, nN, nK, nwg, G, c;
    __host__ __device__ void init(int M, int N, int nK_, int G_, int c_) { nM = M / BM; nN = N / BM; nK = nK_; nwg = nM * nN * nK; G = G_; c = c_; }
    __host__ __device__ bool next(int i, Unit& u) const { const long L = (long)i * G + c; if (L >= nwg) return false; const int w = (int)L; u.pk = w % nK; const int r = w / nK; u.pn = r % nN; u.pm = r / nN; return true; }
    __device__ __forceinline__ void a_ready(const Unit&) const {}
    __device__ __forceinline__ void done(const Unit&) const {}
};
__device__ __forceinline__ unsigned cvt_pk_bf16(float lo, float hi) { unsigned r; asm volatile("v_cvt_pk_bf16_f32 %0, %1, %2" : "=v"(r) : "v"(lo), "v"(hi)); return r; }
typedef float f32x2 __attribute__((ext_vector_type(2)));
template <class Epi, class Sched, bool STAMP = false>
__device__ __forceinline__ void gemm_phase(PG8_LAS unsigned char* lds, const Gemm g, const Sched& S, const Epi& E, unsigned long long* stamps) {
    int ln_; asm volatile("v_mbcnt_lo_u32_b32 %0, -1, 0\n\tv_mbcnt_hi_u32_b32 %0, -1, %0" : "=v"(ln_)); int tid_ = g.wid_s * 64 + ln_; const int tid = tid_, wid = __builtin_amdgcn_readfirstlane(tid >> 6), lane = tid & 63, wr = wid >> 2, wc = wid & 3, fr = lane & 15, fq = lane >> 4;
    int K_ = g.K, LD_ = g.ld; asm volatile("" : "+s"(K_), "+s"(LD_)); const int K = K_, LD = LD_, nt = K / BK;
    int ts_lo = 0, ts_hi = 0, nts = 0; const unsigned long long rt_entry = STAMP ? (unsigned long long)wall_clock64() : 0ull;
#define PG8_STAMP() do { if (STAMP && wid == 0 && nts < 64) { const unsigned long long _c = (unsigned long long)clock64(); \
        ts_lo = (lane == nts) ? (int)(unsigned)_c : ts_lo; ts_hi = (lane == nts) ? (int)(unsigned)(_c >> 32) : ts_hi; ++nts; } } while (0)
    PG8_STAMP();
    unsigned voffA[2], voffB[2];
#pragma unroll
    for (int i = 0; i < 2; ++i) { int R, C; stage_rc(tid * 16 + i * 8192, R, C); const int Rb = Epi::PERM ? ((R & ~31) + perm32(R & 31)) : R;
        voffA[i] = (unsigned)(R * LD + C) * 2u; voffB[i] = (unsigned)(Rb * LD + C) * 2u; }
    const size_t kstep = (size_t)(BK * 2);
    const size_t hstep = (size_t)HALF * LD * 2;
    const size_t tstep = 2 * hstep;
    const unsigned ldsw = (unsigned)wid * 1024u;
    const int aoff = lds_byte(wr * 64 + fr, fq * 8), boff = lds_byte(wc * 32 + fr, fq * 8);
#define PG8_SA(b, h) (((b) * 2 + (h)) * HTB)
#define PG8_SB(b, h) ((4 + (b) * 2 + (h)) * HTB)
#define PG8_STAGE(bufoff, gbase, voff) do { _Pragma("unroll") for (int _i = 0; _i < 2; ++_i) \
        __builtin_amdgcn_global_load_lds((const unsigned*)((const char*)(gbase) + (voff)[_i]), (PG8_LAS unsigned*)(lds + (bufoff) + ldsw + _i * 8192), 16, 0, 0); } while (0)
#define PG8_LDA(dst, b, h) do { _Pragma("unroll") for (int m = 0; m < 4; ++m) _Pragma("unroll") for (int k = 0; k < 2; ++k) dst[m][k] = *(const PG8_LAS bf16x8*)(lds + PG8_SA(b, h) + aoff + m * 2048 + k * 1024); } while (0)
#define PG8_LDB(dst, b, h) do { _Pragma("unroll") for (int n = 0; n < 2; ++n) _Pragma("unroll") for (int k = 0; k < 2; ++k) dst[n][k] = *(const PG8_LAS bf16x8*)(lds + PG8_SB(b, h) + boff + n * 2048 + k * 1024); } while (0)
#define PG8_MMA(ai, bj, At, Bt) do { __builtin_amdgcn_s_setprio(1); _Pragma("unroll") for (int m = 0; m < 4; ++m) _Pragma("unroll") for (int n = 0; n < 2; ++n) _Pragma("unroll") for (int k = 0; k < 2; ++k) \
        acc[ai][bj][m][n] = __builtin_amdgcn_mfma_f32_16x16x32_bf16(Bt[n][k], At[m][k], acc[ai][bj][m][n], 0, 0, 0); __builtin_amdgcn_s_setprio(0); } while (0)
#define PG8_WAIT_V(n) asm volatile("s_waitcnt vmcnt(" #n ")" ::: "memory")
#define PG8_WAIT_L(n) asm volatile("s_waitcnt lgkmcnt(" #n ")" ::: "memory")
#define PG8_BAR __builtin_amdgcn_s_barrier()
#define PG8_SCHED __builtin_amdgcn_sched_barrier(0)
    Unit cur, nxt; int ui = 0;
    if (!S.next(0, cur)) return;
    f32x4 acc[2][2][4][2];
#pragma unroll
    for (int a = 0; a < 2; ++a)
#pragma unroll
        for (int b = 0; b < 2; ++b)
#pragma unroll
            for (int m = 0; m < 4; ++m)
#pragma unroll
                for (int n = 0; n < 2; ++n) acc[a][b][m][n] = (f32x4){0.f, 0.f, 0.f, 0.f};
    bf16x8 At[4][2], B0[2][2], B1[2][2];
    const size_t kchunk = (size_t)K * 2;
    const char* cA = (const char*)g.A + (size_t)cur.pm * tstep + (size_t)cur.pk * kchunk; const char* cB = (const char*)g.Bt + (size_t)cur.pn * tstep + (size_t)cur.pk * kchunk;
    S.a_ready(cur);
    PG8_STAGE(PG8_SB(0, 0), cB, voffB); PG8_STAGE(PG8_SA(0, 0), cA, voffA); PG8_STAGE(PG8_SB(0, 1), cB + hstep, voffB); PG8_STAGE(PG8_SA(0, 1), cA + hstep, voffA);
    if (wr == 1) PG8_BAR;
    PG8_WAIT_V(4); PG8_BAR;
    PG8_STAGE(PG8_SB(1, 0), cB + kstep, voffB); PG8_STAGE(PG8_SA(1, 0), cA + kstep, voffA); PG8_STAGE(PG8_SB(1, 1), cB + hstep + kstep, voffB);
    PG8_WAIT_V(6); PG8_BAR;
    PG8_STAMP();
    for (;;) {
        const bool has_next = S.next(ui + 1, nxt);
        const char* nA = has_next ? (const char*)g.A + (size_t)nxt.pm * tstep + (size_t)nxt.pk * kchunk : cA; const char* nB = has_next ? (const char*)g.Bt + (size_t)nxt.pn * tstep + (size_t)nxt.pk * kchunk : cB;
        for (int t = 0; t < nt; t += 2) {
            const bool last = (t == nt - 2);
            const char* a1 = cA + (size_t)(t + 1) * kstep;
            const char* a2 = last ? nA : cA + (size_t)(t + 2) * kstep; const char* b2 = last ? nB : cB + (size_t)(t + 2) * kstep;
            const char* a3 = a2 + kstep; const char* b3 = b2 + kstep;
            if (last && has_next) S.a_ready(nxt);
            PG8_LDB(B0, 0, 0); PG8_SCHED; PG8_LDA(At, 0, 0); PG8_STAGE(PG8_SA(1, 1), a1 + hstep, voffA);
            PG8_WAIT_L(8); PG8_BAR; PG8_WAIT_L(0); PG8_MMA(0, 0, At, B0); PG8_BAR; PG8_SCHED;
            PG8_LDB(B1, 0, 1); PG8_STAGE(PG8_SB(0, 0), b2, voffB);
            PG8_BAR; PG8_WAIT_L(0); PG8_MMA(0, 1, At, B1); PG8_BAR;
            PG8_LDA(At, 0, 1); PG8_STAGE(PG8_SA(0, 0), a2, voffA);
            PG8_BAR; PG8_WAIT_L(0); PG8_MMA(1, 0, At, B0); PG8_BAR; PG8_SCHED;
            PG8_STAGE(PG8_SB(0, 1), b2 + hstep, voffB);
            PG8_WAIT_V(6); PG8_BAR; PG8_MMA(1, 1, At, B1); PG8_BAR;
            PG8_LDB(B0, 1, 0); PG8_SCHED; PG8_LDA(At, 1, 0); PG8_STAGE(PG8_SA(0, 1), a2 + hstep, voffA);
            PG8_WAIT_L(8); PG8_BAR; PG8_WAIT_L(0); PG8_MMA(0, 0, At, B0); PG8_BAR; PG8_SCHED;
            PG8_LDB(B1, 1, 1); PG8_STAGE(PG8_SB(1, 0), b3, voffB);
            PG8_BAR; PG8_WAIT_L(0); PG8_MMA(0, 1, At, B1); PG8_BAR;
            PG8_LDA(At, 1, 1); PG8_STAGE(PG8_SA(1, 0), a3, voffA);
            PG8_BAR; PG8_WAIT_L(0); PG8_MMA(1, 0, At, B0); PG8_BAR; PG8_SCHED;
            PG8_STAGE(PG8_SB(1, 1), b3 + hstep, voffB);
            PG8_WAIT_V(6); PG8_BAR; PG8_MMA(1, 1, At, B1); PG8_BAR;
        }
        PG8_STAMP();
        if constexpr (!Epi::AFTER_DRAIN) { E(acc, cur, wr, wc, fr, fq); S.done(cur); }
        PG8_STAMP();
        if (!has_next) break;
#pragma unroll
        for (int a = 0; a < 2; ++a)
#pragma unroll
            for (int b = 0; b < 2; ++b)
#pragma unroll
                for (int m = 0; m < 4; ++m)
#pragma unroll
                    for (int n = 0; n < 2; ++n) acc[a][b][m][n] = (f32x4){0.f, 0.f, 0.f, 0.f};
        cur = nxt; cA = nA; cB = nB; ++ui;
    }
    PG8_WAIT_V(0);
    if (wr == 0) PG8_BAR;
    PG8_BAR;
    if constexpr (Epi::AFTER_DRAIN) { E.fused(acc, cur, wr, wc, fr, fq, lds, wid, lane); S.done(cur); }
    PG8_STAMP();
    if (STAMP && wid == 0) { stamps[lane] = lane < nts ? (((unsigned long long)(unsigned)ts_hi << 32) | (unsigned)ts_lo) : 0ull;
        if (lane == 62) stamps[62] = rt_entry; if (lane == 63) stamps[63] = (unsigned long long)wall_clock64(); }
#undef PG8_STAMP
#undef PG8_SA
#undef PG8_SB
#undef PG8_STAGE
#undef PG8_LDA
#undef PG8_LDB
#undef PG8_MMA
#undef PG8_WAIT_V
#undef PG8_WAIT_L
#undef PG8_BAR
#undef PG8_SCHED
}
}

using pg8::bf16_t; using pg8::bf16x8; using pg8::f32x4; using pg8::u32x4; using pg8::Unit; using pg8::cvt_pk_bf16;
typedef unsigned u32x2 __attribute__((ext_vector_type(2)));
#define LAS3 __attribute__((address_space(3)))

constexpr int DM = 1024, SEQL = 4096, NB = 4, CTXL = 256, DFF = 2816, NPROJ = 2816  ;
constexpr int MMAIN = NB * SEQL  , MCTX = NB * CTXL  , MALL = MMAIN + MCTX  ;
constexpr int LDS_CTL = 139264;
constexpr int LDS_BYTES = LDS_CTL + 16;

struct Params {
    const float *x, *c, *ctx, *c_ctx, *w_mod, *b_mod, *norm1_g, *norm2_g, *w_in, *w_out, *hy_conv_w, *hy_conv_b, *filt_w1, *filt_b1, *filt_freq, *filt_w2, *filt_b2, *filt_w3,
        *hy_skip, *na_rpb, *w_gate, *w_up, *w_down, *final_g;
    float* out;
    bf16_t *WIN, *WOUT, *WGU, *WDN;
    bf16_t *DFT, *DFTC;
    float *MOD, *H2F, *H2C, *XRC;
    bf16_t* XB;
    bf16_t *HB;
    bf16_t *HYU, *HYUC, *FNB, *FNBC, *QK, *VT, *VTC, *ACT, *TAPS2;
    unsigned* BAR;
    bf16_t *FM1, *FM2;
    bf16_t* TAPS;
    float* NRM;
};

__device__ __forceinline__ float shx(float v, int o, int lane) { return __int_as_float(__builtin_amdgcn_ds_bpermute((lane ^ o) << 2, __float_as_int(v))); }
__device__ __forceinline__ int my_tid(int wid_s) { int ln; asm volatile("v_mbcnt_lo_u32_b32 %0, -1, 0\n\tv_mbcnt_hi_u32_b32 %0, -1, %0" : "=v"(ln)); return wid_s * 64 + ln; }
__device__ __forceinline__ int perm256(int lc) { return 64 * ((lc >> 5) & 3) + 16 * ((lc >> 2) & 3) + 8 * (lc >> 7) + 4 * ((lc >> 4) & 1) + (lc & 3); }
__device__ __forceinline__ float silu_f(float x) { return x * __builtin_amdgcn_rcpf(1.0f + __builtin_amdgcn_exp2f(-1.4426950408889634f * x)); }
__device__ __forceinline__ bf16_t f2bf(float f) { unsigned u = __float_as_uint(f); u += 0x7FFFu + ((u >> 16) & 1u); return (bf16_t)(u >> 16); }
__device__ __forceinline__ float bf2f(bf16_t b) { return __uint_as_float(((unsigned)b) << 16); }

struct EpiIn {
    static constexpr bool PERM = false, AFTER_DRAIN = false;
    bf16_t *hyu, *hyuc, *fnb, *fnbc, *qk, *vt, *vtc;
    __device__ __forceinline__ void operator()(const f32x4 (&acc)[2][2][4][2], const Unit& u, int wr, int wc, int fr, int fq) const {
        const bool isctx = u.pm >= 64; const int L = isctx ? CTXL : SEQL;
        const int b = isctx ? (u.pm - 64) : (u.pm >> 4), posbase = isctx ? 0 : (u.pm & 15) * 256;
        const int pn = u.pn;
        if (pn >= 5 && pn < 9) {
            const int row0 = u.pm * 256 + wr * 64 + fr, col0 = (pn - 5) * 256 + wc * 32 + 8 * fq;
#pragma unroll
            for (int ai = 0; ai < 2; ++ai)
#pragma unroll
                for (int m = 0; m < 4; ++m) { bf16_t* rowp = qk + (size_t)(row0 + ai * 128 + m * 16) * 1024 + col0;
#pragma unroll
                    for (int bj = 0; bj < 2; ++bj) { const f32x4 v0 = acc[ai][bj][m][0], v1 = acc[ai][bj][m][1];
                        u32x4 w; w.x = cvt_pk_bf16(v0[0], v0[1]); w.y = cvt_pk_bf16(v0[2], v0[3]); w.z = cvt_pk_bf16(v1[0], v1[1]); w.w = cvt_pk_bf16(v1[2], v1[3]); *(u32x4*)(rowp + bj * 128) = w; } }
        } else {
            unsigned stride; int chan0, off;
            unsigned long long bh = (unsigned long long)(isctx ? hyuc : hyu), bf = (unsigned long long)(isctx ? fnbc : fnb), bv = (unsigned long long)(isctx ? vtc : vt);
            asm volatile("" : "+s"(bh), "+s"(bf), "+s"(bv));
            unsigned long long bsel = bv;
            if (pn < 3) { bsel = bh; chan0 = b * 768 + pn * 256; stride = (unsigned)L; off = 0; }
            else if (pn < 5) { bsel = bf; chan0 = b * 256; stride = (unsigned)(2 * L); off = (pn - 3) * L; }
            else { chan0 = b * 512 + (pn - 9) * 256; stride = (unsigned)L; off = 0; }
            asm volatile("" : "+s"(bsel));
            bf16_t* base = (bf16_t*)bsel;
            const unsigned eoff = (unsigned)(chan0 + wc * 32 + 4 * fq) * stride + (unsigned)(posbase + wr * 64 + fr + off);
#pragma unroll
            for (int bj = 0; bj < 2; ++bj)
#pragma unroll
                for (int n = 0; n < 2; ++n)
#pragma unroll
                    for (int e = 0; e < 4; ++e) { unsigned eo = eoff + (unsigned)(bj * 128 + n * 16 + e) * stride; asm volatile("" : "+v"(eo)); bf16_t* cp = base + eo;
#pragma unroll
                        for (int ai = 0; ai < 2; ++ai)
#pragma unroll
                            for (int m = 0; m < 4; m += 2) { const unsigned pk = cvt_pk_bf16(acc[ai][bj][m][n][e], acc[ai][bj][m + 1][n][e]); cp[ai * 128 + m * 16] = (bf16_t)(pk & 0xffffu); cp[ai * 128 + (m + 1) * 16] = (bf16_t)(pk >> 16); } }
        }
    }
};
template <bool RES_F32> struct EpiResT {
    static constexpr bool PERM = false, AFTER_DRAIN = false;
    const float *res_main, *res_ctx; bf16_t* xb; const float* gate;
    __device__ __forceinline__ void operator()(const f32x4 (&acc)[2][2][4][2], const Unit& u, int wr, int wc, int fr, int fq) const {
        const bool isctx = u.pm >= 64; const int bi = isctx ? 4 : (u.pm >> 4);
        const float* res = isctx ? res_ctx + (size_t)(u.pm - 64) * 256 * 1024 : res_main + (size_t)u.pm * 256 * 1024;
        bf16_t* dst = xb + (size_t)u.pm * 256 * 1024;
        const int col0 = u.pn * 256 + wc * 64 + 16 * fq; const float* gp = gate + bi * 6144 + col0;
        f32x4 gv[2][2];
#pragma unroll
        for (int bj = 0; bj < 2; ++bj)
#pragma unroll
            for (int n = 0; n < 2; ++n) gv[bj][n] = *(const f32x4*)(gp + bj * 8 + n * 4);
#pragma unroll
        for (int ai = 0; ai < 2; ++ai)
#pragma unroll
            for (int m = 0; m < 4; ++m) { const size_t ro = (size_t)(ai * 128 + wr * 64 + m * 16 + fr) * 1024 + col0;
#pragma unroll
                for (int bj = 0; bj < 2; ++bj) { f32x4 r0, r1;
                    if (RES_F32) { r0 = *(const f32x4*)(res + ro + bj * 8); r1 = *(const f32x4*)(res + ro + bj * 8 + 4); }
                    else { const u32x4 q = *(const u32x4*)(dst + ro + bj * 8);
                        r0[0] = __uint_as_float(q.x << 16); r0[1] = __uint_as_float(q.x & 0xffff0000u); r0[2] = __uint_as_float(q.y << 16); r0[3] = __uint_as_float(q.y & 0xffff0000u);
                        r1[0] = __uint_as_float(q.z << 16); r1[1] = __uint_as_float(q.z & 0xffff0000u); r1[2] = __uint_as_float(q.w << 16); r1[3] = __uint_as_float(q.w & 0xffff0000u); }
                    const f32x4 x0 = r0 + gv[bj][0] * acc[ai][bj][m][0], x1 = r1 + gv[bj][1] * acc[ai][bj][m][1];
                    u32x4 o; o.x = cvt_pk_bf16(x0[0], x0[1]); o.y = cvt_pk_bf16(x0[2], x0[3]); o.z = cvt_pk_bf16(x1[0], x1[1]); o.w = cvt_pk_bf16(x1[2], x1[3]); *(u32x4*)(dst + ro + bj * 8) = o; } }
    }
};
struct EpiGU {
    static constexpr bool PERM = false, AFTER_DRAIN = false;
    bf16_t* act;
    __device__ __forceinline__ void operator()(const f32x4 (&acc)[2][2][4][2], const Unit& u, int wr, int wc, int fr, int fq) const {
        const int row0 = u.pm * 256 + wr * 64 + fr, col0 = u.pn * 128 + wc * 32 + 8 * fq;
#pragma unroll
        for (int ai = 0; ai < 2; ++ai)
#pragma unroll
            for (int m = 0; m < 4; ++m) { bf16_t* rowp = act + (size_t)(row0 + ai * 128 + m * 16) * DFF + col0;
                float v[8];
#pragma unroll
                for (int n = 0; n < 2; ++n)
#pragma unroll
                    for (int e = 0; e < 4; ++e) v[n * 4 + e] = silu_f(acc[ai][0][m][n][e]) * acc[ai][1][m][n][e];
                u32x4 w; w.x = cvt_pk_bf16(v[0], v[1]); w.y = cvt_pk_bf16(v[2], v[3]); w.z = cvt_pk_bf16(v[4], v[5]); w.w = cvt_pk_bf16(v[6], v[7]);
                *(u32x4*)rowp = w; }
    }
};
struct EpiFn {
    static constexpr bool PERM = false, AFTER_DRAIN = false;
    bf16_t* mix; int rowbase, Lr;
    __device__ __forceinline__ void operator()(const f32x4 (&acc)[2][2][4][2], const Unit& u, int wr, int wc, int fr, int fq) const {
        const int row0 = rowbase + u.pn * Lr + u.pm * 256 + wr * 64 + fr, col0 = 256 + wc * 32 + 4 * fq;
#pragma unroll
        for (int ai = 0; ai < 2; ++ai)
#pragma unroll
            for (int m = 0; m < 4; ++m) { bf16_t* rowp = mix + (size_t)(row0 + ai * 128 + m * 16) * 1024 + col0;
#pragma unroll
                for (int bj = 0; bj < 2; ++bj)
#pragma unroll
                    for (int n = 0; n < 2; ++n) { const f32x4 v = acc[ai][bj][m][n]; u32x2 w; w.x = cvt_pk_bf16(v[0], v[1]); w.y = cvt_pk_bf16(v[2], v[3]); *(u32x2*)(rowp + bj * 128 + n * 16) = w; } }
    }
};

template <class Epi> __device__ __forceinline__ void run_gemm(int wid_s, unsigned char* smem, const bf16_t* A, const bf16_t* Bt, int M, int N, int K, const Epi& E) {
    pg8::Gemm g; g.A = A; g.Bt = Bt; g.M = M; g.N = N; g.K = K; g.wid_s = wid_s; g.ld = K;
    pg8::StaticOrder S; S.init(M, N, (int)gridDim.x, (int)blockIdx.x);
    pg8::gemm_phase<Epi, pg8::StaticOrder, false>((PG8_LAS unsigned char*)smem, g, S, E, nullptr);
}

struct EpiCtxAtomic {
    static constexpr bool PERM = false, AFTER_DRAIN = false;
    float* dst; const float* gate;
    __device__ __forceinline__ void operator()(const f32x4 (&acc)[2][2][4][2], const Unit& u, int wr, int wc, int fr, int fq) const {
        const int col0 = u.pn * 256 + wc * 32 + 4 * fq; float* d0 = dst + (size_t)u.pm * 256 * 1024;
        f32x4 gv[2][2];
#pragma unroll
        for (int bj = 0; bj < 2; ++bj)
#pragma unroll
            for (int n = 0; n < 2; ++n) gv[bj][n] = *(const f32x4*)(gate + col0 + bj * 128 + n * 16);
#pragma unroll
        for (int ai = 0; ai < 2; ++ai)
#pragma unroll
            for (int m = 0; m < 4; ++m) { float* rp = d0 + (size_t)(ai * 128 + wr * 64 + m * 16 + fr) * 1024 + col0;
#pragma unroll
                for (int bj = 0; bj < 2; ++bj)
#pragma unroll
                    for (int n = 0; n < 2; ++n) { const f32x4 v = gv[bj][n] * acc[ai][bj][m][n];
#pragma unroll
                        for (int e = 0; e < 4; ++e) __hip_atomic_fetch_add(rp + bj * 128 + n * 16 + e, v[e], __ATOMIC_RELAXED, __HIP_MEMORY_SCOPE_AGENT); } }
    }
};
template <class Epi> __device__ __forceinline__ void run_gemm_splitk(int wid_s, unsigned char* smem, const bf16_t* A, const bf16_t* Bt, int M, int N, int Kfull, int Kchunk, const Epi& E) {
    pg8::Gemm g; g.A = A; g.Bt = Bt; g.M = M; g.N = N; g.K = Kchunk; g.wid_s = wid_s; g.ld = Kfull;
    pg8::SplitOrder S; S.init(M, N, Kfull / Kchunk, (int)gridDim.x, (int)blockIdx.x);
    pg8::gemm_phase<Epi, pg8::SplitOrder, false>((PG8_LAS unsigned char*)smem, g, S, E, nullptr);
}

#ifdef PROBE_SEL
#define PREP_MARK(k) do { if (MODE == 0 && blockIdx.x == 5 && my_tid(wid_s) == 0) __hip_atomic_store(p.BAR + 96 + (k), (unsigned)__builtin_amdgcn_s_memrealtime(), __ATOMIC_RELAXED, __HIP_MEMORY_SCOPE_AGENT); } while (0)
#else
#define PREP_MARK(k) do {} while (0)
#endif
template <int MODE> __device__ void prep_phase(const Params& p, int wid_s, unsigned char* smem) {
    int tid_ = my_tid(wid_s); const int tid = tid_, lane = tid & 63, w = tid >> 6;
    float* tab = (float*)smem;
    float* tab64 = (float*)(smem + 16384);
    float* sv = (float*)(smem + 20480);
    float* red = (float*)(smem + 40960);
    const int bidx = MODE == 0 ? (int)blockIdx.x : (int)blockIdx.x - 16, nb = MODE == 0 ? (int)gridDim.x : (int)gridDim.x - 16;
    if (bidx < 0) return;
    for (int i = tid; i < 4096; i += 512) tab[i] = cospif((float)i * (1.0f / 2048.0f));
    if (tid < 64) tab64[tid] = cospif((float)tid * (1.0f / 32.0f));
    for (int i = tid; i < 5120; i += 512) { const int v = i >> 10, k = i & 1023; const float xv = v < 4 ? p.c[v * 1024 + k] : p.c_ctx[k]; sv[i] = xv / (1.0f + expf(-xv)); }
    __syncthreads();
    PREP_MARK(40);
    if (MODE != 1) {
        const int nl = lane, kg = w, lw = MODE == 0 ? 0 : 1;
#define WT_DESC(r, sp, ld, dst) do { \
            if ((r) < 704) { const int nt = (r) >> 4, kt = (r) & 15, n = nt * 64 + nl, k0 = kt * 64 + kg * 8; const int np = (n >= 1280 && n < 2304) ? ((n & ~31) + pg8::perm32(n & 31)) : n; const int src = np < 768 ? np : np - 256; \
                ld = 2560; sp = p.w_in + (size_t)lw * 1024 * 2560 + (size_t)k0 * 2560 + src; dst = p.WIN + (size_t)lw * NPROJ * 1024 + (size_t)n * 1024 + k0; } \
            else if ((r) < 960) { const int rr = (r) - 704, nt = rr >> 4, kt = rr & 15, n = nt * 64 + nl, k0 = kt * 64 + kg * 8; \
                ld = 1024; sp = p.w_out + (size_t)lw * 1024 * 1024 + (size_t)k0 * 1024 + ((n & ~255) + perm256(n & 255)); dst = p.WOUT + (size_t)lw * 1024 * 1024 + (size_t)n * 1024 + k0; } \
            else if ((r) < 2368) { const int rr = (r) - 960, nt = rr >> 4, kt = rr & 15, n = nt * 64 + nl, k0 = kt * 64 + kg * 8; \
                const int pn = n >> 8, lc = n & 255, bj = lc >> 7, wc = (lc >> 5) & 3, nn = (lc >> 4) & 1, fq = (lc >> 2) & 3, e4 = lc & 3; \
                const int j = 128 * pn + 32 * wc + 8 * fq + 4 * nn + e4; \
                ld = DFF; sp = (bj ? p.w_up : p.w_gate) + (size_t)lw * 1024 * DFF + (size_t)k0 * DFF + j; dst = p.WGU + (size_t)lw * 5632 * 1024 + (size_t)n * 1024 + k0; } \
            else { const int rr = (r) - 2368, nt = rr / 44, kt = rr % 44, n = nt * 64 + nl, k0 = kt * 64 + kg * 8; \
                ld = 1024; sp = p.w_down + (size_t)lw * DFF * 1024 + (size_t)k0 * 1024 + ((n & ~255) + perm256(n & 255)); dst = p.WDN + (size_t)lw * 1024 * DFF + (size_t)n * DFF + k0; } } while (0)
        for (int r0 = bidx; r0 < 3072; r0 += 4 * nb) {
            const float* sp[4]; int ld[4]; bf16_t* dd[4]; bool ok[4]; float v[4][8];
#pragma unroll
            for (int i = 0; i < 4; ++i) { const int r = r0 + i * nb; ok[i] = r < 3072 && !(r >= 192 && r < 320); sp[i] = p.w_out; ld[i] = 0; dd[i] = nullptr;
                if (r < 3072) WT_DESC(r, sp[i], ld[i], dd[i]); }
#pragma unroll
            for (int i = 0; i < 4; ++i)
#pragma unroll
                for (int e = 0; e < 8; ++e) v[i][e] = ok[i] ? sp[i][(size_t)e * ld[i]] : 0.f;
#pragma unroll
            for (int i = 0; i < 4; ++i) if (ok[i]) { u32x4 o; o.x = cvt_pk_bf16(v[i][0], v[i][1]); o.y = cvt_pk_bf16(v[i][2], v[i][3]); o.z = cvt_pk_bf16(v[i][4], v[i][5]); o.w = cvt_pk_bf16(v[i][6], v[i][7]); *(u32x4*)dd[i] = o; }
        }
#undef WT_DESC
        for (int ft = (MODE == 0 ? bidx - 128 : bidx); ft >= 0 && ft < 128; ft += nb) {
            const int r = 192 + ft, nt = r >> 4, kt = r & 15, n = nt * 64 + nl, k0 = kt * 64 + kg * 8; const float* W = p.w_in + (size_t)lw * 1024 * 2560;
            int cp = n - 768; const bool isq = cp >= 256; cp &= 255; const int g = cp >> 6, j = cp & 63;
            float v[8];
#pragma unroll
            for (int e = 0; e < 8; ++e) v[e] = 0.f;
#pragma unroll 8
            for (int m = 0; m < 64; ++m) { int idx = (j * m) & 63; if (isq) idx = (idx - 16) & 63; const float tv = tab64[idx];
#pragma unroll
                for (int e = 0; e < 8; ++e) v[e] += W[(size_t)(k0 + e) * 2560 + 768 + g * 64 + m] * tv; }
            u32x4 o; o.x = cvt_pk_bf16(v[0], v[1]); o.y = cvt_pk_bf16(v[2], v[3]); o.z = cvt_pk_bf16(v[4], v[5]); o.w = cvt_pk_bf16(v[6], v[7]);
            *(u32x4*)(p.WIN + (size_t)lw * NPROJ * 1024 + (size_t)n * 1024 + k0) = o;
        }
    }
    __syncthreads(); PREP_MARK(41);
    if (MODE == 0) for (int i = blockIdx.x * 512 + tid; i < 2048; i += gridDim.x * 512) p.NRM[i] = 0.f;
    if (MODE != 2) for (int task = (MODE == 0 ? 0 : 96) + bidx; task < (MODE == 0 ? 96 : 192); task += nb) {
        const int l = task / 96, n = (task % 96) * 64 + lane;
        float a0 = 0.f, a1 = 0.f, a2 = 0.f, a3 = 0.f, a4 = 0.f;
        const float* W = p.w_mod + (size_t)l * 1024 * 6144 + n;
#pragma unroll 16
        for (int kk = 0; kk < 128; ++kk) { const int k = w * 128 + kk; const float wv = W[(size_t)k * 6144];
            a0 += sv[k] * wv; a1 += sv[1024 + k] * wv; a2 += sv[2048 + k] * wv; a3 += sv[3072 + k] * wv; a4 += sv[4096 + k] * wv; }
        red[(w * 5 + 0) * 64 + lane] = a0; red[(w * 5 + 1) * 64 + lane] = a1; red[(w * 5 + 2) * 64 + lane] = a2; red[(w * 5 + 3) * 64 + lane] = a3; red[(w * 5 + 4) * 64 + lane] = a4;
        __syncthreads();
        if (w < 5) { float s = p.b_mod[l * 6144 + n]; for (int ww = 0; ww < 8; ++ww) s += red[(ww * 5 + w) * 64 + lane]; p.MOD[(size_t)(l * 5 + w) * 6144 + n] = s; }
        __syncthreads();
    }
    __syncthreads(); PREP_MARK(42);
    if (MODE == 0) {
        const int gw = blockIdx.x * 8 + w, nw = gridDim.x * 8;
        for (int pid = gw; pid < 8448; pid += nw) {
            int l, t, L; float* outp;
            if (pid < 8192) { l = pid >> 12; t = pid & 4095; L = 4096; outp = p.H2F + (size_t)pid * 64; } else { l = 0; t = pid - 8192; L = 256; outp = p.H2C + (size_t)t * 64; }
            const float tt = (float)t / (float)(L - 1), wa = 6.283185307179586f * (float)t / (float)L;
            const float* w1 = p.filt_w1 + l * 33 * 64; const float* w2 = p.filt_w2 + l * 64 * 64;
            float a = p.filt_b1[l * 64 + lane] + tt * w1[lane];
            for (int bnd = 0; bnd < 16; ++bnd) { const float f = 1e-4f + (float)bnd * ((15.0f - 1e-4f) / 15.0f); const float rev2 = f * ((float)(2 * t) / (float)L);
                a += cospif(rev2) * w1[(1 + bnd) * 64 + lane] - sinpif(rev2) * w1[(17 + bnd) * 64 + lane]; }
            const float h1 = sinf(p.filt_freq[l * 128 + lane] * a);
            float a2 = p.filt_b2[l * 64 + lane];
            for (int i = 0; i < 64; ++i) a2 += __int_as_float(__builtin_amdgcn_ds_bpermute(i << 2, __float_as_int(h1))) * w2[i * 64 + lane];
            outp[lane] = sinf(p.filt_freq[l * 128 + 64 + lane] * a2);
        }
    }
    __syncthreads(); PREP_MARK(43);
    if (MODE == 0) {
        const size_t gt = (size_t)blockIdx.x * 512 + tid, gs = (size_t)gridDim.x * 512;
        for (size_t idx = gt; idx < (size_t)128 * 128; idx += gs) {
            const int m = (int)(idx >> 7), k = (int)(idx & 127), ri = m >> 6, k1 = m & 63, pq = k >> 6, n1 = k & 63, ii = (k1 * n1) & 63;
            const float c = tab64[ii], sn = tab64[(ii - 16) & 63];
            p.FM1[idx] = f2bf(ri == 0 ? (pq == 0 ? c : -sn) : (pq == 0 ? -sn : -c));
        }
        for (size_t idx = gt; idx < (size_t)64 * 128; idx += gs) {
            const int k2 = (int)(idx >> 7), k = (int)(idx & 127), ri = k >> 6, n2 = k & 63, ii = (k2 * n2) & 63;
            p.FM2[idx] = f2bf((ri == 0 ? tab64[ii] : tab64[(ii - 16) & 63]) * (1.0f / 512.0f));
        }
        for (size_t idx = gt; idx < (size_t)256 * 64; idx += gs) {
            const int k = (int)(idx >> 6), kk0 = (int)(idx & 63) * 8; float v[8];
#pragma unroll
            for (int e = 0; e < 8; ++e) { const int kk = kk0 + e, n = kk & 255, ii = ((k * n) & 255) * 16; v[e] = (kk < 256 ? tab[ii] : -tab[(ii - 1024) & 4095]) * (1.0f / 128.0f); }
            u32x4 o; o.x = cvt_pk_bf16(v[0], v[1]); o.y = cvt_pk_bf16(v[2], v[3]); o.z = cvt_pk_bf16(v[4], v[5]); o.w = cvt_pk_bf16(v[6], v[7]);
            *(u32x4*)(p.DFTC + idx * 8) = o;
        }
    }
}

__device__ __forceinline__ void split_bf16x8(const f32x4 a, const f32x4 b, bf16x8& hi, bf16x8& lo) {
    union { u32x4 u; bf16x8 v; } ph, pl;
    ph.u.x = cvt_pk_bf16(a[0], a[1]); ph.u.y = cvt_pk_bf16(a[2], a[3]); ph.u.z = cvt_pk_bf16(b[0], b[1]); ph.u.w = cvt_pk_bf16(b[2], b[3]);
    pl.u.x = cvt_pk_bf16(a[0] - __uint_as_float(ph.u.x << 16), a[1] - __uint_as_float(ph.u.x & 0xffff0000u));
    pl.u.y = cvt_pk_bf16(a[2] - __uint_as_float(ph.u.y << 16), a[3] - __uint_as_float(ph.u.y & 0xffff0000u));
    pl.u.z = cvt_pk_bf16(b[0] - __uint_as_float(ph.u.z << 16), b[1] - __uint_as_float(ph.u.z & 0xffff0000u));
    pl.u.w = cvt_pk_bf16(b[2] - __uint_as_float(ph.u.w << 16), b[3] - __uint_as_float(ph.u.w & 0xffff0000u));
    hi = ph.v; lo = pl.v;
}
__device__ void taps_phase(const Params& p, int wid_s, int l, int bstart) {
    if ((int)blockIdx.x < bstart) return;
    int tid_ = my_tid(wid_s); const int tid = tid_, lane = tid & 63, w = tid >> 6, n = lane & 15, g = lane >> 4;
    const float min_decay = -4.605170185988091f / 1.5f, max_decay = -4.605170185988091f / 0.3f;
    for (int wt = ((int)blockIdx.x - bstart) * 8 + w; wt < 2048; wt += ((int)gridDim.x - bstart) * 8) {
        const int ct = wt >> 5, tq = wt & 31;
        const int col = ct * 16 + n, c = col & 255, dir = (col >> 8) & 1, o = col >> 9;
        bf16x8 Bh[2], Bl[2];
#pragma unroll
        for (int ks = 0; ks < 2; ++ks) { f32x4 x0, x1; const float* wp = p.filt_w3 + (size_t)(l * 64 + 32 * ks + 8 * g) * 1024 + col;
#pragma unroll
            for (int e = 0; e < 4; ++e) { x0[e] = wp[(size_t)e * 1024]; x1[e] = wp[(size_t)(4 + e) * 1024]; }
            split_bf16x8(x0, x1, Bh[ks], Bl[ks]); }
        const float delta = fabsf(min_decay + (float)c * ((max_decay - min_decay) / 255.0f)), dl2 = -delta * (1.4426950408889634f / 4095.0f);
        bf16_t* outp = p.TAPS + ((size_t)((l * 2 + o) * 256 + c)) * 8192 + dir * 4096;
        float asum = 0.f;
        for (int tt = 0; tt < 8; ++tt) {
            const int tb = tq * 128 + tt * 16;
            const float* hp = p.H2F + ((size_t)l * 4096 + tb + n) * 64 + 8 * g;
            f32x4 acc = {0.f, 0.f, 0.f, 0.f};
#pragma unroll
            for (int ks = 0; ks < 2; ++ks) { const f32x4 a0 = *(const f32x4*)(hp + 32 * ks), a1 = *(const f32x4*)(hp + 32 * ks + 4); bf16x8 Ah, Al; split_bf16x8(a0, a1, Ah, Al);
                acc = __builtin_amdgcn_mfma_f32_16x16x32_bf16(Ah, Bh[ks], acc, 0, 0, 0); acc = __builtin_amdgcn_mfma_f32_16x16x32_bf16(Al, Bh[ks], acc, 0, 0, 0); acc = __builtin_amdgcn_mfma_f32_16x16x32_bf16(Ah, Bl[ks], acc, 0, 0, 0); }
            float v[4];
#pragma unroll
            for (int e = 0; e < 4; ++e) { const int t = tb + 4 * g + e; v[e] = acc[e] * __builtin_amdgcn_exp2f((float)t * dl2); if (!(dir == 1 && t == 0)) asum += fabsf(v[e]); }
            u32x2 pk; pk.x = cvt_pk_bf16(v[0], v[1]); pk.y = cvt_pk_bf16(v[2], v[3]);
            *(u32x2*)(outp + tb + 4 * g) = pk;
        }
        asum += shx(asum, 16, lane); asum += shx(asum, 32, lane);
        if (g == 0) __hip_atomic_fetch_add(p.NRM + l * 1024 + col, asum, __ATOMIC_RELAXED, __HIP_MEMORY_SCOPE_AGENT);
    }
}

__device__ void norm_phase(const Params& p, int wid_s, int l, int which, int Mrows, bool from_input) {
    int tid_ = my_tid(wid_s); const int tid = tid_, lane = tid & 63, w = tid >> 6;
    const float* gam = (which ? p.norm2_g : p.norm1_g) + l * 1024;
    const int moff = which ? 3072 : 0;
    for (int row0 = (blockIdx.x * 8 + w) * 4; row0 < Mrows; row0 += gridDim.x * 32) {
        f32x4 v[4][4];
#pragma unroll
        for (int rr = 0; rr < 4; ++rr) { const int row = row0 + rr; const bool isctx = row >= MMAIN;
            if (from_input) { const float* src = isctx ? p.ctx + (size_t)(row - MMAIN) * 1024 : p.x + (size_t)row * 1024;
#pragma unroll
                for (int i = 0; i < 4; ++i) v[rr][i] = *(const f32x4*)(src + i * 256 + lane * 4);
            } else { const bf16_t* src = p.XB + (size_t)row * 1024;
#pragma unroll
                for (int i = 0; i < 4; ++i) { const u32x2 q = *(const u32x2*)(src + i * 256 + lane * 4); v[rr][i][0] = __uint_as_float(q.x << 16); v[rr][i][1] = __uint_as_float(q.x & 0xffff0000u); v[rr][i][2] = __uint_as_float(q.y << 16); v[rr][i][3] = __uint_as_float(q.y & 0xffff0000u); } } }
#pragma unroll
        for (int rr = 0; rr < 4; ++rr) { const int row = row0 + rr; const bool isctx = row >= MMAIN; const int bi = isctx ? 4 : (row >> 12);
            float ss = 0.f;
#pragma unroll
            for (int i = 0; i < 4; ++i) ss += v[rr][i][0] * v[rr][i][0] + v[rr][i][1] * v[rr][i][1] + v[rr][i][2] * v[rr][i][2] + v[rr][i][3] * v[rr][i][3];
#pragma unroll
            for (int o = 32; o >= 1; o >>= 1) ss += shx(ss, o, lane);
            const float rstd = rsqrtf(ss * (1.0f / 1024.0f) + 1e-6f);
            const float* mod = p.MOD + (size_t)(l * 5 + bi) * 6144 + moff;
#pragma unroll
            for (int i = 0; i < 4; ++i) { const int col = i * 256 + lane * 4;
                const f32x4 g = *(const f32x4*)(gam + col), sh = *(const f32x4*)(mod + col), sc = *(const f32x4*)(mod + 1024 + col);
                f32x4 y = v[rr][i] * rstd * g * (sc + 1.0f) + sh;
                u32x2 o; o.x = cvt_pk_bf16(y[0], y[1]); o.y = cvt_pk_bf16(y[2], y[3]);
                *(u32x2*)(p.HB + (size_t)row * 1024 + col) = o; } }
    }
}
__device__ void final_norm(const Params& p, int wid_s) {
    int tid_ = my_tid(wid_s); const int tid = tid_, lane = tid & 63, w = tid >> 6;
    for (int row0 = (blockIdx.x * 8 + w) * 4; row0 < MMAIN; row0 += gridDim.x * 32) {
        f32x4 v[4][4];
#pragma unroll
        for (int rr = 0; rr < 4; ++rr)
#pragma unroll
            for (int i = 0; i < 4; ++i) { const u32x2 q = *(const u32x2*)(p.XB + (size_t)(row0 + rr) * 1024 + i * 256 + lane * 4); v[rr][i][0] = __uint_as_float(q.x << 16); v[rr][i][1] = __uint_as_float(q.x & 0xffff0000u); v[rr][i][2] = __uint_as_float(q.y << 16); v[rr][i][3] = __uint_as_float(q.y & 0xffff0000u); }
#pragma unroll
        for (int rr = 0; rr < 4; ++rr) { const int row = row0 + rr; float* src = p.out + (size_t)row * 1024; float ss = 0.f;
#pragma unroll
            for (int i = 0; i < 4; ++i) ss += v[rr][i][0] * v[rr][i][0] + v[rr][i][1] * v[rr][i][1] + v[rr][i][2] * v[rr][i][2] + v[rr][i][3] * v[rr][i][3];
#pragma unroll
            for (int o = 32; o >= 1; o >>= 1) ss += shx(ss, o, lane);
            const float rstd = rsqrtf(ss * (1.0f / 1024.0f) + 1e-6f);
#pragma unroll
            for (int i = 0; i < 4; ++i) { const int col = i * 256 + lane * 4; const f32x4 g = *(const f32x4*)(p.final_g + col); __builtin_nontemporal_store(v[rr][i] * rstd * g, (f32x4*)(src + col)); }
#ifdef PROBE_SEL
            if (row == 0 && lane == 0) { const unsigned ta = __hip_atomic_load(p.BAR + 96 + PROBE_A, __ATOMIC_RELAXED, __HIP_MEMORY_SCOPE_AGENT), tb = __hip_atomic_load(p.BAR + 96 + PROBE_SEL, __ATOMIC_RELAXED, __HIP_MEMORY_SCOPE_AGENT); src[0] += (float)(tb - ta) * 1e-4f * PROBE_SCALE; }
#endif
        }
    }
}

__device__ __forceinline__ float short_conv_at(const bf16_t* base, int t, int L, float w0, float w1, float w2, float bb) {
    const float um = t > 0 ? bf2f(base[t - 1]) : 0.f, u0 = bf2f(base[t]), up = t < L - 1 ? bf2f(base[t + 1]) : 0.f;
    return um * w0 + u0 * w1 + up * w2 + bb;
}
template <int L> __device__ void hyena_naive(const Params& p, int wid_s, int l, int c, unsigned char* smem) {
    constexpr bool ISCTX = (L == CTXL); constexpr int NI = (L + 511) / 512;
    int tid_ = my_tid(wid_s); const int tid = tid_, lane = tid & 63, w = tid >> 6;
    float* Kf = (float*)smem;
    float* Uf = (float*)(smem + 32768);
    float* red = (float*)(smem + 32768 + 65536);
    const bf16_t* hy = ISCTX ? p.HYUC : p.HYU;
    const float* H2 = ISCTX ? p.H2C : p.H2F + (size_t)l * 4096 * 64;
    const float* cw = p.hy_conv_w + l * 3 * 768; const float* cb = p.hy_conv_b + l * 768;
    const float min_decay = -4.605170185988091f / 1.5f, max_decay = -4.605170185988091f / 0.3f;
    const float delta = fabsf(min_decay + (float)c * ((max_decay - min_decay) / 255.0f));
    const int rowbase = ISCTX ? MMAIN : 0;
    for (int o = 0; o < 2; ++o) {
        float part = 0.f;
        const float* w3 = p.filt_w3 + (size_t)l * 64 * 1024 + o * 512 + c;
        for (int t = tid; t < L; t += 512) {
            const f32x4* hr = (const f32x4*)(H2 + (size_t)t * 64); float kf = 0.f, kb = 0.f;
#pragma unroll
            for (int j4 = 0; j4 < 16; ++j4) { const f32x4 hv = hr[j4];
#pragma unroll
                for (int jj = 0; jj < 4; ++jj) { kf += hv[jj] * w3[(4 * j4 + jj) * 1024]; kb += hv[jj] * w3[(4 * j4 + jj) * 1024 + 256]; } }
            const float dec = expf(-((float)t / (float)(L - 1)) * delta); kf *= dec; kb *= dec;
            Kf[L + t] = kf; part += fabsf(kf);
            if (t >= 1) { Kf[L - t] = kb; part += fabsf(kb); } else Kf[0] = 0.f;
        }
#pragma unroll
        for (int s = 32; s >= 1; s >>= 1) part += shx(part, s, lane);
        if (lane == 0) red[w] = part;
        if (o == 0) {
            const int ch = 512 + c; const float w0 = cw[ch], w1 = cw[768 + ch], w2 = cw[1536 + ch], bb = cb[ch];
            for (int idx = tid; idx < 4 * L; idx += 512) { const int b = idx / L, s = idx % L; Uf[s * 4 + b] = short_conv_at(hy + (size_t)(b * 768 + ch) * L, s, L, w0, w1, w2, bb); }
        }
        __syncthreads();
        float nrm = 0.f;
#pragma unroll
        for (int i = 0; i < 8; ++i) nrm += red[i];
        const float inv = 1.0f / nrm;
        float acc[NI][4];
#pragma unroll
        for (int i = 0; i < NI; ++i) { acc[i][0] = 0.f; acc[i][1] = 0.f; acc[i][2] = 0.f; acc[i][3] = 0.f; }
        if (tid < L) {
            const float* kp = Kf + L + tid;
#pragma unroll 8
            for (int s = 0; s < L; ++s) { const f32x4 u4 = *(const f32x4*)(Uf + s * 4);
#pragma unroll
                for (int i = 0; i < NI; ++i) { const float kv = kp[i * 512 - s]; acc[i][0] += kv * u4[0]; acc[i][1] += kv * u4[1]; acc[i][2] += kv * u4[2]; acc[i][3] += kv * u4[3]; } }
        }
        __syncthreads();
        if (tid < L) {
            const float sk = p.hy_skip[(l * 2 + o) * 256 + c];
            const int ch = o == 0 ? c : 256 + c; const float w0 = cw[ch], w1 = cw[768 + ch], w2 = cw[1536 + ch], bb = cb[ch];
#pragma unroll
            for (int i = 0; i < NI; ++i) { const int t = tid + i * 512;
#pragma unroll
                for (int b = 0; b < 4; ++b) { const float y = acc[i][b] * inv + sk * Uf[t * 4 + b];
                    const float xg = short_conv_at(hy + (size_t)(b * 768 + ch) * L, t, L, w0, w1, w2, bb);
                    if (o == 0) Uf[t * 4 + b] = xg * y; else p.HB[(size_t)(rowbase + b * L + t) * 1024 + c] = f2bf(xg * y); } }
        }
        __syncthreads();
    }
}


constexpr int HK_COPY = 8256, HK_OFF = 4128, HU_BLK = 136, HU_SB = 5280, HK_BYTES = 4 * HK_COPY * 2  , HU_BYTES = 4 * HU_SB * 2  ;
__device__ __forceinline__ int hy_swz(int idx) { return idx ^ ((((idx >> 9) & 3) << 2) | (((idx >> 7) & 1) << 4)); }
__device__ __forceinline__ int hu_idx(int b, int t) { return b * HU_SB + ((t >> 7) + 3) * HU_BLK + (t & 127); }

__device__ __forceinline__ void hyena_conv_mfma(const bf16_t* KC, const bf16_t* UU, float* Yf, int lane, int w) {
    const int qh = w & 1, ks = w >> 1, n = lane & 15, g = lane >> 4;
    f32x4 acc[8][4];
#pragma unroll
    for (int a = 0; a < 8; ++a)
#pragma unroll
        for (int qq = 0; qq < 4; ++qq) acc[a][qq] = (f32x4){0.f, 0.f, 0.f, 0.f};
    const int abase = HK_OFF + 32 * ks + 8 * g - 8 * n;
    const int bbase = (n & 3) * HU_SB + ((n >> 2) + 3) * HU_BLK + 32 * ks + 8 * g;
    for (int D = 16 * qh - 31; D <= 16 * qh + 15; ++D) {
        bf16x8 A[8];
#pragma unroll
        for (int a = 0; a < 8; ++a) { const bf16_t* ap = KC + (a & 3) * HK_COPY + abase - 128 * D - (a & 4);
            if (a < 4) A[a] = *(const bf16x8*)ap;
            else { union { u32x2 h[2]; bf16x8 v; } t; t.h[0] = *(const u32x2*)ap; t.h[1] = *(const u32x2*)(ap + 4); A[a] = t.v; } }
        bf16x8 B[4];
#pragma unroll
        for (int qq = 0; qq < 4; ++qq) B[qq] = *(const bf16x8*)(UU + bbase + min(max(4 * (4 * qh + qq) - D, -3), 31) * HU_BLK);
#pragma unroll
        for (int qq = 0; qq < 4; ++qq) { const int q = 4 * qh + qq;
            if (D >= 4 * q - 31 && D <= 4 * q + 3) {
#pragma unroll
                for (int a = 0; a < 8; ++a) acc[a][qq] = __builtin_amdgcn_mfma_f32_16x16x32_bf16(A[a], B[qq], acc[a][qq], 0, 0, 0);
            } }
    }
    __syncthreads();
    const int Il = n >> 2, b = n & 3;
    const int L3 = Il | ((g & 1) << 2), lbase = 8192 * qh + 512 * Il + 128 * g + b;
    int xa[8];
#pragma unroll
    for (int a = 0; a < 8; ++a) xa[a] = lbase + ((a ^ L3) << 2);
    for (int r = 0; r < 4; ++r) {
        if (ks == r) {
#pragma unroll
            for (int a = 0; a < 8; ++a) { float* yp = Yf + xa[a];
#pragma unroll
                for (int qq = 0; qq < 4; ++qq)
#pragma unroll
                    for (int e = 0; e < 4; ++e) { if (r == 0) yp[2048 * qq + 32 * e] = acc[a][qq][e]; else yp[2048 * qq + 32 * e] += acc[a][qq][e]; } }
        }
        __syncthreads();
    }
}

#ifdef PROBE_SEL
#define PROBE_MARK(k) do { if (l == 0 && c == 0 && my_tid(wid_s) == 0) { __hip_atomic_store(p.BAR + 96 + (k), (unsigned)__builtin_amdgcn_s_memrealtime(), __ATOMIC_RELAXED, __HIP_MEMORY_SCOPE_AGENT); } } while (0)
#else
#define PROBE_MARK(k) do {} while (0)
#endif
__device__ __forceinline__ void short_conv8(const bf16_t* base, int t0, int L, float w0, float w1, float w2, float bb, float (&o)[8]) {
    const u32x4 v = *(const u32x4*)(base + t0);
    const float um = t0 > 0 ? bf2f(base[t0 - 1]) : 0.f, up = t0 + 8 < L ? bf2f(base[t0 + 8]) : 0.f;
    float x[10]; x[0] = um; x[9] = up;
#pragma unroll
    for (int e = 0; e < 4; ++e) { x[1 + 2 * e] = __uint_as_float(v[e] << 16); x[2 + 2 * e] = __uint_as_float(v[e] & 0xffff0000u); }
#pragma unroll
    for (int e = 0; e < 8; ++e) o[e] = x[e] * w0 + x[e + 1] * w1 + x[e + 2] * w2 + bb;
}

__device__ void hyena_mfma(const Params& p, int wid_s, int l, int c, unsigned char* smem) {
    int tid_ = my_tid(wid_s); const int tid = tid_, lane = tid & 63, w = tid >> 6;
    bf16_t* KC = (bf16_t*)smem; bf16_t* UU = (bf16_t*)(smem + HK_BYTES); float* Yf = (float*)smem; float* red = (float*)(smem + HK_BYTES + HU_BYTES);
    constexpr int L = SEQL;
    const bf16_t* hy = p.HYU; const float* H2 = p.H2F + (size_t)l * 4096 * 64;
    const float* cw = p.hy_conv_w + l * 3 * 768; const float* cb = p.hy_conv_b + l * 768;
    const float min_decay = -4.605170185988091f / 1.5f, max_decay = -4.605170185988091f / 0.3f;
    const float delta = fabsf(min_decay + (float)c * ((max_decay - min_decay) / 255.0f));
    u32x4 zero4 = (u32x4){0u, 0u, 0u, 0u}; asm volatile("" : "+v"(zero4));
    PROBE_MARK(0);
    for (int i = tid; i < (HK_BYTES + HU_BYTES) / 16; i += 512) ((u32x4*)smem)[i] = zero4;
    __syncthreads();
#define HY_COPIES(ord) do { const bf16_t* tp = p.TAPS + ((size_t)((l * 2 + (ord)) * 256 + c)) * 8192; \
        for (int i = tid; i < 1024; i += 512) { const u32x4 v = *(const u32x4*)(tp + i * 8); const int dir = i >> 9, tq = (i & 511) * 8; \
            _Pragma("unroll") for (int e = 0; e < 8; ++e) { const bf16_t val = (bf16_t)((e & 1) ? (v[e >> 1] >> 16) : (v[e >> 1] & 0xffffu)); const int t = tq + e; \
                if (dir == 0) { _Pragma("unroll") for (int s4 = 0; s4 < 4; ++s4) KC[s4 * HK_COPY + HK_OFF + s4 - t] = val; } \
                else if (t >= 1) { _Pragma("unroll") for (int s4 = 0; s4 < 4; ++s4) KC[s4 * HK_COPY + HK_OFF + s4 + t] = val; } } } } while (0)
    HY_COPIES(0);
    { int t0 = tid * 8; asm volatile("" : "+v"(t0));
      const int ch = 512 + c; const float w0 = cw[ch], w1 = cw[768 + ch], w2 = cw[1536 + ch], bb = cb[ch];
#pragma unroll
      for (int b = 0; b < 4; ++b) { float o[8]; short_conv8(hy + (size_t)(b * 768 + ch) * L, t0, L, w0, w1, w2, bb, o);
          u32x4 pk; pk.x = cvt_pk_bf16(o[0], o[1]); pk.y = cvt_pk_bf16(o[2], o[3]); pk.z = cvt_pk_bf16(o[4], o[5]); pk.w = cvt_pk_bf16(o[6], o[7]);
          *(u32x4*)(UU + hu_idx(b, t0)) = pk; } }
    __syncthreads();
    const float inv1 = 1.0f / (p.NRM[l * 1024 + c] + p.NRM[l * 1024 + 256 + c]), inv2 = 1.0f / (p.NRM[l * 1024 + 512 + c] + p.NRM[l * 1024 + 768 + c]);
    PROBE_MARK(1);
    hyena_conv_mfma(KC, UU, Yf, lane, w);
    PROBE_MARK(2);
    { int t0 = tid * 8; asm volatile("" : "+v"(t0));
      const float sk = p.hy_skip[(l * 2 + 0) * 256 + c]; const int ch = c; const float w0 = cw[ch], w1 = cw[768 + ch], w2 = cw[1536 + ch], bb = cb[ch];
#pragma unroll
      for (int b = 0; b < 4; ++b) { float xg[8]; short_conv8(hy + (size_t)(b * 768 + ch) * L, t0, L, w0, w1, w2, bb, xg);
          float yv[8];
#pragma unroll
          for (int e = 0; e < 8; ++e) yv[e] = Yf[hy_swz((t0 + e) * 4) + b];
          const u32x4 uq = *(const u32x4*)(UU + hu_idx(b, t0)); float uf[8];
#pragma unroll
          for (int e = 0; e < 4; ++e) { uf[2 * e] = __uint_as_float(uq[e] << 16); uf[2 * e + 1] = __uint_as_float(uq[e] & 0xffff0000u); }
          float z[8];
#pragma unroll
          for (int e = 0; e < 8; ++e) z[e] = xg[e] * (yv[e] * inv1 + sk * uf[e]);
          u32x4 pk; pk.x = cvt_pk_bf16(z[0], z[1]); pk.y = cvt_pk_bf16(z[2], z[3]); pk.z = cvt_pk_bf16(z[4], z[5]); pk.w = cvt_pk_bf16(z[6], z[7]);
          *(u32x4*)(UU + hu_idx(b, t0)) = pk; } }
    __syncthreads();
    PROBE_MARK(3);
    for (int i = tid; i < HK_BYTES / 16; i += 512) ((u32x4*)smem)[i] = zero4;
    __syncthreads();
    HY_COPIES(1);
#undef HY_COPIES
    __syncthreads();
    PROBE_MARK(4);
    hyena_conv_mfma(KC, UU, Yf, lane, w);
    PROBE_MARK(5);
    { int t0 = tid * 8; asm volatile("" : "+v"(t0));
      const float sk = p.hy_skip[(l * 2 + 1) * 256 + c]; const int ch = 256 + c; const float w0 = cw[ch], w1 = cw[768 + ch], w2 = cw[1536 + ch], bb = cb[ch];
#pragma unroll
      for (int b = 0; b < 4; ++b) { float xg[8]; short_conv8(hy + (size_t)(b * 768 + ch) * L, t0, L, w0, w1, w2, bb, xg);
          float yv[8];
#pragma unroll
          for (int e = 0; e < 8; ++e) yv[e] = Yf[hy_swz((t0 + e) * 4) + b];
          const u32x4 uq = *(const u32x4*)(UU + hu_idx(b, t0)); float uf[8];
#pragma unroll
          for (int e = 0; e < 4; ++e) { uf[2 * e] = __uint_as_float(uq[e] << 16); uf[2 * e + 1] = __uint_as_float(uq[e] & 0xffff0000u); }
#pragma unroll
          for (int e = 0; e < 8; ++e) p.HB[(size_t)(b * L + t0 + e) * 1024 + c] = f2bf(xg[e] * (yv[e] * inv2 + sk * uf[e])); } }
    __syncthreads();
    PROBE_MARK(6);
}


constexpr int FN_PITCH = 136, FN_BUF = 256 * FN_PITCH * 2  ;
__device__ void fnet_task(const Params& p, int wid_s, int task, unsigned char* smem) {
    int tid_ = my_tid(wid_s); const int tid = tid_, lane = tid & 63, w = tid >> 6, n = lane & 15, g = lane >> 4;
    const int b = task >> 6, cg = task & 63;
    const int l = 0, c = (task == 50) ? 0 : 1; PROBE_MARK(30);
    bf16_t* In = (bf16_t*)smem; bf16_t* Tb = (bf16_t*)(smem + FN_BUF); bf16_t* Yb = (bf16_t*)smem;
    {
        const bf16_t* src = p.FNB + (size_t)(b * 256 + 4 * cg) * 8192;
#pragma unroll
        for (int i = 0; i < 8; ++i) { const int ch = tid + 512 * i;
            const int cl = ch >> 10, pq = (ch >> 9) & 1, n1 = (ch >> 3) & 63, n20 = (ch & 7) * 8;
            const u32x4 v = *(const u32x4*)(src + (size_t)cl * 8192 + pq * 4096 + n1 * 64 + n20);
            bf16_t* dst = In + (cl * 64 + n20) * FN_PITCH + pq * 64 + n1;
#pragma unroll
            for (int e = 0; e < 4; ++e) { dst[(2 * e) * FN_PITCH] = (bf16_t)(v[e] & 0xffffu); dst[(2 * e + 1) * FN_PITCH] = (bf16_t)(v[e] >> 16); } }
    }
    __syncthreads();
    {
        f32x4 acc[8][2];
#pragma unroll
        for (int mt = 0; mt < 8; ++mt) { acc[mt][0] = (f32x4){0.f, 0.f, 0.f, 0.f}; acc[mt][1] = (f32x4){0.f, 0.f, 0.f, 0.f}; }
        bf16x8 Af[2][8];
#pragma unroll
        for (int mt = 0; mt < 8; ++mt) Af[0][mt] = *(const bf16x8*)(p.FM1 + (16 * mt + n) * 128 + 8 * g);
#pragma unroll
        for (int ks = 0; ks < 4; ++ks) {
            bf16x8 Bf[2];
#pragma unroll
            for (int j = 0; j < 2; ++j) Bf[j] = *(const bf16x8*)(In + (16 * (2 * w + j) + n) * FN_PITCH + 32 * ks + 8 * g);
            if (ks < 3) {
#pragma unroll
                for (int mt = 0; mt < 8; ++mt) Af[(ks + 1) & 1][mt] = *(const bf16x8*)(p.FM1 + (16 * mt + n) * 128 + 32 * (ks + 1) + 8 * g); }
#pragma unroll
            for (int mt = 0; mt < 8; ++mt) {
                acc[mt][0] = __builtin_amdgcn_mfma_f32_16x16x32_bf16(Af[ks & 1][mt], Bf[0], acc[mt][0], 0, 0, 0); acc[mt][1] = __builtin_amdgcn_mfma_f32_16x16x32_bf16(Af[ks & 1][mt], Bf[1], acc[mt][1], 0, 0, 0); }
        }
#pragma unroll
        for (int j = 0; j < 2; ++j) { const int nn = 16 * (2 * w + j) + n, cl = nn >> 6, n2 = nn & 63;
#pragma unroll
            for (int kt = 0; kt < 4; ++kt)
#pragma unroll
                for (int e = 0; e < 4; ++e) { const int k1 = 16 * kt + 4 * g + e; const float ph = (float)(k1 * n2) * (1.0f / 4096.0f);
                    const float cph = __builtin_amdgcn_cosf(ph), sph = __builtin_amdgcn_sinf(ph);
                    const float tr = acc[kt][j][e], ti = acc[kt + 4][j][e];
                    bf16_t* dst = Tb + (cl * 64 + k1) * FN_PITCH + n2;
                    dst[0] = f2bf(cph * tr + sph * ti); dst[64] = f2bf(cph * ti - sph * tr); } }
    }
    __syncthreads();
    {
        f32x4 acc[4][2];
#pragma unroll
        for (int mt = 0; mt < 4; ++mt) { acc[mt][0] = (f32x4){0.f, 0.f, 0.f, 0.f}; acc[mt][1] = (f32x4){0.f, 0.f, 0.f, 0.f}; }
        bf16x8 Af[4][4];
#pragma unroll
        for (int ks = 0; ks < 4; ++ks)
#pragma unroll
            for (int mt = 0; mt < 4; ++mt) Af[ks][mt] = *(const bf16x8*)(p.FM2 + (16 * mt + n) * 128 + 32 * ks + 8 * g);
#pragma unroll
        for (int ks = 0; ks < 4; ++ks) {
            bf16x8 Bf[2];
#pragma unroll
            for (int j = 0; j < 2; ++j) Bf[j] = *(const bf16x8*)(Tb + (16 * (2 * w + j) + n) * FN_PITCH + 32 * ks + 8 * g);
#pragma unroll
            for (int mt = 0; mt < 4; ++mt) {
                acc[mt][0] = __builtin_amdgcn_mfma_f32_16x16x32_bf16(Af[ks][mt], Bf[0], acc[mt][0], 0, 0, 0); acc[mt][1] = __builtin_amdgcn_mfma_f32_16x16x32_bf16(Af[ks][mt], Bf[1], acc[mt][1], 0, 0, 0); }
        }
#pragma unroll
        for (int j = 0; j < 2; ++j) { const int nn = 16 * (2 * w + j) + n, cl = nn >> 6, k1 = nn & 63;
#pragma unroll
            for (int mt = 0; mt < 4; ++mt)
#pragma unroll
                for (int e = 0; e < 4; ++e) { const int k2 = 16 * mt + 4 * g + e; Yb[(k1 + 64 * k2) * 4 + cl] = f2bf(acc[mt][j][e]); } }
    }
    __syncthreads();
#pragma unroll
    for (int i = 0; i < 8; ++i) { const int k = tid + 512 * i; *(u32x2*)(p.HB + (size_t)(b * SEQL + k) * 1024 + 256 + 4 * cg) = *(const u32x2*)(Yb + k * 4); }
    __syncthreads();
    PROBE_MARK(31);
}

template <bool LOCAL> __device__ void attn_wave(const Params& p, int wid_s, int l, int b, int r, int h, int qt, const float* rpbl  ) {
    int tid_ = my_tid(wid_s); const int lane = tid_ & 63, q = lane & 15, g = lane >> 4;
    const int qrow = LOCAL ? (b * SEQL + r * 64 + qt * 16 + q) : (MMAIN + b * CTXL + qt * 16 + q);
    constexpr int T0 = LOCAL ? 0 : 16;
    bf16x8 Qf[2];
#pragma unroll
    for (int ds = 0; ds < 2; ++ds) Qf[ds] = *(const bf16x8*)(p.QK + (size_t)qrow * 1024 + h * 64 + ds * 32 + 8 * g);
    const int c = (LOCAL && b == 1 && r == 11 && h == 4 && qt == 0) ? 0 : 1; PROBE_MARK(10);
    f32x4 S[32];
    const int c0 = qt == 0 ? 0 : (qt == 1 ? 8 : (qt == 2 ? 24 : 32));
    const int rs = min(max(r - 4, 0), 56);
    const int ki = 8 * (q >> 2) + (q & 3);
    const bf16_t* kloc = p.QK + (size_t)(b * SEQL + rs * 64 + c0 + ki) * 1024 + 512 + h * 64 + 8 * g;
    const bf16_t* kctx = p.QK + (size_t)(MMAIN + b * CTXL + ki) * 1024 + 512 + h * 64 + 8 * g;
#pragma unroll
    for (int tb = T0; tb < 32; tb += 8) {
        bf16x8 kf[8][2];
#pragma unroll
        for (int j = 0; j < 8; ++j) { const int T = tb + j, hh = T & 1;
            const bf16_t* kp = (T < 16) ? kloc + (size_t)((T >> 1) * 64 + 4 * hh) * 1024 : kctx + (size_t)(32 * ((T - 16) >> 1) + 4 * hh) * 1024;
            kf[j][0] = *(const bf16x8*)kp; kf[j][1] = *(const bf16x8*)(kp + 32); }
        __builtin_amdgcn_sched_barrier(0);
#pragma unroll
        for (int j = 0; j < 8; ++j) { f32x4 a = {0.f, 0.f, 0.f, 0.f};
            a = __builtin_amdgcn_mfma_f32_16x16x32_bf16(kf[j][0], Qf[0], a, 0, 0, 0); a = __builtin_amdgcn_mfma_f32_16x16x32_bf16(kf[j][1], Qf[1], a, 0, 0, 0); S[tb + j] = a; }
        __builtin_amdgcn_sched_barrier(0);
    }
    PROBE_MARK(11);
    float mx = -1e30f;
    if (LOCAL) {
        const int qc = qt * 16 + q, cs = min(max(qc - 8, 0), 48);
#pragma unroll
        for (int T = 0; T < 16; ++T) { const int kr = T >> 1, hh = T & 1; const int brow = (rs + kr - r + 7) * 31;
#pragma unroll
            for (int e = 0; e < 4; ++e) { const int kc = c0 + 8 * g + 4 * hh + e; const bool valid = (kc >= cs) && (kc < cs + 16);
                const int bidx = min(max(kc - qc + 15, 0), 30);
                const float sval = valid ? S[T][e] * 0.125f + rpbl[brow + bidx] : -1e30f; S[T][e] = sval; mx = fmaxf(mx, sval); } }
    }
#pragma unroll
    for (int T = 16; T < 32; ++T)
#pragma unroll
        for (int e = 0; e < 4; ++e) { const float sval = S[T][e] * 0.125f; S[T][e] = sval; mx = fmaxf(mx, sval); }
    mx = fmaxf(mx, shx(mx, 16, lane)); mx = fmaxf(mx, shx(mx, 32, lane));
    float sum = 0.f;
    bf16x8 Pf[16];
#pragma unroll
    for (int ch = T0 / 2; ch < 16; ++ch) {
        float pv[8];
#pragma unroll
        for (int e = 0; e < 4; ++e) { pv[e] = __expf(S[2 * ch][e] - mx); pv[4 + e] = __expf(S[2 * ch + 1][e] - mx); }
#pragma unroll
        for (int e = 0; e < 8; ++e) sum += pv[e];
        union { u32x4 u; bf16x8 v; } pf;
        pf.u.x = cvt_pk_bf16(pv[0], pv[1]); pf.u.y = cvt_pk_bf16(pv[2], pv[3]); pf.u.z = cvt_pk_bf16(pv[4], pv[5]); pf.u.w = cvt_pk_bf16(pv[6], pv[7]);
        Pf[ch] = pf.v;
    }
    sum += shx(sum, 16, lane); sum += shx(sum, 32, lane);
    const float inv = 1.0f / sum;
    PROBE_MARK(12);
    f32x4 O[4];
#pragma unroll
    for (int dt = 0; dt < 4; ++dt) O[dt] = (f32x4){0.f, 0.f, 0.f, 0.f};
    const bf16_t* vloc = p.VT + ((size_t)(b * 512 + h * 64 + q) * SEQL + rs * 64 + c0 + 8 * g);
    const bf16_t* vctx = p.VTC + ((size_t)(b * 512 + h * 64 + q) * CTXL + 8 * g);
#pragma unroll
    for (int cb = T0 / 2; cb < 16; cb += 4) {
        bf16x8 vf[4][4];
#pragma unroll
        for (int j = 0; j < 4; ++j)
#pragma unroll
            for (int dt = 0; dt < 4; ++dt) { const int ch = cb + j;
                const bf16_t* vp = (ch < 8) ? vloc + (size_t)(16 * dt) * SEQL + ch * 64 : vctx + (size_t)(16 * dt) * CTXL + 32 * (ch - 8);
                vf[j][dt] = *(const bf16x8*)vp; }
        __builtin_amdgcn_sched_barrier(0);
#pragma unroll
        for (int j = 0; j < 4; ++j)
#pragma unroll
            for (int dt = 0; dt < 4; ++dt) O[dt] = __builtin_amdgcn_mfma_f32_16x16x32_bf16(vf[j][dt], Pf[cb + j], O[dt], 0, 0, 0);
        __builtin_amdgcn_sched_barrier(0);
    }
#pragma unroll
    for (int dt = 0; dt < 4; ++dt) { u32x2 o; o.x = cvt_pk_bf16(O[dt][0] * inv, O[dt][1] * inv); o.y = cvt_pk_bf16(O[dt][2] * inv, O[dt][3] * inv);
        *(u32x2*)(p.HB + (size_t)qrow * 1024 + 512 + h * 64 + 16 * dt + 4 * g) = o; }
    PROBE_MARK(13);
}

__device__ __forceinline__ void attn_ld(const bf16_t* kp, const bf16_t* vp, size_t vstride, bf16x8 (&kf)[2][2], bf16x8 (&vf)[4]) {
#pragma unroll
    for (int hh = 0; hh < 2; ++hh)
#pragma unroll
        for (int ds = 0; ds < 2; ++ds) kf[hh][ds] = *(const bf16x8*)(kp + (size_t)hh * 4 * 1024 + ds * 32);
#pragma unroll
    for (int dt = 0; dt < 4; ++dt) vf[dt] = *(const bf16x8*)(vp + (size_t)dt * 16 * vstride);
}
__device__ void attn_wave4(const Params& p, int wid_s, int l, int b, int h, int qt, int rg, const float* rpbl) {
    int tid_ = my_tid(wid_s); const int lane = tid_ & 63, q = lane & 15, g = lane >> 4;
    const int r0 = rg * 4, c0 = qt == 0 ? 0 : (qt == 1 ? 8 : (qt == 2 ? 24 : 32)), qc = qt * 16 + q, cs = min(max(qc - 8, 0), 48);
    int rsj[4];
#pragma unroll
    for (int j = 0; j < 4; ++j) rsj[j] = min(max(r0 + j - 4, 0), 56);
    const int rs0 = rsj[0], nl = rsj[3] + 8 - rs0, nch = nl + 8;
    bf16x8 Qf[4][2];
#pragma unroll
    for (int j = 0; j < 4; ++j)
#pragma unroll
        for (int ds = 0; ds < 2; ++ds) Qf[j][ds] = *(const bf16x8*)(p.QK + (size_t)(b * SEQL + (r0 + j) * 64 + qt * 16 + q) * 1024 + h * 64 + ds * 32 + 8 * g);
    int bidx[8];
#pragma unroll
    for (int hh = 0; hh < 2; ++hh)
#pragma unroll
        for (int e = 0; e < 4; ++e) { const int kc = c0 + 8 * g + 4 * hh + e; bidx[hh * 4 + e] = (kc >= cs && kc < cs + 16) ? (kc - qc + 15) : 31; }
    const float SC = 0.125f * 1.4426950408889634f;
    float m[4], ls[4]; f32x4 O[4][4];
#pragma unroll
    for (int j = 0; j < 4; ++j) { m[j] = -1e30f; ls[j] = 0.f;
#pragma unroll
        for (int dt = 0; dt < 4; ++dt) O[j][dt] = (f32x4){0.f, 0.f, 0.f, 0.f}; }
    const int ki = 8 * (q >> 2) + (q & 3);
    const bf16_t* kloc = p.QK + (size_t)(b * SEQL + c0 + ki) * 1024 + 512 + h * 64 + 8 * g;
    const bf16_t* kctx = p.QK + (size_t)(MMAIN + b * CTXL + ki) * 1024 + 512 + h * 64 + 8 * g;
    const bf16_t* vloc = p.VT + ((size_t)(b * 512 + h * 64 + q) * SEQL + c0 + 8 * g);
    const bf16_t* vctx = p.VTC + ((size_t)(b * 512 + h * 64 + q) * CTXL + 8 * g);
    bf16x8 kf[2][2], vf[4], kfn[2][2], vfn[4];
    attn_ld(kloc + (size_t)rs0 * 64 * 1024, vloc + rs0 * 64, SEQL, kf, vf);
    for (int i = 0; i < nch; ++i) {
        const int i1 = i + 1;
        if (i1 < nch) { if (i1 < nl) attn_ld(kloc + (size_t)(rs0 + i1) * 64 * 1024, vloc + (rs0 + i1) * 64, SEQL, kfn, vfn);
                        else attn_ld(kctx + (size_t)(i1 - nl) * 32 * 1024, vctx + (i1 - nl) * 32, CTXL, kfn, vfn); }
        const bool isloc = i < nl; const int kr = rs0 + i;
#pragma unroll
        for (int j = 0; j < 4; ++j) {
            if (!isloc || (kr >= rsj[j] && kr < rsj[j] + 8)) {
                f32x4 s0 = {0.f, 0.f, 0.f, 0.f}, s1 = {0.f, 0.f, 0.f, 0.f};
                s0 = __builtin_amdgcn_mfma_f32_16x16x32_bf16(kf[0][0], Qf[j][0], s0, 0, 0, 0); s0 = __builtin_amdgcn_mfma_f32_16x16x32_bf16(kf[0][1], Qf[j][1], s0, 0, 0, 0);
                s1 = __builtin_amdgcn_mfma_f32_16x16x32_bf16(kf[1][0], Qf[j][0], s1, 0, 0, 0); s1 = __builtin_amdgcn_mfma_f32_16x16x32_bf16(kf[1][1], Qf[j][1], s1, 0, 0, 0);
                float sv[8];
                if (isloc) { const float* rb = rpbl + (kr - (r0 + j) + 7) * 32;
#pragma unroll
                    for (int e = 0; e < 4; ++e) { sv[e] = s0[e] * SC + rb[bidx[e]]; sv[4 + e] = s1[e] * SC + rb[bidx[4 + e]]; }
                } else {
#pragma unroll
                    for (int e = 0; e < 4; ++e) { sv[e] = s0[e] * SC; sv[4 + e] = s1[e] * SC; }
                }
                float cmax = fmaxf(fmaxf(fmaxf(sv[0], sv[1]), fmaxf(sv[2], sv[3])), fmaxf(fmaxf(sv[4], sv[5]), fmaxf(sv[6], sv[7])));
                cmax = fmaxf(cmax, shx(cmax, 16, lane)); cmax = fmaxf(cmax, shx(cmax, 32, lane));
                const float mn = fmaxf(m[j], cmax); const bool moved = __builtin_amdgcn_ballot_w64(mn > m[j]) != 0ull;
                float pv[8], psum = 0.f;
#pragma unroll
                for (int e = 0; e < 8; ++e) { pv[e] = __builtin_amdgcn_exp2f(sv[e] - mn); psum += pv[e]; }
                if (moved) { const float alpha = __builtin_amdgcn_exp2f(m[j] - mn); m[j] = mn; ls[j] *= alpha;
#pragma unroll
                    for (int dt = 0; dt < 4; ++dt) O[j][dt] *= alpha; }
                ls[j] += psum;
                union { u32x4 u; bf16x8 v; } pf;
                pf.u.x = cvt_pk_bf16(pv[0], pv[1]); pf.u.y = cvt_pk_bf16(pv[2], pv[3]); pf.u.z = cvt_pk_bf16(pv[4], pv[5]); pf.u.w = cvt_pk_bf16(pv[6], pv[7]);
#pragma unroll
                for (int dt = 0; dt < 4; ++dt) O[j][dt] = __builtin_amdgcn_mfma_f32_16x16x32_bf16(vf[dt], pf.v, O[j][dt], 0, 0, 0);
            }
        }
#pragma unroll
        for (int hh = 0; hh < 2; ++hh)
#pragma unroll
            for (int ds = 0; ds < 2; ++ds) kf[hh][ds] = kfn[hh][ds];
#pragma unroll
        for (int dt = 0; dt < 4; ++dt) vf[dt] = vfn[dt];
    }
#pragma unroll
    for (int j = 0; j < 4; ++j) { float lt = ls[j]; lt += shx(lt, 16, lane); lt += shx(lt, 32, lane); const float inv = 1.0f / lt;
        bf16_t* op = p.HB + (size_t)(b * SEQL + (r0 + j) * 64 + qt * 16 + q) * 1024 + 512 + h * 64 + 4 * g;
#pragma unroll
        for (int dt = 0; dt < 4; ++dt) { u32x2 o; o.x = cvt_pk_bf16(O[j][dt][0] * inv, O[j][dt][1] * inv); o.y = cvt_pk_bf16(O[j][dt][2] * inv, O[j][dt][3] * inv); *(u32x2*)(op + 16 * dt) = o; } }
}
__device__ void attn_block_main(const Params& p, int wid_s, int l, int bt, unsigned char* smem) {
    int tid_ = my_tid(wid_s); const int tid = tid_, w = tid >> 6;
    float* rp = (float*)smem;
    const int wt = bt * 8 + w, qt = wt & 3, rg = (wt >> 2) & 15, h = (wt >> 6) & 7, b = wt >> 9;
    { const int c = (bt == 100 && l == 0) ? 0 : 1; PROBE_MARK(8); }
    if (tid < 480) { const int rr = tid >> 5, cc = tid & 31; rp[tid] = cc < 31 ? p.na_rpb[(size_t)(l * 8 + h) * 465 + rr * 31 + cc] * 1.4426950408889634f : -1e30f; }
    __syncthreads();
    attn_wave4(p, wid_s, l, b, h, qt, rg, rp);
    __syncthreads(); { const int c = (bt == 100 && l == 0) ? 0 : 1; PROBE_MARK(9); }
}
__device__ void attn_block_ctx(const Params& p, int wid_s, int l, int bt, unsigned char* smem) {
    int tid_ = my_tid(wid_s); const int tid = tid_, w = tid >> 6;
    const int wt = bt * 8 + w, qt = wt & 15, h = (wt >> 4) & 7, b = wt >> 7;
    attn_wave<false>(p, wid_s, l, b, 0, h, qt, (const float*)smem);
}

__global__ __launch_bounds__(512, 2) void mega_kernel(Params p) {
    extern __shared__ __attribute__((aligned(16))) unsigned char smem[];
    if (p.BAR == nullptr) cg::this_grid().sync();
    const int wid_s = __builtin_amdgcn_readfirstlane((int)(threadIdx.x >> 6));
#ifndef NO_PREP
    if (threadIdx.x == 0) { *(volatile LAS unsigned*)(smem + LDS_CTL) = 0u; *(volatile LAS unsigned*)(smem + LDS_CTL + 4) = 0u; }
    __syncthreads();
    const XcdBarrier xb = xcd_barrier_post(p.BAR, (volatile LAS unsigned*)(smem + LDS_CTL));
#ifdef PROBE_SEL
#define PHASE_MARK(k) do { if (blockIdx.x == 0 && my_tid(wid_s) == 0) __hip_atomic_store(p.BAR + 96 + (k), (unsigned)__builtin_amdgcn_s_memrealtime(), __ATOMIC_RELAXED, __HIP_MEMORY_SCOPE_AGENT); } while (0)
#else
#define PHASE_MARK(k) do {} while (0)
#endif
    int phase_ctr = 16;
#define GSYNC() do { xcd_barrier(xb, wid_s); PHASE_MARK(phase_ctr); ++phase_ctr; } while (0)
    prep_phase<0>(p, wid_s, smem);
#endif
    xcd_barrier(xb, wid_s);
    PHASE_MARK(15);
#ifdef REP_SYNC
    for (int i = 0; i < 10; ++i) GSYNC();
#endif
    for (int l = 0; l < 2; ++l) {
        const int Mff = (l == 0) ? MALL : MMAIN;
        const float* modl = p.MOD + (size_t)l * 5 * 6144;
        norm_phase(p, wid_s, l, 0, MALL, l == 0);
        if (l == 0) taps_phase(p, wid_s, 0, 0);
#ifdef REP_NORM
        norm_phase(p, wid_s, l, 0, MALL, l == 0);
#endif
        GSYNC();
        { EpiIn E; E.hyu = p.HYU; E.hyuc = p.HYUC; E.fnb = p.FNB; E.fnbc = p.FNBC; E.qk = p.QK; E.vt = p.VT; E.vtc = p.VTC;
          run_gemm(wid_s, smem, p.HB, p.WIN + (size_t)l * NPROJ * 1024, MALL, NPROJ, 1024, E);
#ifdef REP_IN
          __syncthreads(); run_gemm(wid_s, smem, p.HB, p.WIN + (size_t)l * NPROJ * 1024, MALL, NPROJ, 1024, E);
#endif
 }
        GSYNC();
        if (l == 0) { EpiFn E; E.mix = p.HB; E.rowbase = MMAIN; E.Lr = CTXL; run_gemm(wid_s, smem, p.DFTC, p.FNBC, CTXL, 1024, 512, E); }
        {
            unsigned* qctr = p.BAR + 64 * l;
            const int nh = (l == 0) ? 768 : 512, ntot = nh + 256 + ((l == 0) ? 64 : 0);
            for (;;) {
                __syncthreads();
                if (my_tid(wid_s) == 0) *(volatile LAS unsigned*)(smem + LDS_CTL + 8) = __hip_atomic_fetch_add(qctr, 1u, __ATOMIC_RELAXED, __HIP_MEMORY_SCOPE_AGENT);
                __syncthreads();
                const int task = __builtin_amdgcn_readfirstlane((int)*(volatile LAS unsigned*)(smem + LDS_CTL + 8));
                if (task >= ntot) break;
                if (task < 256) hyena_mfma(p, wid_s, l, task, smem);
                else if (task < 512) fnet_task(p, wid_s, task - 256, smem);
                else if (task < nh) hyena_naive<CTXL>(p, wid_s, l, task - 512, smem);
                else if (task - nh < 256) attn_block_main(p, wid_s, l, task - nh, smem);
                else attn_block_ctx(p, wid_s, l, task - nh - 256, smem);
            }
        }
        GSYNC();
        if (l == 0) { EpiResT<true> E; E.res_main = p.x; E.res_ctx = p.ctx; E.xb = p.XB; E.gate = modl + 2048;
          run_gemm(wid_s, smem, p.HB, p.WOUT + (size_t)l * 1024 * 1024, Mff, 1024, 1024, E); }
        else { EpiResT<false> E; E.res_main = nullptr; E.res_ctx = nullptr; E.xb = p.XB; E.gate = modl + 2048;
          run_gemm(wid_s, smem, p.HB, p.WOUT + (size_t)l * 1024 * 1024, Mff, 1024, 1024, E); }
        if (l == 0) taps_phase(p, wid_s, 1, 16);
        GSYNC();
        norm_phase(p, wid_s, l, 1, Mff, false);
        GSYNC();
        { EpiGU E; E.act = p.ACT; run_gemm(wid_s, smem, p.HB, p.WGU + (size_t)l * 5632 * 1024, Mff, 5632, 1024, E);
#ifdef REP_GU
          __syncthreads(); run_gemm(wid_s, smem, p.HB, p.WGU + (size_t)l * 5632 * 1024, Mff, 5632, 1024, E);
#endif
 }
        GSYNC();
        { EpiResT<false> E; E.res_main = nullptr; E.res_ctx = nullptr; E.xb = p.XB; E.gate = modl + 5120;
          run_gemm(wid_s, smem, p.ACT, p.WDN + (size_t)l * 1024 * DFF, Mff, 1024, DFF, E); }
        if (l == 0) { __syncthreads(); prep_phase<2>(p, wid_s, smem); __syncthreads(); prep_phase<1>(p, wid_s, smem); }
        GSYNC();
    }
    final_norm(p, wid_s);
}

extern "C" void kernel_launch(void* const* d_in, const int* in_sizes, int n_in, void* d_out, int out_size, void* d_ws, size_t ws_size, hipStream_t stream) {
    (void)in_sizes; (void)n_in; (void)out_size;
    static int grid_blocks = 0;
    if (!grid_blocks) {
        int dev = 0, cus = 0, per_cu = 0;
        hipGetDevice(&dev);
        hipDeviceGetAttribute(&cus, hipDeviceAttributeMultiprocessorCount, dev);
        hipFuncSetAttribute((const void*)mega_kernel, hipFuncAttributeMaxDynamicSharedMemorySize, LDS_BYTES);
        hipOccupancyMaxActiveBlocksPerMultiprocessor(&per_cu, mega_kernel, 512, LDS_BYTES);
        if (per_cu < 1) per_cu = 1;
        if (per_cu > 1) per_cu = 1;
        grid_blocks = cus * per_cu;
    }
    Params p{};
    const float* const* in = (const float* const*)d_in;
    p.x = in[0]; p.c = in[1]; p.ctx = in[2]; p.c_ctx = in[3]; p.w_mod = in[4]; p.b_mod = in[5]; p.norm1_g = in[6]; p.norm2_g = in[7]; p.w_in = in[8]; p.w_out = in[9];
    p.hy_conv_w = in[10]; p.hy_conv_b = in[11]; p.filt_w1 = in[12]; p.filt_b1 = in[13]; p.filt_freq = in[14]; p.filt_w2 = in[15]; p.filt_b2 = in[16]; p.filt_w3 = in[17];
    p.hy_skip = in[18]; p.na_rpb = in[19]; p.w_gate = in[20]; p.w_up = in[21]; p.w_down = in[22]; p.final_g = in[23];
    p.out = (float*)d_out;
    unsigned char* ws = (unsigned char*)d_ws; size_t off = 0;
    auto take = [&](size_t bytes) { unsigned char* r = ws + off; off += (bytes + 255) & ~(size_t)255; return r; };
    p.WIN = (bf16_t*)take((size_t)2 * NPROJ * 1024 * 2);
    p.WOUT = (bf16_t*)take((size_t)2 * 1024 * 1024 * 2);
    p.WGU = (bf16_t*)take((size_t)2 * 5632 * 1024 * 2);
    p.WDN = (bf16_t*)take((size_t)2 * 1024 * DFF * 2);
    p.DFT = nullptr;
    p.FM1 = (bf16_t*)take((size_t)128 * 128 * 2);
    p.FM2 = (bf16_t*)take((size_t)64 * 128 * 2);
    p.DFTC = (bf16_t*)take((size_t)256 * 512 * 2);
    p.MOD = (float*)take((size_t)2 * 5 * 6144 * 4);
    p.H2F = (float*)take((size_t)2 * 4096 * 64 * 4);
    p.H2C = (float*)take((size_t)256 * 64 * 4);
    p.XRC = nullptr;
    p.XB = (bf16_t*)take((size_t)MALL * 1024 * 2);
    p.HB = (bf16_t*)take((size_t)MALL * 1024 * 2);
    p.TAPS2 = nullptr;
    p.TAPS = (bf16_t*)take((size_t)2 * 2 * 256 * 8192 * 2);
    p.NRM = (float*)take((size_t)2048 * 4);
    p.BAR = (unsigned*)take((size_t)XCD_BAR_WORDS * 4);
    unsigned char* big = ws + off;
    p.ACT = (bf16_t*)big;
    size_t boff = 0;
    auto takeb = [&](size_t bytes) { unsigned char* r = big + boff; boff += (bytes + 255) & ~(size_t)255; return r; };
    p.HYU = (bf16_t*)takeb((size_t)NB * 768 * SEQL * 2);
    p.HYUC = (bf16_t*)takeb((size_t)NB * 768 * CTXL * 2);
    p.FNB = (bf16_t*)takeb((size_t)1024 * 8192 * 2);
    p.FNBC = (bf16_t*)takeb((size_t)1024 * 512 * 2);
    p.QK = (bf16_t*)takeb((size_t)MALL * 1024 * 2);
    p.VT = (bf16_t*)takeb((size_t)NB * 512 * SEQL * 2);
    p.VTC = (bf16_t*)takeb((size_t)NB * 512 * CTXL * 2);
    const size_t actb = (size_t)MALL * DFF * 2;
    const size_t need = off + (boff > actb ? boff : actb);
    if (need > ws_size) { fprintf(stderr, "workspace too small: need %zu have %zu\n", need, ws_size); return; }
    hipMemsetAsync(p.BAR, 0, (size_t)XCD_BAR_WORDS * 4, stream);
    void* args[] = {&p};
    hipError_t e = hipLaunchCooperativeKernel((const void*)mega_kernel, dim3(grid_blocks), dim3(512), args, LDS_BYTES, stream);
    if (e != hipSuccess) fprintf(stderr, "cooperative launch failed: %s (grid %d)\n", hipGetErrorString(e), grid_blocks);
}
```

```cpp
#include <hip/hip_runtime.h>
#include <hip/hip_cooperative_groups.h>
#include <cstdio>
namespace cg = cooperative_groups;
#include <cstdint>

#define XB_TMO      128
#define XB_XCNT(j)  (256  + 64 * (j))
#define XB_XSUB(j)  (1280 + 64 * (j))
#define XB_XGEN(j)  (2304 + 64 * (j))
#define XB_TOP      3328
#define XB_TOPGEN   3392
#define XCD_BAR_WORDS 3456
#define XB_SPIN_CAP (1u << 18)
#define LAS __attribute__((address_space(3)))

__device__ __forceinline__ unsigned xb_ld(unsigned* p)              { return __hip_atomic_load(p, __ATOMIC_RELAXED, __HIP_MEMORY_SCOPE_AGENT); }
__device__ __forceinline__ unsigned xb_add(unsigned* p, unsigned v) { return __hip_atomic_fetch_add(p, v, __ATOMIC_RELAXED, __HIP_MEMORY_SCOPE_AGENT); }
__device__ __forceinline__ unsigned xb_xcc_id() { return (unsigned)__builtin_amdgcn_s_getreg((3 << 11) | 20) & 0xFu; }
#define XB_SPIN(cond, bar) do { unsigned _sp = 0; while (cond) { __builtin_amdgcn_s_sleep(1); \
    if ((++_sp & 255u) == 0u) { if (xb_ld(&(bar)[XB_TMO])) break; if (_sp > XB_SPIN_CAP) { atomicAdd(&(bar)[XB_TMO], 1u); break; } } } } while (0)

struct XcdBarrier {
    unsigned* bar; unsigned x;
    volatile LAS unsigned* st;
};

__device__ __forceinline__ XcdBarrier xcd_barrier_post(unsigned* bar, volatile LAS unsigned* st) {
    XcdBarrier b; b.bar = bar; b.x = xb_xcc_id(); b.st = st;
    if (threadIdx.x == 0) (void)xb_add(&bar[XB_XCNT(b.x)], 1u);
    return b;
}
__device__ __forceinline__ void xcd_barrier_complete(unsigned* bar, unsigned x, unsigned& nloc, unsigned& nx) {
    const unsigned G = gridDim.x * gridDim.y * gridDim.z;
    unsigned sum, cnt, mine, sp = 0u;
    for (;;) {
        sum = 0u; cnt = 0u; mine = 0u;
#pragma unroll
        for (unsigned j = 0; j < 16; ++j) { const unsigned c = xb_ld(&bar[XB_XCNT(j)]); sum += c; cnt += (c > 0u) ? 1u : 0u; mine = (j == x) ? c : mine; }
        if (sum == G) break;
        __builtin_amdgcn_s_sleep(1);
        if ((++sp & 255u) == 0u) { if (xb_ld(&bar[XB_TMO])) break; if (sp > XB_SPIN_CAP) { atomicAdd(&bar[XB_TMO], 1u); break; } }
    }
    nloc = mine > 0u ? mine : 1u; nx = cnt > 0u ? cnt : 1u;
}
__device__ __forceinline__ void xcd_barrier(const XcdBarrier& b, int wid_s) {
    asm volatile("s_waitcnt vmcnt(0)" ::: "memory");
    __syncthreads();
    int ln; asm volatile("v_mbcnt_lo_u32_b32 %0, -1, 0\n\tv_mbcnt_hi_u32_b32 %0, -1, %0" : "=v"(ln));
    if (wid_s == 0 && ln == 0) {
        unsigned* bar = b.bar; unsigned bx = b.x; asm volatile("" : "+s"(bar), "+s"(bx));
        __builtin_amdgcn_s_waitcnt(0);
        unsigned nloc = b.st[0], nx = b.st[1];
        if (nloc == 0u) { xcd_barrier_complete(bar, bx, nloc, nx); b.st[0] = nloc; b.st[1] = nx; }
        const unsigned old = xb_add(&bar[XB_XSUB(bx)], 1u);
        const unsigned gen = old / nloc;
        if (old + 1u == (gen + 1u) * nloc) {
            __builtin_amdgcn_fence(__ATOMIC_RELEASE, "agent");
            asm volatile("s_waitcnt vmcnt(0)" ::: "memory");
            const unsigned og = xb_add(&bar[XB_TOP], 1u);
            const unsigned tg = og / nx;
            if (og + 1u == (tg + 1u) * nx) xb_add(&bar[XB_TOPGEN], 1u);
            else XB_SPIN(xb_ld(&bar[XB_TOPGEN]) == tg, bar);
            __builtin_amdgcn_fence(__ATOMIC_ACQUIRE, "agent");
            xb_add(&bar[XB_XGEN(bx)], 1u);
            asm volatile("s_waitcnt vmcnt(0)" ::: "memory");
        } else {
            XB_SPIN(xb_ld(&bar[XB_XGEN(bx)]) == gen, bar);
            __builtin_amdgcn_fence(__ATOMIC_ACQUIRE, "agent");
            asm volatile("s_waitcnt vmcnt(0)" ::: "memory");
        }
    }
    __syncthreads();
}
namespace pg8 {
#define PG8_LAS __attribute__((address_space(3)))
typedef unsigned short bf16_t;
typedef short bf16x8 __attribute__((ext_vector_type(8)));
typedef float f32x4 __attribute__((ext_vector_type(4)));
typedef unsigned u32x4 __attribute__((ext_vector_type(4)));
constexpr int BM = 256, BK = 64, HALF = 128, HTB = HALF * BK * 2  , STAGE_BYTES = 8 * HTB, NXCD = 8, WGM = 8;

__host__ __device__ __forceinline__ int lds_byte(int r, int c) { const int st = (r >> 4) * 2 + (c >> 5), rr = r & 15, cc = c & 31, ob = rr * 64 + cc * 2; return st * 1024 + (ob ^ (((ob >> 9) & 1) << 5)); }
__host__ __device__ __forceinline__ void stage_rc(int b, int& R, int& C) { const int st = b / 1024, sb = b % 1024, swz = sb ^ (((sb >> 9) & 1) << 5); R = (st >> 1) * 16 + swz / 64; C = (st & 1) * 32 + (swz % 64) / 2; }
__host__ __device__ __forceinline__ int perm32(int rho) { const int n = rho >> 4, i = rho & 15; return 8 * (i >> 2) + 4 * n + (i & 3); }

struct Unit { int pm, pn, pk; };
struct Gemm { const bf16_t* A; const bf16_t* Bt; int M, N, K, wid_s, ld; };

struct StaticOrder {
    int nM, nN, nwg, G, c;
    __host__ __device__ void init(int M, int N, int G_, int c_) { nM = M / BM; nN = N / BM; nwg = nM * nN; G = G_; c = c_; }
    __host__ __device__ bool next(int i, Unit& u) const {
        const long L = (long)i * G + c; if (L >= nwg) return false;
        int wgid = (int)L; { const int q = nwg / NXCD, r = nwg % NXCD, xcd = wgid % NXCD, off = wgid / NXCD; wgid = (xcd < r ? xcd * (q + 1) : r * (q + 1) + (xcd - r) * q) + off; }
        const int nig = WGM * nN, gid = wgid / nig, fm = gid * WGM, gsz = (nM - fm) < WGM ? (nM - fm) : WGM;
        u.pm = fm + ((wgid % nig) % gsz); u.pn = (wgid % nig) / gsz; u.pk = 0; return true;
    }
    __device__ __forceinline__ void a_ready(const Unit&) const {}
    __device__ __forceinline__ void done(const Unit&) const {}
};
struct SplitOrder {
    int nM, nN, nK, nwg, G, c;
    __host__ __device__ void init(int M, int N, int nK_, int G_, int c_) { nM = M / BM; nN = N / BM; nK = nK_; nwg = nM * nN * nK; G = G_; c = c_; }
    __host__ __device__ bool next(int i, Unit& u) const { const long L = (long)i * G + c; if (L >= nwg) return false; const int w = (int)L; u.pk = w % nK; const int r = w / nK; u.pn = r % nN; u.pm = r / nN; return true; }
    __device__ __forceinline__ void a_ready(const Unit&) const {}
    __device__ __forceinline__ void done(const Unit&) const {}
};
__device__ __forceinline__ unsigned cvt_pk_bf16(float lo, float hi) { unsigned r; asm volatile("v_cvt_pk_bf16_f32 %0, %1, %2" : "=v"(r) : "v"(lo), "v"(hi)); return r; }
typedef float f32x2 __attribute__((ext_vector_type(2)));
template <class Epi, class Sched, bool STAMP = false>
__device__ __forceinline__ void gemm_phase(PG8_LAS unsigned char* lds, const Gemm g, const Sched& S, const Epi& E, unsigned long long* stamps) {
    int ln_; asm volatile("v_mbcnt_lo_u32_b32 %0, -1, 0\n\tv_mbcnt_hi_u32_b32 %0, -1, %0" : "=v"(ln_)); int tid_ = g.wid_s * 64 + ln_; const int tid = tid_, wid = __builtin_amdgcn_readfirstlane(tid >> 6), lane = tid & 63, wr = wid >> 2, wc = wid & 3, fr = lane & 15, fq = lane >> 4;
    int K_ = g.K, LD_ = g.ld; asm volatile("" : "+s"(K_), "+s"(LD_)); const int K = K_, LD = LD_, nt = K / BK;
    int ts_lo = 0, ts_hi = 0, nts = 0; const unsigned long long rt_entry = STAMP ? (unsigned long long)wall_clock64() : 0ull;
#define PG8_STAMP() do { if (STAMP && wid == 0 && nts < 64) { const unsigned long long _c = (unsigned long long)clock64(); \
        ts_lo = (lane == nts) ? (int)(unsigned)_c : ts_lo; ts_hi = (lane == nts) ? (int)(unsigned)(_c >> 32) : ts_hi; ++nts; } } while (0)
    PG8_STAMP();
    unsigned voffA[2], voffB[2];
#pragma unroll
    for (int i = 0; i < 2; ++i) { int R, C; stage_rc(tid * 16 + i * 8192, R, C); const int Rb = Epi::PERM ? ((R & ~31) + perm32(R & 31)) : R;
        voffA[i] = (unsigned)(R * LD + C) * 2u; voffB[i] = (unsigned)(Rb * LD + C) * 2u; }
    const size_t kstep = (size_t)(BK * 2);
    const size_t hstep = (size_t)HALF * LD * 2;
    const size_t tstep = 2 * hstep;
    const unsigned ldsw = (unsigned)wid * 1024u;
    const int aoff = lds_byte(wr * 64 + fr, fq * 8), boff = lds_byte(wc * 32 + fr, fq * 8);
#define PG8_SA(b, h) (((b) * 2 + (h)) * HTB)
#define PG8_SB(b, h) ((4 + (b) * 2 + (h)) * HTB)
#define PG8_STAGE(bufoff, gbase, voff) do { _Pragma("unroll") for (int _i = 0; _i < 2; ++_i) \
        __builtin_amdgcn_global_load_lds((const unsigned*)((const char*)(gbase) + (voff)[_i]), (PG8_LAS unsigned*)(lds + (bufoff) + ldsw + _i * 8192), 16, 0, 0); } while (0)
#define PG8_LDA(dst, b, h) do { _Pragma("unroll") for (int m = 0; m < 4; ++m) _Pragma("unroll") for (int k = 0; k < 2; ++k) dst[m][k] = *(const PG8_LAS bf16x8*)(lds + PG8_SA(b, h) + aoff + m * 2048 + k * 1024); } while (0)
#define PG8_LDB(dst, b, h) do { _Pragma("unroll") for (int n = 0; n < 2; ++n) _Pragma("unroll") for (int k = 0; k < 2; ++k) dst[n][k] = *(const PG8_LAS bf16x8*)(lds + PG8_SB(b, h) + boff + n * 2048 + k * 1024); } while (0)
#define PG8_MMA(ai, bj, At, Bt) do { __builtin_amdgcn_s_setprio(1); _Pragma("unroll") for (int m = 0; m < 4; ++m) _Pragma("unroll") for (int n = 0; n < 2; ++n) _Pragma("unroll") for (int k = 0; k < 2; ++k) \
        acc[ai][bj][m][n] = __builtin_amdgcn_mfma_f32_16x16x32_bf16(Bt[n][k], At[m][k], acc[ai][bj][m][n], 0, 0, 0); __builtin_amdgcn_s_setprio(0); } while (0)
#define PG8_WAIT_V(n) asm volatile("s_waitcnt vmcnt(" #n ")" ::: "memory")
#define PG8_WAIT_L(n) asm volatile("s_waitcnt lgkmcnt(" #n ")" ::: "memory")
#define PG8_BAR __builtin_amdgcn_s_barrier()
#define PG8_SCHED __builtin_amdgcn_sched_barrier(0)
    Unit cur, nxt; int ui = 0;
    if (!S.next(0, cur)) return;
    f32x4 acc[2][2][4][2];
#pragma unroll
    for (int a = 0; a < 2; ++a)
#pragma unroll
        for (int b = 0; b < 2; ++b)
#pragma unroll
            for (int m = 0; m < 4; ++m)
#pragma unroll
                for (int n = 0; n < 2; ++n) acc[a][b][m][n] = (f32x4){0.f, 0.f, 0.f, 0.f};
    bf16x8 At[4][2], B0[2][2], B1[2][2];
    const size_t kchunk = (size_t)K * 2;
    const char* cA = (const char*)g.A + (size_t)cur.pm * tstep + (size_t)cur.pk * kchunk; const char* cB = (const char*)g.Bt + (size_t)cur.pn * tstep + (size_t)cur.pk * kchunk;
    S.a_ready(cur);
    PG8_STAGE(PG8_SB(0, 0), cB, voffB); PG8_STAGE(PG8_SA(0, 0), cA, voffA); PG8_STAGE(PG8_SB(0, 1), cB + hstep, voffB); PG8_STAGE(PG8_SA(0, 1), cA + hstep, voffA);
    if (wr == 1) PG8_BAR;
    PG8_WAIT_V(4); PG8_BAR;
    PG8_STAGE(PG8_SB(1, 0), cB + kstep, voffB); PG8_STAGE(PG8_SA(1, 0), cA + kstep, voffA); PG8_STAGE(PG8_SB(1, 1), cB + hstep + kstep, voffB);
    PG8_WAIT_V(6); PG8_BAR;
    PG8_STAMP();
    for (;;) {
        const bool has_next = S.next(ui + 1, nxt);
        const char* nA = has_next ? (const char*)g.A + (size_t)nxt.pm * tstep + (size_t)nxt.pk * kchunk : cA; const char* nB = has_next ? (const char*)g.Bt + (size_t)nxt.pn * tstep + (size_t)nxt.pk * kchunk : cB;
        for (int t = 0; t < nt; t += 2) {
            const bool last = (t == nt - 2);
            const char* a1 = cA + (size_t)(t + 1) * kstep;
            const char* a2 = last ? nA : cA + (size_t)(t + 2) * kstep; const char* b2 = last ? nB : cB + (size_t)(t + 2) * kstep;
            const char* a3 = a2 + kstep; const char* b3 = b2 + kstep;
            if (last && has_next) S.a_ready(nxt);
            PG8_LDB(B0, 0, 0); PG8_SCHED; PG8_LDA(At, 0, 0); PG8_STAGE(PG8_SA(1, 1), a1 + hstep, voffA);
            PG8_WAIT_L(8); PG8_BAR; PG8_WAIT_L(0); PG8_MMA(0, 0, At, B0); PG8_BAR; PG8_SCHED;
            PG8_LDB(B1, 0, 1); PG8_STAGE(PG8_SB(0, 0), b2, voffB);
            PG8_BAR; PG8_WAIT_L(0); PG8_MMA(0, 1, At, B1); PG8_BAR;
            PG8_LDA(At, 0, 1); PG8_STAGE(PG8_SA(0, 0), a2, voffA);
            PG8_BAR; PG8_WAIT_L(0); PG8_MMA(1, 0, At, B0); PG8_BAR; PG8_SCHED;
            PG8_STAGE(PG8_SB(0, 1), b2 + hstep, voffB);
            PG8_WAIT_V(6); PG8_BAR; PG8_MMA(1, 1, At, B1); PG8_BAR;
            PG8_LDB(B0, 1, 0); PG8_SCHED; PG8_LDA(At, 1, 0); PG8_STAGE(PG8_SA(0, 1), a2 + hstep, voffA);
            PG8_WAIT_L(8); PG8_BAR; PG8_WAIT_L(0); PG8_MMA(0, 0, At, B0); PG8_BAR; PG8_SCHED;
            PG8_LDB(B1, 1, 1); PG8_STAGE(PG8_SB(1, 0), b3, voffB);
            PG8_BAR; PG8_WAIT_L(0); PG8_MMA(0, 1, At, B1); PG8_BAR;
            PG8_LDA(At, 1, 1); PG8_STAGE(PG8_SA(1, 0), a3, voffA);
            PG8_BAR; PG8_WAIT_L(0); PG8_MMA(1, 0, At, B0); PG8_BAR; PG8_SCHED;
            PG8_STAGE(PG8_SB(1, 1), b3 + hstep, voffB);
            PG8_WAIT_V(6); PG8_BAR; PG8_MMA(1, 1, At, B1); PG8_BAR;
        }
        PG8_STAMP();
        if constexpr (!Epi::AFTER_DRAIN) { E(acc, cur, wr, wc, fr, fq); S.done(cur); }
        PG8_STAMP();
        if (!has_next) break;
#pragma unroll
        for (int a = 0; a < 2; ++a)
#pragma unroll
            for (int b = 0; b < 2; ++b)
#pragma unroll
                for (int m = 0; m < 4; ++m)
#pragma unroll
                    for (int n = 0; n < 2; ++n) acc[a][b][m][n] = (f32x4){0.f, 0.f, 0.f, 0.f};
        cur = nxt; cA = nA; cB = nB; ++ui;
    }
    PG8_WAIT_V(0);
    if (wr == 0) PG8_BAR;
    PG8_BAR;
    if constexpr (Epi::AFTER_DRAIN) { E.fused(acc, cur, wr, wc, fr, fq, lds, wid, lane); S.done(cur); }
    PG8_STAMP();
    if (STAMP && wid == 0) { stamps[lane] = lane < nts ? (((unsigned long long)(unsigned)ts_hi << 32) | (unsigned)ts_lo) : 0ull;
        if (lane == 62) stamps[62] = rt_entry; if (lane == 63) stamps[63] = (unsigned long long)wall_clock64(); }
#undef PG8_STAMP
#undef PG8_SA
#undef PG8_SB
#undef PG8_STAGE
#undef PG8_LDA
#undef PG8_LDB
#undef PG8_MMA
#undef PG8_WAIT_V
#undef PG8_WAIT_L
#undef PG8_BAR
#undef PG8_SCHED
}
}

using pg8::bf16_t; using pg8::bf16x8; using pg8::f32x4; using pg8::u32x4; using pg8::Unit; using pg8::cvt_pk_bf16;
typedef unsigned u32x2 __attribute__((ext_vector_type(2)));
#define LAS3 __attribute__((address_space(3)))

constexpr int DM = 1024, SEQL = 4096, NB = 4, CTXL = 256, DFF = 2816, NPROJ = 2816  ;
constexpr int MMAIN = NB * SEQL  , MCTX = NB * CTXL  , MALL = MMAIN + MCTX  ;
constexpr int LDS_CTL = 139264;
constexpr int LDS_BYTES = LDS_CTL + 16;

struct Params {
    const float *x, *c, *ctx, *c_ctx, *w_mod, *b_mod, *norm1_g, *norm2_g, *w_in, *w_out, *hy_conv_w, *hy_conv_b, *filt_w1, *filt_b1, *filt_freq, *filt_w2, *filt_b2, *filt_w3,
        *hy_skip, *na_rpb, *w_gate, *w_up, *w_down, *final_g;
    float* out;
    bf16_t *WIN, *WOUT, *WGU, *WDN;
    bf16_t *DFT, *DFTC;
    float *MOD, *H2F, *H2C, *XRC;
    bf16_t* XB;
    bf16_t *HB;
    bf16_t *HYU, *HYUC, *FNB, *FNBC, *QK, *VT, *VTC, *ACT, *TAPS2;
    unsigned* BAR;
    bf16_t *FM1, *FM2;
    bf16_t* TAPS;
    float* NRM;
};

__device__ __forceinline__ float shx(float v, int o, int lane) { return __int_as_float(__builtin_amdgcn_ds_bpermute((lane ^ o) << 2, __float_as_int(v))); }
__device__ __forceinline__ int my_tid(int wid_s) { int ln; asm volatile("v_mbcnt_lo_u32_b32 %0, -1, 0\n\tv_mbcnt_hi_u32_b32 %0, -1, %0" : "=v"(ln)); return wid_s * 64 + ln; }
__device__ __forceinline__ int perm256(int lc) { return 64 * ((lc >> 5) & 3) + 16 * ((lc >> 2) & 3) + 8 * (lc >> 7) + 4 * ((lc >> 4) & 1) + (lc & 3); }
__device__ __forceinline__ float silu_f(float x) { return x * __builtin_amdgcn_rcpf(1.0f + __builtin_amdgcn_exp2f(-1.4426950408889634f * x)); }
__device__ __forceinline__ bf16_t f2bf(float f) { unsigned u = __float_as_uint(f); u += 0x7FFFu + ((u >> 16) & 1u); return (bf16_t)(u >> 16); }
__device__ __forceinline__ float bf2f(bf16_t b) { return __uint_as_float(((unsigned)b) << 16); }

struct EpiIn {
    static constexpr bool PERM = false, AFTER_DRAIN = false;
    bf16_t *hyu, *hyuc, *fnb, *fnbc, *qk, *vt, *vtc;
    __device__ __forceinline__ void operator()(const f32x4 (&acc)[2][2][4][2], const Unit& u, int wr, int wc, int fr, int fq) const {
        const bool isctx = u.pm >= 64; const int L = isctx ? CTXL : SEQL;
        const int b = isctx ? (u.pm - 64) : (u.pm >> 4), posbase = isctx ? 0 : (u.pm & 15) * 256;
        const int pn = u.pn;
        if (pn >= 5 && pn < 9) {
            const int row0 = u.pm * 256 + wr * 64 + fr, col0 = (pn - 5) * 256 + wc * 32 + 8 * fq;
#pragma unroll
            for (int ai = 0; ai < 2; ++ai)
#pragma unroll
                for (int m = 0; m < 4; ++m) { bf16_t* rowp = qk + (size_t)(row0 + ai * 128 + m * 16) * 1024 + col0;
#pragma unroll
                    for (int bj = 0; bj < 2; ++bj) { const f32x4 v0 = acc[ai][bj][m][0], v1 = acc[ai][bj][m][1];
                        u32x4 w; w.x = cvt_pk_bf16(v0[0], v0[1]); w.y = cvt_pk_bf16(v0[2], v0[3]); w.z = cvt_pk_bf16(v1[0], v1[1]); w.w = cvt_pk_bf16(v1[2], v1[3]); *(u32x4*)(rowp + bj * 128) = w; } }
        } else {
            unsigned stride; int chan0, off;
            unsigned long long bh = (unsigned long long)(isctx ? hyuc : hyu), bf = (unsigned long long)(isctx ? fnbc : fnb), bv = (unsigned long long)(isctx ? vtc : vt);
            asm volatile("" : "+s"(bh), "+s"(bf), "+s"(bv));
            unsigned long long bsel = bv;
            if (pn < 3) { bsel = bh; chan0 = b * 768 + pn * 256; stride = (unsigned)L; off = 0; }
            else if (pn < 5) { bsel = bf; chan0 = b * 256; stride = (unsigned)(2 * L); off = (pn - 3) * L; }
            else { chan0 = b * 512 + (pn - 9) * 256; stride = (unsigned)L; off = 0; }
            asm volatile("" : "+s"(bsel));
            bf16_t* base = (bf16_t*)bsel;
            const unsigned eoff = (unsigned)(chan0 + wc * 32 + 4 * fq) * stride + (unsigned)(posbase + wr * 64 + fr + off);
#pragma unroll
            for (int bj = 0; bj < 2; ++bj)
#pragma unroll
                for (int n = 0; n < 2; ++n)
#pragma unroll
                    for (int e = 0; e < 4; ++e) { unsigned eo = eoff + (unsigned)(bj * 128 + n * 16 + e) * stride; asm volatile("" : "+v"(eo)); bf16_t* cp = base + eo;
#pragma unroll
                        for (int ai = 0; ai < 2; ++ai)
#pragma unroll
                            for (int m = 0; m < 4; m += 2) { const unsigned pk = cvt_pk_bf16(acc[ai][bj][m][n][e], acc[ai][bj][m + 1][n][e]); cp[ai * 128 + m * 16] = (bf16_t)(pk & 0xffffu); cp[ai * 128 + (m + 1) * 16] = (bf16_t)(pk >> 16); } }
        }
    }
};
template <bool RES_F32> struct EpiResT {
    static constexpr bool PERM = false, AFTER_DRAIN = false;
    const float *res_main, *res_ctx; bf16_t* xb; const float* gate;
    __device__ __forceinline__ void operator()(const f32x4 (&acc)[2][2][4][2], const Unit& u, int wr, int wc, int fr, int fq) const {
        const bool isctx = u.pm >= 64; const int bi = isctx ? 4 : (u.pm >> 4);
        const float* res = isctx ? res_ctx + (size_t)(u.pm - 64) * 256 * 1024 : res_main + (size_t)u.pm * 256 * 1024;
        bf16_t* dst = xb + (size_t)u.pm * 256 * 1024;
        const int col0 = u.pn * 256 + wc * 64 + 16 * fq; const float* gp = gate + bi * 6144 + col0;
        f32x4 gv[2][2];
#pragma unroll
        for (int bj = 0; bj < 2; ++bj)
#pragma unroll
            for (int n = 0; n < 2; ++n) gv[bj][n] = *(const f32x4*)(gp + bj * 8 + n * 4);
#pragma unroll
        for (int ai = 0; ai < 2; ++ai)
#pragma unroll
            for (int m = 0; m < 4; ++m) { const size_t ro = (size_t)(ai * 128 + wr * 64 + m * 16 + fr) * 1024 + col0;
#pragma unroll
                for (int bj = 0; bj < 2; ++bj) { f32x4 r0, r1;
                    if (RES_F32) { r0 = *(const f32x4*)(res + ro + bj * 8); r1 = *(const f32x4*)(res + ro + bj * 8 + 4); }
                    else { const u32x4 q = *(const u32x4*)(dst + ro + bj * 8);
                        r0[0] = __uint_as_float(q.x << 16); r0[1] = __uint_as_float(q.x & 0xffff0000u); r0[2] = __uint_as_float(q.y << 16); r0[3] = __uint_as_float(q.y & 0xffff0000u);
                        r1[0] = __uint_as_float(q.z << 16); r1[1] = __uint_as_float(q.z & 0xffff0000u); r1[2] = __uint_as_float(q.w << 16); r1[3] = __uint_as_float(q.w & 0xffff0000u); }
                    const f32x4 x0 = r0 + gv[bj][0] * acc[ai][bj][m][0], x1 = r1 + gv[bj][1] * acc[ai][bj][m][1];
                    u32x4 o; o.x = cvt_pk_bf16(x0[0], x0[1]); o.y = cvt_pk_bf16(x0[2], x0[3]); o.z = cvt_pk_bf16(x1[0], x1[1]); o.w = cvt_pk_bf16(x1[2], x1[3]); *(u32x4*)(dst + ro + bj * 8) = o; } }
    }
};
struct EpiGU {
    static constexpr bool PERM = false, AFTER_DRAIN = false;
    bf16_t* act;
    __device__ __forceinline__ void operator()(const f32x4 (&acc)[2][2][4][2], const Unit& u, int wr, int wc, int fr, int fq) const {
        const int row0 = u.pm * 256 + wr * 64 + fr, col0 = u.pn * 128 + wc * 32 + 8 * fq;
#pragma unroll
        for (int ai = 0; ai < 2; ++ai)
#pragma unroll
            for (int m = 0; m < 4; ++m) { bf16_t* rowp = act + (size_t)(row0 + ai * 128 + m * 16) * DFF + col0;
                float v[8];
#pragma unroll
                for (int n = 0; n < 2; ++n)
#pragma unroll
                    for (int e = 0; e < 4; ++e) v[n * 4 + e] = silu_f(acc[ai][0][m][n][e]) * acc[ai][1][m][n][e];
                u32x4 w; w.x = cvt_pk_bf16(v[0], v[1]); w.y = cvt_pk_bf16(v[2], v[3]); w.z = cvt_pk_bf16(v[4], v[5]); w.w = cvt_pk_bf16(v[6], v[7]);
                *(u32x4*)rowp = w; }
    }
};
struct EpiFn {
    static constexpr bool PERM = false, AFTER_DRAIN = false;
    bf16_t* mix; int rowbase, Lr;
    __device__ __forceinline__ void operator()(const f32x4 (&acc)[2][2][4][2], const Unit& u, int wr, int wc, int fr, int fq) const {
        const int row0 = rowbase + u.pn * Lr + u.pm * 256 + wr * 64 + fr, col0 = 256 + wc * 32 + 4 * fq;
#pragma unroll
        for (int ai = 0; ai < 2; ++ai)
#pragma unroll
            for (int m = 0; m < 4; ++m) { bf16_t* rowp = mix + (size_t)(row0 + ai * 128 + m * 16) * 1024 + col0;
#pragma unroll
                for (int bj = 0; bj < 2; ++bj)
#pragma unroll
                    for (int n = 0; n < 2; ++n) { const f32x4 v = acc[ai][bj][m][n]; u32x2 w; w.x = cvt_pk_bf16(v[0], v[1]); w.y = cvt_pk_bf16(v[2], v[3]); *(u32x2*)(rowp + bj * 128 + n * 16) = w; } }
    }
};

template <class Epi> __device__ __forceinline__ void run_gemm(int wid_s, unsigned char* smem, const bf16_t* A, const bf16_t* Bt, int M, int N, int K, const Epi& E) {
    pg8::Gemm g; g.A = A; g.Bt = Bt; g.M = M; g.N = N; g.K = K; g.wid_s = wid_s; g.ld = K;
    pg8::StaticOrder S; S.init(M, N, (int)gridDim.x, (int)blockIdx.x);
    pg8::gemm_phase<Epi, pg8::StaticOrder, false>((PG8_LAS unsigned char*)smem, g, S, E, nullptr);
}

struct EpiCtxAtomic {
    static constexpr bool PERM = false, AFTER_DRAIN = false;
    float* dst; const float* gate;
    __device__ __forceinline__ void operator()(const f32x4 (&acc)[2][2][4][2], const Unit& u, int wr, int wc, int fr, int fq) const {
        const int col0 = u.pn * 256 + wc * 32 + 4 * fq; float* d0 = dst + (size_t)u.pm * 256 * 1024;
        f32x4 gv[2][2];
#pragma unroll
        for (int bj = 0; bj < 2; ++bj)
#pragma unroll
            for (int n = 0; n < 2; ++n) gv[bj][n] = *(const f32x4*)(gate + col0 + bj * 128 + n * 16);
#pragma unroll
        for (int ai = 0; ai < 2; ++ai)
#pragma unroll
            for (int m = 0; m < 4; ++m) { float* rp = d0 + (size_t)(ai * 128 + wr * 64 + m * 16 + fr) * 1024 + col0;
#pragma unroll
                for (int bj = 0; bj < 2; ++bj)
#pragma unroll
                    for (int n = 0; n < 2; ++n) { const f32x4 v = gv[bj][n] * acc[ai][bj][m][n];
#pragma unroll
                        for (int e = 0; e < 4; ++e) __hip_atomic_fetch_add(rp + bj * 128 + n * 16 + e, v[e], __ATOMIC_RELAXED, __HIP_MEMORY_SCOPE_AGENT); } }
    }
};
template <class Epi> __device__ __forceinline__ void run_gemm_splitk(int wid_s, unsigned char* smem, const bf16_t* A, const bf16_t* Bt, int M, int N, int Kfull, int Kchunk, const Epi& E) {
    pg8::Gemm g; g.A = A; g.Bt = Bt; g.M = M; g.N = N; g.K = Kchunk; g.wid_s = wid_s; g.ld = Kfull;
    pg8::SplitOrder S; S.init(M, N, Kfull / Kchunk, (int)gridDim.x, (int)blockIdx.x);
    pg8::gemm_phase<Epi, pg8::SplitOrder, false>((PG8_LAS unsigned char*)smem, g, S, E, nullptr);
}

#ifdef PROBE_SEL
#define PREP_MARK(k) do { if (MODE == 0 && blockIdx.x == 5 && my_tid(wid_s) == 0) __hip_atomic_store(p.BAR + 96 + (k), (unsigned)__builtin_amdgcn_s_memrealtime(), __ATOMIC_RELAXED, __HIP_MEMORY_SCOPE_AGENT); } while (0)
#else
#define PREP_MARK(k) do {} while (0)
#endif
template <int MODE> __device__ void prep_phase(const Params& p, int wid_s, unsigned char* smem) {
    int tid_ = my_tid(wid_s); const int tid = tid_, lane = tid & 63, w = tid >> 6;
    float* tab = (float*)smem;
    float* tab64 = (float*)(smem + 16384);
    float* sv = (float*)(smem + 20480);
    float* red = (float*)(smem + 40960);
    const int bidx = MODE == 0 ? (int)blockIdx.x : (int)blockIdx.x - 16, nb = MODE == 0 ? (int)gridDim.x : (int)gridDim.x - 16;
    if (bidx < 0) return;
    for (int i = tid; i < 4096; i += 512) tab[i] = cospif((float)i * (1.0f / 2048.0f));
    if (tid < 64) tab64[tid] = cospif((float)tid * (1.0f / 32.0f));
    for (int i = tid; i < 5120; i += 512) { const int v = i >> 10, k = i & 1023; const float xv = v < 4 ? p.c[v * 1024 + k] : p.c_ctx[k]; sv[i] = xv / (1.0f + expf(-xv)); }
    __syncthreads();
    PREP_MARK(40);
    if (MODE != 1) {
        const int nl = lane, kg = w, lw = MODE == 0 ? 0 : 1;
#define WT_DESC(r, sp, ld, dst) do { \
            if ((r) < 704) { const int nt = (r) >> 4, kt = (r) & 15, n = nt * 64 + nl, k0 = kt * 64 + kg * 8; const int np = (n >= 1280 && n < 2304) ? ((n & ~31) + pg8::perm32(n & 31)) : n; const int src = np < 768 ? np : np - 256; \
                ld = 2560; sp = p.w_in + (size_t)lw * 1024 * 2560 + (size_t)k0 * 2560 + src; dst = p.WIN + (size_t)lw * NPROJ * 1024 + (size_t)n * 1024 + k0; } \
            else if ((r) < 960) { const int rr = (r) - 704, nt = rr >> 4, kt = rr & 15, n = nt * 64 + nl, k0 = kt * 64 + kg * 8; \
                ld = 1024; sp = p.w_out + (size_t)lw * 1024 * 1024 + (size_t)k0 * 1024 + ((n & ~255) + perm256(n & 255)); dst = p.WOUT + (size_t)lw * 1024 * 1024 + (size_t)n * 1024 + k0; } \
            else if ((r) < 2368) { const int rr = (r) - 960, nt = rr >> 4, kt = rr & 15, n = nt * 64 + nl, k0 = kt * 64 + kg * 8; \
                const int pn = n >> 8, lc = n & 255, bj = lc >> 7, wc = (lc >> 5) & 3, nn = (lc >> 4) & 1, fq = (lc >> 2) & 3, e4 = lc & 3; \
                const int j = 128 * pn + 32 * wc + 8 * fq + 4 * nn + e4; \
                ld = DFF; sp = (bj ? p.w_up : p.w_gate) + (size_t)lw * 1024 * DFF + (size_t)k0 * DFF + j; dst = p.WGU + (size_t)lw * 5632 * 1024 + (size_t)n * 1024 + k0; } \
            else { const int rr = (r) - 2368, nt = rr / 44, kt = rr % 44, n = nt * 64 + nl, k0 = kt * 64 + kg * 8; \
                ld = 1024; sp = p.w_down + (size_t)lw * DFF * 1024 + (size_t)k0 * 1024 + ((n & ~255) + perm256(n & 255)); dst = p.WDN + (size_t)lw * 1024 * DFF + (size_t)n * DFF + k0; } } while (0)
        for (int r0 = bidx; r0 < 3072; r0 += 4 * nb) {
            const float* sp[4]; int ld[4]; bf16_t* dd[4]; bool ok[4]; float v[4][8];
#pragma unroll
            for (int i = 0; i < 4; ++i) { const int r = r0 + i * nb; ok[i] = r < 3072 && !(r >= 192 && r < 320); sp[i] = p.w_out; ld[i] = 0; dd[i] = nullptr;
                if (r < 3072) WT_DESC(r, sp[i], ld[i], dd[i]); }
#pragma unroll
            for (int i = 0; i < 4; ++i)
#pragma unroll
                for (int e = 0; e < 8; ++e) v[i][e] = ok[i] ? sp[i][(size_t)e * ld[i]] : 0.f;
#pragma unroll
            for (int i = 0; i < 4; ++i) if (ok[i]) { u32x4 o; o.x = cvt_pk_bf16(v[i][0], v[i][1]); o.y = cvt_pk_bf16(v[i][2], v[i][3]); o.z = cvt_pk_bf16(v[i][4], v[i][5]); o.w = cvt_pk_bf16(v[i][6], v[i][7]); *(u32x4*)dd[i] = o; }
        }
#undef WT_DESC
        for (int ft = (MODE == 0 ? bidx - 128 : bidx); ft >= 0 && ft < 128; ft += nb) {
            const int r = 192 + ft, nt = r >> 4, kt = r & 15, n = nt * 64 + nl, k0 = kt * 64 + kg * 8; const float* W = p.w_in + (size_t)lw * 1024 * 2560;
            int cp = n - 768; const bool isq = cp >= 256; cp &= 255; const int g = cp >> 6, j = cp & 63;
            float v[8];
#pragma unroll
            for (int e = 0; e < 8; ++e) v[e] = 0.f;
#pragma unroll 8
            for (int m = 0; m < 64; ++m) { int idx = (j * m) & 63; if (isq) idx = (idx - 16) & 63; const float tv = tab64[idx];
#pragma unroll
                for (int e = 0; e < 8; ++e) v[e] += W[(size_t)(k0 + e) * 2560 + 768 + g * 64 + m] * tv; }
            u32x4 o; o.x = cvt_pk_bf16(v[0], v[1]); o.y = cvt_pk_bf16(v[2], v[3]); o.z = cvt_pk_bf16(v[4], v[5]); o.w = cvt_pk_bf16(v[6], v[7]);
            *(u32x4*)(p.WIN + (size_t)lw * NPROJ * 1024 + (size_t)n * 1024 + k0) = o;
        }
    }
    __syncthreads(); PREP_MARK(41);
    if (MODE == 0) for (int i = blockIdx.x * 512 + tid; i < 2048; i += gridDim.x * 512) p.NRM[i] = 0.f;
    if (MODE != 2) for (int task = (MODE == 0 ? 0 : 96) + bidx; task < (MODE == 0 ? 96 : 192); task += nb) {
        const int l = task / 96, n = (task % 96) * 64 + lane;
        float a0 = 0.f, a1 = 0.f, a2 = 0.f, a3 = 0.f, a4 = 0.f;
        const float* W = p.w_mod + (size_t)l * 1024 * 6144 + n;
#pragma unroll 16
        for (int kk = 0; kk < 128; ++kk) { const int k = w * 128 + kk; const float wv = W[(size_t)k * 6144];
            a0 += sv[k] * wv; a1 += sv[1024 + k] * wv; a2 += sv[2048 + k] * wv; a3 += sv[3072 + k] * wv; a4 += sv[4096 + k] * wv; }
        red[(w * 5 + 0) * 64 + lane] = a0; red[(w * 5 + 1) * 64 + lane] = a1; red[(w * 5 + 2) * 64 + lane] = a2; red[(w * 5 + 3) * 64 + lane] = a3; red[(w * 5 + 4) * 64 + lane] = a4;
        __syncthreads();
        if (w < 5) { float s = p.b_mod[l * 6144 + n]; for (int ww = 0; ww < 8; ++ww) s += red[(ww * 5 + w) * 64 + lane]; p.MOD[(size_t)(l * 5 + w) * 6144 + n] = s; }
        __syncthreads();
    }
    __syncthreads(); PREP_MARK(42);
    if (MODE == 0) {
        const int gw = blockIdx.x * 8 + w, nw = gridDim.x * 8;
        for (int pid = gw; pid < 8448; pid += nw) {
            int l, t, L; float* outp;
            if (pid < 8192) { l = pid >> 12; t = pid & 4095; L = 4096; outp = p.H2F + (size_t)pid * 64; } else { l = 0; t = pid - 8192; L = 256; outp = p.H2C + (size_t)t * 64; }
            const float tt = (float)t / (float)(L - 1), wa = 6.283185307179586f * (float)t / (float)L;
            const float* w1 = p.filt_w1 + l * 33 * 64; const float* w2 = p.filt_w2 + l * 64 * 64;
            float a = p.filt_b1[l * 64 + lane] + tt * w1[lane];
            for (int bnd = 0; bnd < 16; ++bnd) { const float f = 1e-4f + (float)bnd * ((15.0f - 1e-4f) / 15.0f); const float rev2 = f * ((float)(2 * t) / (float)L);
                a += cospif(rev2) * w1[(1 + bnd) * 64 + lane] - sinpif(rev2) * w1[(17 + bnd) * 64 + lane]; }
            const float h1 = sinf(p.filt_freq[l * 128 + lane] * a);
            float a2 = p.filt_b2[l * 64 + lane];
            for (int i = 0; i < 64; ++i) a2 += __int_as_float(__builtin_amdgcn_ds_bpermute(i << 2, __float_as_int(h1))) * w2[i * 64 + lane];
            outp[lane] = sinf(p.filt_freq[l * 128 + 64 + lane] * a2);
        }
    }
    __syncthreads(); PREP_MARK(43);
    if (MODE == 0) {
        const size_t gt = (size_t)blockIdx.x * 512 + tid, gs = (size_t)gridDim.x * 512;
        for (size_t idx = gt; idx < (size_t)128 * 128; idx += gs) {
            const int m = (int)(idx >> 7), k = (int)(idx & 127), ri = m >> 6, k1 = m & 63, pq = k >> 6, n1 = k & 63, ii = (k1 * n1) & 63;
            const float c = tab64[ii], sn = tab64[(ii - 16) & 63];
            p.FM1[idx] = f2bf(ri == 0 ? (pq == 0 ? c : -sn) : (pq == 0 ? -sn : -c));
        }
        for (size_t idx = gt; idx < (size_t)64 * 128; idx += gs) {
            const int k2 = (int)(idx >> 7), k = (int)(idx & 127), ri = k >> 6, n2 = k & 63, ii = (k2 * n2) & 63;
            p.FM2[idx] = f2bf((ri == 0 ? tab64[ii] : tab64[(ii - 16) & 63]) * (1.0f / 512.0f));
        }
        for (size_t idx = gt; idx < (size_t)256 * 64; idx += gs) {
            const int k = (int)(idx >> 6), kk0 = (int)(idx & 63) * 8; float v[8];
#pragma unroll
            for (int e = 0; e < 8; ++e) { const int kk = kk0 + e, n = kk & 255, ii = ((k * n) & 255) * 16; v[e] = (kk < 256 ? tab[ii] : -tab[(ii - 1024) & 4095]) * (1.0f / 128.0f); }
            u32x4 o; o.x = cvt_pk_bf16(v[0], v[1]); o.y = cvt_pk_bf16(v[2], v[3]); o.z = cvt_pk_bf16(v[4], v[5]); o.w = cvt_pk_bf16(v[6], v[7]);
            *(u32x4*)(p.DFTC + idx * 8) = o;
        }
    }
}

__device__ __forceinline__ void split_bf16x8(const f32x4 a, const f32x4 b, bf16x8& hi, bf16x8& lo) {
    union { u32x4 u; bf16x8 v; } ph, pl;
    ph.u.x = cvt_pk_bf16(a[0], a[1]); ph.u.y = cvt_pk_bf16(a[2], a[3]); ph.u.z = cvt_pk_bf16(b[0], b[1]); ph.u.w = cvt_pk_bf16(b[2], b[3]);
    pl.u.x = cvt_pk_bf16(a[0] - __uint_as_float(ph.u.x << 16), a[1] - __uint_as_float(ph.u.x & 0xffff0000u));
    pl.u.y = cvt_pk_bf16(a[2] - __uint_as_float(ph.u.y << 16), a[3] - __uint_as_float(ph.u.y & 0xffff0000u));
    pl.u.z = cvt_pk_bf16(b[0] - __uint_as_float(ph.u.z << 16), b[1] - __uint_as_float(ph.u.z & 0xffff0000u));
    pl.u.w = cvt_pk_bf16(b[2] - __uint_as_float(ph.u.w << 16), b[3] - __uint_as_float(ph.u.w & 0xffff0000u));
    hi = ph.v; lo = pl.v;
}
__device__ void taps_phase(const Params& p, int wid_s, int l, int bstart) {
    if ((int)blockIdx.x < bstart) return;
    int tid_ = my_tid(wid_s); const int tid = tid_, lane = tid & 63, w = tid >> 6, n = lane & 15, g = lane >> 4;
    const float min_decay = -4.605170185988091f / 1.5f, max_decay = -4.605170185988091f / 0.3f;
    for (int wt = ((int)blockIdx.x - bstart) * 8 + w; wt < 2048; wt += ((int)gridDim.x - bstart) * 8) {
        const int ct = wt >> 5, tq = wt & 31;
        const int col = ct * 16 + n, c = col & 255, dir = (col >> 8) & 1, o = col >> 9;
        bf16x8 Bh[2], Bl[2];
#pragma unroll
        for (int ks = 0; ks < 2; ++ks) { f32x4 x0, x1; const float* wp = p.filt_w3 + (size_t)(l * 64 + 32 * ks + 8 * g) * 1024 + col;
#pragma unroll
            for (int e = 0; e < 4; ++e) { x0[e] = wp[(size_t)e * 1024]; x1[e] = wp[(size_t)(4 + e) * 1024]; }
            split_bf16x8(x0, x1, Bh[ks], Bl[ks]); }
        const float delta = fabsf(min_decay + (float)c * ((max_decay - min_decay) / 255.0f)), dl2 = -delta * (1.4426950408889634f / 4095.0f);
        bf16_t* outp = p.TAPS + ((size_t)((l * 2 + o) * 256 + c)) * 8192 + dir * 4096;
        float asum = 0.f;
        for (int tt = 0; tt < 8; ++tt) {
            const int tb = tq * 128 + tt * 16;
            const float* hp = p.H2F + ((size_t)l * 4096 + tb + n) * 64 + 8 * g;
            f32x4 acc = {0.f, 0.f, 0.f, 0.f};
#pragma unroll
            for (int ks = 0; ks < 2; ++ks) { const f32x4 a0 = *(const f32x4*)(hp + 32 * ks), a1 = *(const f32x4*)(hp + 32 * ks + 4); bf16x8 Ah, Al; split_bf16x8(a0, a1, Ah, Al);
                acc = __builtin_amdgcn_mfma_f32_16x16x32_bf16(Ah, Bh[ks], acc, 0, 0, 0); acc = __builtin_amdgcn_mfma_f32_16x16x32_bf16(Al, Bh[ks], acc, 0, 0, 0); acc = __builtin_amdgcn_mfma_f32_16x16x32_bf16(Ah, Bl[ks], acc, 0, 0, 0); }
            float v[4];
#pragma unroll
            for (int e = 0; e < 4; ++e) { const int t = tb + 4 * g + e; v[e] = acc[e] * __builtin_amdgcn_exp2f((float)t * dl2); if (!(dir == 1 && t == 0)) asum += fabsf(v[e]); }
            u32x2 pk; pk.x = cvt_pk_bf16(v[0], v[1]); pk.y = cvt_pk_bf16(v[2], v[3]);
            *(u32x2*)(outp + tb + 4 * g) = pk;
        }
        asum += shx(asum, 16, lane); asum += shx(asum, 32, lane);
        if (g == 0) __hip_atomic_fetch_add(p.NRM + l * 1024 + col, asum, __ATOMIC_RELAXED, __HIP_MEMORY_SCOPE_AGENT);
    }
}

__device__ void norm_phase(const Params& p, int wid_s, int l, int which, int Mrows, bool from_input) {
    int tid_ = my_tid(wid_s); const int tid = tid_, lane = tid & 63, w = tid >> 6;
    const float* gam = (which ? p.norm2_g : p.norm1_g) + l * 1024;
    const int moff = which ? 3072 : 0;
    for (int row0 = (blockIdx.x * 8 + w) * 4; row0 < Mrows; row0 += gridDim.x * 32) {
        f32x4 v[4][4];
#pragma unroll
        for (int rr = 0; rr < 4; ++rr) { const int row = row0 + rr; const bool isctx = row >= MMAIN;
            if (from_input) { const float* src = isctx ? p.ctx + (size_t)(row - MMAIN) * 1024 : p.x + (size_t)row * 1024;
#pragma unroll
                for (int i = 0; i < 4; ++i) v[rr][i] = *(const f32x4*)(src + i * 256 + lane * 4);
            } else { const bf16_t* src = p.XB + (size_t)row * 1024;
#pragma unroll
                for (int i = 0; i < 4; ++i) { const u32x2 q = *(const u32x2*)(src + i * 256 + lane * 4); v[rr][i][0] = __uint_as_float(q.x << 16); v[rr][i][1] = __uint_as_float(q.x & 0xffff0000u); v[rr][i][2] = __uint_as_float(q.y << 16); v[rr][i][3] = __uint_as_float(q.y & 0xffff0000u); } } }
#pragma unroll
        for (int rr = 0; rr < 4; ++rr) { const int row = row0 + rr; const bool isctx = row >= MMAIN; const int bi = isctx ? 4 : (row >> 12);
            float ss = 0.f;
#pragma unroll
            for (int i = 0; i < 4; ++i) ss += v[rr][i][0] * v[rr][i][0] + v[rr][i][1] * v[rr][i][1] + v[rr][i][2] * v[rr][i][2] + v[rr][i][3] * v[rr][i][3];
#pragma unroll
            for (int o = 32; o >= 1; o >>= 1) ss += shx(ss, o, lane);
            const float rstd = rsqrtf(ss * (1.0f / 1024.0f) + 1e-6f);
            const float* mod = p.MOD + (size_t)(l * 5 + bi) * 6144 + moff;
#pragma unroll
            for (int i = 0; i < 4; ++i) { const int col = i * 256 + lane * 4;
                const f32x4 g = *(const f32x4*)(gam + col), sh = *(const f32x4*)(mod + col), sc = *(const f32x4*)(mod + 1024 + col);
                f32x4 y = v[rr][i] * rstd * g * (sc + 1.0f) + sh;
                u32x2 o; o.x = cvt_pk_bf16(y[0], y[1]); o.y = cvt_pk_bf16(y[2], y[3]);
                *(u32x2*)(p.HB + (size_t)row * 1024 + col) = o; } }
    }
}
__device__ void final_norm(const Params& p, int wid_s) {
    int tid_ = my_tid(wid_s); const int tid = tid_, lane = tid & 63, w = tid >> 6;
    for (int row0 = (blockIdx.x * 8 + w) * 4; row0 < MMAIN; row0 += gridDim.x * 32) {
        f32x4 v[4][4];
#pragma unroll
        for (int rr = 0; rr < 4; ++rr)
#pragma unroll
            for (int i = 0; i < 4; ++i) { const u32x2 q = *(const u32x2*)(p.XB + (size_t)(row0 + rr) * 1024 + i * 256 + lane * 4); v[rr][i][0] = __uint_as_float(q.x << 16); v[rr][i][1] = __uint_as_float(q.x & 0xffff0000u); v[rr][i][2] = __uint_as_float(q.y << 16); v[rr][i][3] = __uint_as_float(q.y & 0xffff0000u); }
#pragma unroll
        for (int rr = 0; rr < 4; ++rr) { const int row = row0 + rr; float* src = p.out + (size_t)row * 1024; float ss = 0.f;
#pragma unroll
            for (int i = 0; i < 4; ++i) ss += v[rr][i][0] * v[rr][i][0] + v[rr][i][1] * v[rr][i][1] + v[rr][i][2] * v[rr][i][2] + v[rr][i][3] * v[rr][i][3];
#pragma unroll
            for (int o = 32; o >= 1; o >>= 1) ss += shx(ss, o, lane);
            const float rstd = rsqrtf(ss * (1.0f / 1024.0f) + 1e-6f);
#pragma unroll
            for (int i = 0; i < 4; ++i) { const int col = i * 256 + lane * 4; const f32x4 g = *(const f32x4*)(p.final_g + col); *(f32x4*)(src + col) = v[rr][i] * rstd * g; }
#ifdef PROBE_SEL
            if (row == 0 && lane == 0) { const unsigned ta = __hip_atomic_load(p.BAR + 96 + PROBE_A, __ATOMIC_RELAXED, __HIP_MEMORY_SCOPE_AGENT), tb = __hip_atomic_load(p.BAR + 96 + PROBE_SEL, __ATOMIC_RELAXED, __HIP_MEMORY_SCOPE_AGENT); src[0] += (float)(tb - ta) * 1e-4f * PROBE_SCALE; }
#endif
        }
    }
}

__device__ __forceinline__ float short_conv_at(const bf16_t* base, int t, int L, float w0, float w1, float w2, float bb) {
    const float um = t > 0 ? bf2f(base[t - 1]) : 0.f, u0 = bf2f(base[t]), up = t < L - 1 ? bf2f(base[t + 1]) : 0.f;
    return um * w0 + u0 * w1 + up * w2 + bb;
}
template <int L> __device__ void hyena_naive(const Params& p, int wid_s, int l, int c, unsigned char* smem) {
    constexpr bool ISCTX = (L == CTXL); constexpr int NI = (L + 511) / 512;
    int tid_ = my_tid(wid_s); const int tid = tid_, lane = tid & 63, w = tid >> 6;
    float* Kf = (float*)smem;
    float* Uf = (float*)(smem + 32768);
    float* red = (float*)(smem + 32768 + 65536);
    const bf16_t* hy = ISCTX ? p.HYUC : p.HYU;
    const float* H2 = ISCTX ? p.H2C : p.H2F + (size_t)l * 4096 * 64;
    const float* cw = p.hy_conv_w + l * 3 * 768; const float* cb = p.hy_conv_b + l * 768;
    const float min_decay = -4.605170185988091f / 1.5f, max_decay = -4.605170185988091f / 0.3f;
    const float delta = fabsf(min_decay + (float)c * ((max_decay - min_decay) / 255.0f));
    const int rowbase = ISCTX ? MMAIN : 0;
    for (int o = 0; o < 2; ++o) {
        float part = 0.f;
        const float* w3 = p.filt_w3 + (size_t)l * 64 * 1024 + o * 512 + c;
        for (int t = tid; t < L; t += 512) {
            const f32x4* hr = (const f32x4*)(H2 + (size_t)t * 64); float kf = 0.f, kb = 0.f;
#pragma unroll
            for (int j4 = 0; j4 < 16; ++j4) { const f32x4 hv = hr[j4];
#pragma unroll
                for (int jj = 0; jj < 4; ++jj) { kf += hv[jj] * w3[(4 * j4 + jj) * 1024]; kb += hv[jj] * w3[(4 * j4 + jj) * 1024 + 256]; } }
            const float dec = expf(-((float)t / (float)(L - 1)) * delta); kf *= dec; kb *= dec;
            Kf[L + t] = kf; part += fabsf(kf);
            if (t >= 1) { Kf[L - t] = kb; part += fabsf(kb); } else Kf[0] = 0.f;
        }
#pragma unroll
        for (int s = 32; s >= 1; s >>= 1) part += shx(part, s, lane);
        if (lane == 0) red[w] = part;
        if (o == 0) {
            const int ch = 512 + c; const float w0 = cw[ch], w1 = cw[768 + ch], w2 = cw[1536 + ch], bb = cb[ch];
            for (int idx = tid; idx < 4 * L; idx += 512) { const int b = idx / L, s = idx % L; Uf[s * 4 + b] = short_conv_at(hy + (size_t)(b * 768 + ch) * L, s, L, w0, w1, w2, bb); }
        }
        __syncthreads();
        float nrm = 0.f;
#pragma unroll
        for (int i = 0; i < 8; ++i) nrm += red[i];
        const float inv = 1.0f / nrm;
        float acc[NI][4];
#pragma unroll
        for (int i = 0; i < NI; ++i) { acc[i][0] = 0.f; acc[i][1] = 0.f; acc[i][2] = 0.f; acc[i][3] = 0.f; }
        if (tid < L) {
            const float* kp = Kf + L + tid;
#pragma unroll 8
            for (int s = 0; s < L; ++s) { const f32x4 u4 = *(const f32x4*)(Uf + s * 4);
#pragma unroll
                for (int i = 0; i < NI; ++i) { const float kv = kp[i * 512 - s]; acc[i][0] += kv * u4[0]; acc[i][1] += kv * u4[1]; acc[i][2] += kv * u4[2]; acc[i][3] += kv * u4[3]; } }
        }
        __syncthreads();
        if (tid < L) {
            const float sk = p.hy_skip[(l * 2 + o) * 256 + c];
            const int ch = o == 0 ? c : 256 + c; const float w0 = cw[ch], w1 = cw[768 + ch], w2 = cw[1536 + ch], bb = cb[ch];
#pragma unroll
            for (int i = 0; i < NI; ++i) { const int t = tid + i * 512;
#pragma unroll
                for (int b = 0; b < 4; ++b) { const float y = acc[i][b] * inv + sk * Uf[t * 4 + b];
                    const float xg = short_conv_at(hy + (size_t)(b * 768 + ch) * L, t, L, w0, w1, w2, bb);
                    if (o == 0) Uf[t * 4 + b] = xg * y; else p.HB[(size_t)(rowbase + b * L + t) * 1024 + c] = f2bf(xg * y); } }
        }
        __syncthreads();
    }
}


constexpr int HK_COPY = 8256, HK_OFF = 4128, HU_BLK = 136, HU_SB = 5280, HK_BYTES = 4 * HK_COPY * 2  , HU_BYTES = 4 * HU_SB * 2  ;
__device__ __forceinline__ int hy_swz(int idx) { return idx ^ ((((idx >> 9) & 3) << 2) | (((idx >> 7) & 1) << 4)); }
__device__ __forceinline__ int hu_idx(int b, int t) { return b * HU_SB + ((t >> 7) + 3) * HU_BLK + (t & 127); }

__device__ __forceinline__ void hyena_conv_mfma(const bf16_t* KC, const bf16_t* UU, float* Yf, int lane, int w) {
    const int qh = w & 1, ks = w >> 1, n = lane & 15, g = lane >> 4;
    f32x4 acc[8][4];
#pragma unroll
    for (int a = 0; a < 8; ++a)
#pragma unroll
        for (int qq = 0; qq < 4; ++qq) acc[a][qq] = (f32x4){0.f, 0.f, 0.f, 0.f};
    const int abase = HK_OFF + 32 * ks + 8 * g - 8 * n;
    const int bbase = (n & 3) * HU_SB + ((n >> 2) + 3) * HU_BLK + 32 * ks + 8 * g;
    for (int D = 16 * qh - 31; D <= 16 * qh + 15; ++D) {
        bf16x8 A[8];
#pragma unroll
        for (int a = 0; a < 8; ++a) { const bf16_t* ap = KC + (a & 3) * HK_COPY + abase - 128 * D - (a & 4);
            if (a < 4) A[a] = *(const bf16x8*)ap;
            else { union { u32x2 h[2]; bf16x8 v; } t; t.h[0] = *(const u32x2*)ap; t.h[1] = *(const u32x2*)(ap + 4); A[a] = t.v; } }
        bf16x8 B[4];
#pragma unroll
        for (int qq = 0; qq < 4; ++qq) B[qq] = *(const bf16x8*)(UU + bbase + min(max(4 * (4 * qh + qq) - D, -3), 31) * HU_BLK);
#pragma unroll
        for (int qq = 0; qq < 4; ++qq) { const int q = 4 * qh + qq;
            if (D >= 4 * q - 31 && D <= 4 * q + 3) {
#pragma unroll
                for (int a = 0; a < 8; ++a) acc[a][qq] = __builtin_amdgcn_mfma_f32_16x16x32_bf16(A[a], B[qq], acc[a][qq], 0, 0, 0);
            } }
    }
    __syncthreads();
    const int Il = n >> 2, b = n & 3;
    const int L3 = Il | ((g & 1) << 2), lbase = 8192 * qh + 512 * Il + 128 * g + b;
    int xa[8];
#pragma unroll
    for (int a = 0; a < 8; ++a) xa[a] = lbase + ((a ^ L3) << 2);
    for (int r = 0; r < 4; ++r) {
        if (ks == r) {
#pragma unroll
            for (int a = 0; a < 8; ++a) { float* yp = Yf + xa[a];
#pragma unroll
                for (int qq = 0; qq < 4; ++qq)
#pragma unroll
                    for (int e = 0; e < 4; ++e) { if (r == 0) yp[2048 * qq + 32 * e] = acc[a][qq][e]; else yp[2048 * qq + 32 * e] += acc[a][qq][e]; } }
        }
        __syncthreads();
    }
}

#ifdef PROBE_SEL
#define PROBE_MARK(k) do { if (l == 0 && c == 0 && my_tid(wid_s) == 0) { __hip_atomic_store(p.BAR + 96 + (k), (unsigned)__builtin_amdgcn_s_memrealtime(), __ATOMIC_RELAXED, __HIP_MEMORY_SCOPE_AGENT); } } while (0)
#else
#define PROBE_MARK(k) do {} while (0)
#endif
__device__ __forceinline__ void short_conv8(const bf16_t* base, int t0, int L, float w0, float w1, float w2, float bb, float (&o)[8]) {
    const u32x4 v = *(const u32x4*)(base + t0);
    const float um = t0 > 0 ? bf2f(base[t0 - 1]) : 0.f, up = t0 + 8 < L ? bf2f(base[t0 + 8]) : 0.f;
    float x[10]; x[0] = um; x[9] = up;
#pragma unroll
    for (int e = 0; e < 4; ++e) { x[1 + 2 * e] = __uint_as_float(v[e] << 16); x[2 + 2 * e] = __uint_as_float(v[e] & 0xffff0000u); }
#pragma unroll
    for (int e = 0; e < 8; ++e) o[e] = x[e] * w0 + x[e + 1] * w1 + x[e + 2] * w2 + bb;
}

__device__ void hyena_mfma(const Params& p, int wid_s, int l, int c, unsigned char* smem) {
    int tid_ = my_tid(wid_s); const int tid = tid_, lane = tid & 63, w = tid >> 6;
    bf16_t* KC = (bf16_t*)smem; bf16_t* UU = (bf16_t*)(smem + HK_BYTES); float* Yf = (float*)smem; float* red = (float*)(smem + HK_BYTES + HU_BYTES);
    constexpr int L = SEQL;
    const bf16_t* hy = p.HYU; const float* H2 = p.H2F + (size_t)l * 4096 * 64;
    const float* cw = p.hy_conv_w + l * 3 * 768; const float* cb = p.hy_conv_b + l * 768;
    const float min_decay = -4.605170185988091f / 1.5f, max_decay = -4.605170185988091f / 0.3f;
    const float delta = fabsf(min_decay + (float)c * ((max_decay - min_decay) / 255.0f));
    u32x4 zero4 = (u32x4){0u, 0u, 0u, 0u}; asm volatile("" : "+v"(zero4));
    PROBE_MARK(0);
    for (int i = tid; i < (HK_BYTES + HU_BYTES) / 16; i += 512) ((u32x4*)smem)[i] = zero4;
    __syncthreads();
#define HY_COPIES(ord) do { const bf16_t* tp = p.TAPS + ((size_t)((l * 2 + (ord)) * 256 + c)) * 8192; \
        for (int i = tid; i < 1024; i += 512) { const u32x4 v = *(const u32x4*)(tp + i * 8); const int dir = i >> 9, tq = (i & 511) * 8; \
            _Pragma("unroll") for (int e = 0; e < 8; ++e) { const bf16_t val = (bf16_t)((e & 1) ? (v[e >> 1] >> 16) : (v[e >> 1] & 0xffffu)); const int t = tq + e; \
                if (dir == 0) { _Pragma("unroll") for (int s4 = 0; s4 < 4; ++s4) KC[s4 * HK_COPY + HK_OFF + s4 - t] = val; } \
                else if (t >= 1) { _Pragma("unroll") for (int s4 = 0; s4 < 4; ++s4) KC[s4 * HK_COPY + HK_OFF + s4 + t] = val; } } } } while (0)
    HY_COPIES(0);
    { int t0 = tid * 8; asm volatile("" : "+v"(t0));
      const int ch = 512 + c; const float w0 = cw[ch], w1 = cw[768 + ch], w2 = cw[1536 + ch], bb = cb[ch];
#pragma unroll
      for (int b = 0; b < 4; ++b) { float o[8]; short_conv8(hy + (size_t)(b * 768 + ch) * L, t0, L, w0, w1, w2, bb, o);
          u32x4 pk; pk.x = cvt_pk_bf16(o[0], o[1]); pk.y = cvt_pk_bf16(o[2], o[3]); pk.z = cvt_pk_bf16(o[4], o[5]); pk.w = cvt_pk_bf16(o[6], o[7]);
          *(u32x4*)(UU + hu_idx(b, t0)) = pk; } }
    __syncthreads();
    const float inv1 = 1.0f / (p.NRM[l * 1024 + c] + p.NRM[l * 1024 + 256 + c]), inv2 = 1.0f / (p.NRM[l * 1024 + 512 + c] + p.NRM[l * 1024 + 768 + c]);
    PROBE_MARK(1);
    hyena_conv_mfma(KC, UU, Yf, lane, w);
    PROBE_MARK(2);
    { int t0 = tid * 8; asm volatile("" : "+v"(t0));
      const float sk = p.hy_skip[(l * 2 + 0) * 256 + c]; const int ch = c; const float w0 = cw[ch], w1 = cw[768 + ch], w2 = cw[1536 + ch], bb = cb[ch];
#pragma unroll
      for (int b = 0; b < 4; ++b) { float xg[8]; short_conv8(hy + (size_t)(b * 768 + ch) * L, t0, L, w0, w1, w2, bb, xg);
          float yv[8];
#pragma unroll
          for (int e = 0; e < 8; ++e) yv[e] = Yf[hy_swz((t0 + e) * 4) + b];
          const u32x4 uq = *(const u32x4*)(UU + hu_idx(b, t0)); float uf[8];
#pragma unroll
          for (int e = 0; e < 4; ++e) { uf[2 * e] = __uint_as_float(uq[e] << 16); uf[2 * e + 1] = __uint_as_float(uq[e] & 0xffff0000u); }
          float z[8];
#pragma unroll
          for (int e = 0; e < 8; ++e) z[e] = xg[e] * (yv[e] * inv1 + sk * uf[e]);
          u32x4 pk; pk.x = cvt_pk_bf16(z[0], z[1]); pk.y = cvt_pk_bf16(z[2], z[3]); pk.z = cvt_pk_bf16(z[4], z[5]); pk.w = cvt_pk_bf16(z[6], z[7]);
          *(u32x4*)(UU + hu_idx(b, t0)) = pk; } }
    __syncthreads();
    PROBE_MARK(3);
    for (int i = tid; i < HK_BYTES / 16; i += 512) ((u32x4*)smem)[i] = zero4;
    __syncthreads();
    HY_COPIES(1);
#undef HY_COPIES
    __syncthreads();
    PROBE_MARK(4);
    hyena_conv_mfma(KC, UU, Yf, lane, w);
    PROBE_MARK(5);
    { int t0 = tid * 8; asm volatile("" : "+v"(t0));
      const float sk = p.hy_skip[(l * 2 + 1) * 256 + c]; const int ch = 256 + c; const float w0 = cw[ch], w1 = cw[768 + ch], w2 = cw[1536 + ch], bb = cb[ch];
#pragma unroll
      for (int b = 0; b < 4; ++b) { float xg[8]; short_conv8(hy + (size_t)(b * 768 + ch) * L, t0, L, w0, w1, w2, bb, xg);
          float yv[8];
#pragma unroll
          for (int e = 0; e < 8; ++e) yv[e] = Yf[hy_swz((t0 + e) * 4) + b];
          const u32x4 uq = *(const u32x4*)(UU + hu_idx(b, t0)); float uf[8];
#pragma unroll
          for (int e = 0; e < 4; ++e) { uf[2 * e] = __uint_as_float(uq[e] << 16); uf[2 * e + 1] = __uint_as_float(uq[e] & 0xffff0000u); }
#pragma unroll
          for (int e = 0; e < 8; ++e) p.HB[(size_t)(b * L + t0 + e) * 1024 + c] = f2bf(xg[e] * (yv[e] * inv2 + sk * uf[e])); } }
    __syncthreads();
    PROBE_MARK(6);
}


constexpr int FN_PITCH = 136, FN_BUF = 256 * FN_PITCH * 2  ;
__device__ void fnet_task(const Params& p, int wid_s, int task, unsigned char* smem) {
    int tid_ = my_tid(wid_s); const int tid = tid_, lane = tid & 63, w = tid >> 6, n = lane & 15, g = lane >> 4;
    const int b = task >> 6, cg = task & 63;
    const int l = 0, c = (task == 50) ? 0 : 1; PROBE_MARK(30);
    bf16_t* In = (bf16_t*)smem; bf16_t* Tb = (bf16_t*)(smem + FN_BUF); bf16_t* Yb = (bf16_t*)smem;
    {
        const bf16_t* src = p.FNB + (size_t)(b * 256 + 4 * cg) * 8192;
#pragma unroll
        for (int i = 0; i < 8; ++i) { const int ch = tid + 512 * i;
            const int cl = ch >> 10, pq = (ch >> 9) & 1, n1 = (ch >> 3) & 63, n20 = (ch & 7) * 8;
            const u32x4 v = *(const u32x4*)(src + (size_t)cl * 8192 + pq * 4096 + n1 * 64 + n20);
            bf16_t* dst = In + (cl * 64 + n20) * FN_PITCH + pq * 64 + n1;
#pragma unroll
            for (int e = 0; e < 4; ++e) { dst[(2 * e) * FN_PITCH] = (bf16_t)(v[e] & 0xffffu); dst[(2 * e + 1) * FN_PITCH] = (bf16_t)(v[e] >> 16); } }
    }
    __syncthreads();
    {
        f32x4 acc[8][2];
#pragma unroll
        for (int mt = 0; mt < 8; ++mt) { acc[mt][0] = (f32x4){0.f, 0.f, 0.f, 0.f}; acc[mt][1] = (f32x4){0.f, 0.f, 0.f, 0.f}; }
        bf16x8 Af[2][8];
#pragma unroll
        for (int mt = 0; mt < 8; ++mt) Af[0][mt] = *(const bf16x8*)(p.FM1 + (16 * mt + n) * 128 + 8 * g);
#pragma unroll
        for (int ks = 0; ks < 4; ++ks) {
            bf16x8 Bf[2];
#pragma unroll
            for (int j = 0; j < 2; ++j) Bf[j] = *(const bf16x8*)(In + (16 * (2 * w + j) + n) * FN_PITCH + 32 * ks + 8 * g);
            if (ks < 3) {
#pragma unroll
                for (int mt = 0; mt < 8; ++mt) Af[(ks + 1) & 1][mt] = *(const bf16x8*)(p.FM1 + (16 * mt + n) * 128 + 32 * (ks + 1) + 8 * g); }
#pragma unroll
            for (int mt = 0; mt < 8; ++mt) {
                acc[mt][0] = __builtin_amdgcn_mfma_f32_16x16x32_bf16(Af[ks & 1][mt], Bf[0], acc[mt][0], 0, 0, 0); acc[mt][1] = __builtin_amdgcn_mfma_f32_16x16x32_bf16(Af[ks & 1][mt], Bf[1], acc[mt][1], 0, 0, 0); }
        }
#pragma unroll
        for (int j = 0; j < 2; ++j) { const int nn = 16 * (2 * w + j) + n, cl = nn >> 6, n2 = nn & 63;
#pragma unroll
            for (int kt = 0; kt < 4; ++kt)
#pragma unroll
                for (int e = 0; e < 4; ++e) { const int k1 = 16 * kt + 4 * g + e; const float ph = (float)(k1 * n2) * (1.0f / 4096.0f);
                    const float cph = __builtin_amdgcn_cosf(ph), sph = __builtin_amdgcn_sinf(ph);
                    const float tr = acc[kt][j][e], ti = acc[kt + 4][j][e];
                    bf16_t* dst = Tb + (cl * 64 + k1) * FN_PITCH + n2;
                    dst[0] = f2bf(cph * tr + sph * ti); dst[64] = f2bf(cph * ti - sph * tr); } }
    }
    __syncthreads();
    {
        f32x4 acc[4][2];
#pragma unroll
        for (int mt = 0; mt < 4; ++mt) { acc[mt][0] = (f32x4){0.f, 0.f, 0.f, 0.f}; acc[mt][1] = (f32x4){0.f, 0.f, 0.f, 0.f}; }
        bf16x8 Af[4][4];
#pragma unroll
        for (int ks = 0; ks < 4; ++ks)
#pragma unroll
            for (int mt = 0; mt < 4; ++mt) Af[ks][mt] = *(const bf16x8*)(p.FM2 + (16 * mt + n) * 128 + 32 * ks + 8 * g);
#pragma unroll
        for (int ks = 0; ks < 4; ++ks) {
            bf16x8 Bf[2];
#pragma unroll
            for (int j = 0; j < 2; ++j) Bf[j] = *(const bf16x8*)(Tb + (16 * (2 * w + j) + n) * FN_PITCH + 32 * ks + 8 * g);
#pragma unroll
            for (int mt = 0; mt < 4; ++mt) {
                acc[mt][0] = __builtin_amdgcn_mfma_f32_16x16x32_bf16(Af[ks][mt], Bf[0], acc[mt][0], 0, 0, 0); acc[mt][1] = __builtin_amdgcn_mfma_f32_16x16x32_bf16(Af[ks][mt], Bf[1], acc[mt][1], 0, 0, 0); }
        }
#pragma unroll
        for (int j = 0; j < 2; ++j) { const int nn = 16 * (2 * w + j) + n, cl = nn >> 6, k1 = nn & 63;
#pragma unroll
            for (int mt = 0; mt < 4; ++mt)
#pragma unroll
                for (int e = 0; e < 4; ++e) { const int k2 = 16 * mt + 4 * g + e; Yb[(k1 + 64 * k2) * 4 + cl] = f2bf(acc[mt][j][e]); } }
    }
    __syncthreads();
#pragma unroll
    for (int i = 0; i < 8; ++i) { const int k = tid + 512 * i; *(u32x2*)(p.HB + (size_t)(b * SEQL + k) * 1024 + 256 + 4 * cg) = *(const u32x2*)(Yb + k * 4); }
    __syncthreads();
    PROBE_MARK(31);
}

template <bool LOCAL> __device__ void attn_wave(const Params& p, int wid_s, int l, int b, int r, int h, int qt, const float* rpbl  ) {
    int tid_ = my_tid(wid_s); const int lane = tid_ & 63, q = lane & 15, g = lane >> 4;
    const int qrow = LOCAL ? (b * SEQL + r * 64 + qt * 16 + q) : (MMAIN + b * CTXL + qt * 16 + q);
    constexpr int T0 = LOCAL ? 0 : 16;
    bf16x8 Qf[2];
#pragma unroll
    for (int ds = 0; ds < 2; ++ds) Qf[ds] = *(const bf16x8*)(p.QK + (size_t)qrow * 1024 + h * 64 + ds * 32 + 8 * g);
    const int c = (LOCAL && b == 1 && r == 11 && h == 4 && qt == 0) ? 0 : 1; PROBE_MARK(10);
    f32x4 S[32];
    const int c0 = qt == 0 ? 0 : (qt == 1 ? 8 : (qt == 2 ? 24 : 32));
    const int rs = min(max(r - 4, 0), 56);
    const int ki = 8 * (q >> 2) + (q & 3);
    const bf16_t* kloc = p.QK + (size_t)(b * SEQL + rs * 64 + c0 + ki) * 1024 + 512 + h * 64 + 8 * g;
    const bf16_t* kctx = p.QK + (size_t)(MMAIN + b * CTXL + ki) * 1024 + 512 + h * 64 + 8 * g;
#pragma unroll
    for (int tb = T0; tb < 32; tb += 8) {
        bf16x8 kf[8][2];
#pragma unroll
        for (int j = 0; j < 8; ++j) { const int T = tb + j, hh = T & 1;
            const bf16_t* kp = (T < 16) ? kloc + (size_t)((T >> 1) * 64 + 4 * hh) * 1024 : kctx + (size_t)(32 * ((T - 16) >> 1) + 4 * hh) * 1024;
            kf[j][0] = *(const bf16x8*)kp; kf[j][1] = *(const bf16x8*)(kp + 32); }
        __builtin_amdgcn_sched_barrier(0);
#pragma unroll
        for (int j = 0; j < 8; ++j) { f32x4 a = {0.f, 0.f, 0.f, 0.f};
            a = __builtin_amdgcn_mfma_f32_16x16x32_bf16(kf[j][0], Qf[0], a, 0, 0, 0); a = __builtin_amdgcn_mfma_f32_16x16x32_bf16(kf[j][1], Qf[1], a, 0, 0, 0); S[tb + j] = a; }
        __builtin_amdgcn_sched_barrier(0);
    }
    PROBE_MARK(11);
    float mx = -1e30f;
    if (LOCAL) {
        const int qc = qt * 16 + q, cs = min(max(qc - 8, 0), 48);
#pragma unroll
        for (int T = 0; T < 16; ++T) { const int kr = T >> 1, hh = T & 1; const int brow = (rs + kr - r + 7) * 31;
#pragma unroll
            for (int e = 0; e < 4; ++e) { const int kc = c0 + 8 * g + 4 * hh + e; const bool valid = (kc >= cs) && (kc < cs + 16);
                const int bidx = min(max(kc - qc + 15, 0), 30);
                const float sval = valid ? S[T][e] * 0.125f + rpbl[brow + bidx] : -1e30f; S[T][e] = sval; mx = fmaxf(mx, sval); } }
    }
#pragma unroll
    for (int T = 16; T < 32; ++T)
#pragma unroll
        for (int e = 0; e < 4; ++e) { const float sval = S[T][e] * 0.125f; S[T][e] = sval; mx = fmaxf(mx, sval); }
    mx = fmaxf(mx, shx(mx, 16, lane)); mx = fmaxf(mx, shx(mx, 32, lane));
    float sum = 0.f;
    bf16x8 Pf[16];
#pragma unroll
    for (int ch = T0 / 2; ch < 16; ++ch) {
        float pv[8];
#pragma unroll
        for (int e = 0; e < 4; ++e) { pv[e] = __expf(S[2 * ch][e] - mx); pv[4 + e] = __expf(S[2 * ch + 1][e] - mx); }
#pragma unroll
        for (int e = 0; e < 8; ++e) sum += pv[e];
        union { u32x4 u; bf16x8 v; } pf;
        pf.u.x = cvt_pk_bf16(pv[0], pv[1]); pf.u.y = cvt_pk_bf16(pv[2], pv[3]); pf.u.z = cvt_pk_bf16(pv[4], pv[5]); pf.u.w = cvt_pk_bf16(pv[6], pv[7]);
        Pf[ch] = pf.v;
    }
    sum += shx(sum, 16, lane); sum += shx(sum, 32, lane);
    const float inv = 1.0f / sum;
    PROBE_MARK(12);
    f32x4 O[4];
#pragma unroll
    for (int dt = 0; dt < 4; ++dt) O[dt] = (f32x4){0.f, 0.f, 0.f, 0.f};
    const bf16_t* vloc = p.VT + ((size_t)(b * 512 + h * 64 + q) * SEQL + rs * 64 + c0 + 8 * g);
    const bf16_t* vctx = p.VTC + ((size_t)(b * 512 + h * 64 + q) * CTXL + 8 * g);
#pragma unroll
    for (int cb = T0 / 2; cb < 16; cb += 4) {
        bf16x8 vf[4][4];
#pragma unroll
        for (int j = 0; j < 4; ++j)
#pragma unroll
            for (int dt = 0; dt < 4; ++dt) { const int ch = cb + j;
                const bf16_t* vp = (ch < 8) ? vloc + (size_t)(16 * dt) * SEQL + ch * 64 : vctx + (size_t)(16 * dt) * CTXL + 32 * (ch - 8);
                vf[j][dt] = *(const bf16x8*)vp; }
        __builtin_amdgcn_sched_barrier(0);
#pragma unroll
        for (int j = 0; j < 4; ++j)
#pragma unroll
            for (int dt = 0; dt < 4; ++dt) O[dt] = __builtin_amdgcn_mfma_f32_16x16x32_bf16(vf[j][dt], Pf[cb + j], O[dt], 0, 0, 0);
        __builtin_amdgcn_sched_barrier(0);
    }
#pragma unroll
    for (int dt = 0; dt < 4; ++dt) { u32x2 o; o.x = cvt_pk_bf16(O[dt][0] * inv, O[dt][1] * inv); o.y = cvt_pk_bf16(O[dt][2] * inv, O[dt][3] * inv);
        *(u32x2*)(p.HB + (size_t)qrow * 1024 + 512 + h * 64 + 16 * dt + 4 * g) = o; }
    PROBE_MARK(13);
}

__device__ __forceinline__ void attn_ld(const bf16_t* kp, const bf16_t* vp, size_t vstride, bf16x8 (&kf)[2][2], bf16x8 (&vf)[4]) {
#pragma unroll
    for (int hh = 0; hh < 2; ++hh)
#pragma unroll
        for (int ds = 0; ds < 2; ++ds) kf[hh][ds] = *(const bf16x8*)(kp + (size_t)hh * 4 * 1024 + ds * 32);
#pragma unroll
    for (int dt = 0; dt < 4; ++dt) vf[dt] = *(const bf16x8*)(vp + (size_t)dt * 16 * vstride);
}
__device__ void attn_wave4(const Params& p, int wid_s, int l, int b, int h, int qt, int rg, const float* rpbl) {
    int tid_ = my_tid(wid_s); const int lane = tid_ & 63, q = lane & 15, g = lane >> 4;
    const int r0 = rg * 4, c0 = qt == 0 ? 0 : (qt == 1 ? 8 : (qt == 2 ? 24 : 32)), qc = qt * 16 + q, cs = min(max(qc - 8, 0), 48);
    int rsj[4];
#pragma unroll
    for (int j = 0; j < 4; ++j) rsj[j] = min(max(r0 + j - 4, 0), 56);
    const int rs0 = rsj[0], nl = rsj[3] + 8 - rs0, nch = nl + 8;
    bf16x8 Qf[4][2];
#pragma unroll
    for (int j = 0; j < 4; ++j)
#pragma unroll
        for (int ds = 0; ds < 2; ++ds) Qf[j][ds] = *(const bf16x8*)(p.QK + (size_t)(b * SEQL + (r0 + j) * 64 + qt * 16 + q) * 1024 + h * 64 + ds * 32 + 8 * g);
    int bidx[8];
#pragma unroll
    for (int hh = 0; hh < 2; ++hh)
#pragma unroll
        for (int e = 0; e < 4; ++e) { const int kc = c0 + 8 * g + 4 * hh + e; bidx[hh * 4 + e] = (kc >= cs && kc < cs + 16) ? (kc - qc + 15) : 31; }
    const float SC = 0.125f * 1.4426950408889634f;
    float m[4], ls[4]; f32x4 O[4][4];
#pragma unroll
    for (int j = 0; j < 4; ++j) { m[j] = -1e30f; ls[j] = 0.f;
#pragma unroll
        for (int dt = 0; dt < 4; ++dt) O[j][dt] = (f32x4){0.f, 0.f, 0.f, 0.f}; }
    const int ki = 8 * (q >> 2) + (q & 3);
    const bf16_t* kloc = p.QK + (size_t)(b * SEQL + c0 + ki) * 1024 + 512 + h * 64 + 8 * g;
    const bf16_t* kctx = p.QK + (size_t)(MMAIN + b * CTXL + ki) * 1024 + 512 + h * 64 + 8 * g;
    const bf16_t* vloc = p.VT + ((size_t)(b * 512 + h * 64 + q) * SEQL + c0 + 8 * g);
    const bf16_t* vctx = p.VTC + ((size_t)(b * 512 + h * 64 + q) * CTXL + 8 * g);
    bf16x8 kf[2][2], vf[4], kfn[2][2], vfn[4];
    attn_ld(kloc + (size_t)rs0 * 64 * 1024, vloc + rs0 * 64, SEQL, kf, vf);
    for (int i = 0; i < nch; ++i) {
        const int i1 = i + 1;
        if (i1 < nch) { if (i1 < nl) attn_ld(kloc + (size_t)(rs0 + i1) * 64 * 1024, vloc + (rs0 + i1) * 64, SEQL, kfn, vfn);
                        else attn_ld(kctx + (size_t)(i1 - nl) * 32 * 1024, vctx + (i1 - nl) * 32, CTXL, kfn, vfn); }
        const bool isloc = i < nl; const int kr = rs0 + i;
#pragma unroll
        for (int j = 0; j < 4; ++j) {
            if (!isloc || (kr >= rsj[j] && kr < rsj[j] + 8)) {
                f32x4 s0 = {0.f, 0.f, 0.f, 0.f}, s1 = {0.f, 0.f, 0.f, 0.f};
                s0 = __builtin_amdgcn_mfma_f32_16x16x32_bf16(kf[0][0], Qf[j][0], s0, 0, 0, 0); s0 = __builtin_amdgcn_mfma_f32_16x16x32_bf16(kf[0][1], Qf[j][1], s0, 0, 0, 0);
                s1 = __builtin_amdgcn_mfma_f32_16x16x32_bf16(kf[1][0], Qf[j][0], s1, 0, 0, 0); s1 = __builtin_amdgcn_mfma_f32_16x16x32_bf16(kf[1][1], Qf[j][1], s1, 0, 0, 0);
                float sv[8];
                if (isloc) { const float* rb = rpbl + (kr - (r0 + j) + 7) * 32;
#pragma unroll
                    for (int e = 0; e < 4; ++e) { sv[e] = s0[e] * SC + rb[bidx[e]]; sv[4 + e] = s1[e] * SC + rb[bidx[4 + e]]; }
                } else {
#pragma unroll
                    for (int e = 0; e < 4; ++e) { sv[e] = s0[e] * SC; sv[4 + e] = s1[e] * SC; }
                }
                float cmax = fmaxf(fmaxf(fmaxf(sv[0], sv[1]), fmaxf(sv[2], sv[3])), fmaxf(fmaxf(sv[4], sv[5]), fmaxf(sv[6], sv[7])));
                cmax = fmaxf(cmax, shx(cmax, 16, lane)); cmax = fmaxf(cmax, shx(cmax, 32, lane));
                const float mn = fmaxf(m[j], cmax); const bool moved = __builtin_amdgcn_ballot_w64(mn > m[j]) != 0ull;
                float pv[8], psum = 0.f;
#pragma unroll
                for (int e = 0; e < 8; ++e) { pv[e] = __builtin_amdgcn_exp2f(sv[e] - mn); psum += pv[e]; }
                if (moved) { const float alpha = __builtin_amdgcn_exp2f(m[j] - mn); m[j] = mn; ls[j] *= alpha;
#pragma unroll
                    for (int dt = 0; dt < 4; ++dt) O[j][dt] *= alpha; }
                ls[j] += psum;
                union { u32x4 u; bf16x8 v; } pf;
                pf.u.x = cvt_pk_bf16(pv[0], pv[1]); pf.u.y = cvt_pk_bf16(pv[2], pv[3]); pf.u.z = cvt_pk_bf16(pv[4], pv[5]); pf.u.w = cvt_pk_bf16(pv[6], pv[7]);
#pragma unroll
                for (int dt = 0; dt < 4; ++dt) O[j][dt] = __builtin_amdgcn_mfma_f32_16x16x32_bf16(vf[dt], pf.v, O[j][dt], 0, 0, 0);
            }
        }
#pragma unroll
        for (int hh = 0; hh < 2; ++hh)
#pragma unroll
            for (int ds = 0; ds < 2; ++ds) kf[hh][ds] = kfn[hh][ds];
#pragma unroll
        for (int dt = 0; dt < 4; ++dt) vf[dt] = vfn[dt];
    }
#pragma unroll
    for (int j = 0; j < 4; ++j) { float lt = ls[j]; lt += shx(lt, 16, lane); lt += shx(lt, 32, lane); const float inv = 1.0f / lt;
        bf16_t* op = p.HB + (size_t)(b * SEQL + (r0 + j) * 64 + qt * 16 + q) * 1024 + 512 + h * 64 + 4 * g;
#pragma unroll
        for (int dt = 0; dt < 4; ++dt) { u32x2 o; o.x = cvt_pk_bf16(O[j][dt][0] * inv, O[j][dt][1] * inv); o.y = cvt_pk_bf16(O[j][dt][2] * inv, O[j][dt][3] * inv); *(u32x2*)(op + 16 * dt) = o; } }
}
__device__ void attn_block_main(const Params& p, int wid_s, int l, int bt, unsigned char* smem) {
    int tid_ = my_tid(wid_s); const int tid = tid_, w = tid >> 6;
    float* rp = (float*)smem;
    const int wt = bt * 8 + w, qt = wt & 3, rg = (wt >> 2) & 15, h = (wt >> 6) & 7, b = wt >> 9;
    { const int c = (bt == 100 && l == 0) ? 0 : 1; PROBE_MARK(8); }
    if (tid < 480) { const int rr = tid >> 5, cc = tid & 31; rp[tid] = cc < 31 ? p.na_rpb[(size_t)(l * 8 + h) * 465 + rr * 31 + cc] * 1.4426950408889634f : -1e30f; }
    __syncthreads();
    attn_wave4(p, wid_s, l, b, h, qt, rg, rp);
    __syncthreads(); { const int c = (bt == 100 && l == 0) ? 0 : 1; PROBE_MARK(9); }
}
__device__ void attn_block_ctx(const Params& p, int wid_s, int l, int bt, unsigned char* smem) {
    int tid_ = my_tid(wid_s); const int tid = tid_, w = tid >> 6;
    const int wt = bt * 8 + w, qt = wt & 15, h = (wt >> 4) & 7, b = wt >> 7;
    attn_wave<false>(p, wid_s, l, b, 0, h, qt, (const float*)smem);
}

__global__ __launch_bounds__(512, 2) void mega_kernel(Params p) {
    extern __shared__ __attribute__((aligned(16))) unsigned char smem[];
    if (p.BAR == nullptr) cg::this_grid().sync();
    const int wid_s = __builtin_amdgcn_readfirstlane((int)(threadIdx.x >> 6));
#ifndef NO_PREP
    if (threadIdx.x == 0) { *(volatile LAS unsigned*)(smem + LDS_CTL) = 0u; *(volatile LAS unsigned*)(smem + LDS_CTL + 4) = 0u; }
    __syncthreads();
    const XcdBarrier xb = xcd_barrier_post(p.BAR, (volatile LAS unsigned*)(smem + LDS_CTL));
#ifdef PROBE_SEL
#define PHASE_MARK(k) do { if (blockIdx.x == 0 && my_tid(wid_s) == 0) __hip_atomic_store(p.BAR + 96 + (k), (unsigned)__builtin_amdgcn_s_memrealtime(), __ATOMIC_RELAXED, __HIP_MEMORY_SCOPE_AGENT); } while (0)
#else
#define PHASE_MARK(k) do {} while (0)
#endif
    int phase_ctr = 16;
#define GSYNC() do { xcd_barrier(xb, wid_s); PHASE_MARK(phase_ctr); ++phase_ctr; } while (0)
    prep_phase<0>(p, wid_s, smem);
#endif
    xcd_barrier(xb, wid_s);
    PHASE_MARK(15);
#ifdef REP_SYNC
    for (int i = 0; i < 10; ++i) GSYNC();
#endif
    for (int l = 0; l < 2; ++l) {
        const int Mff = (l == 0) ? MALL : MMAIN;
        const float* modl = p.MOD + (size_t)l * 5 * 6144;
        norm_phase(p, wid_s, l, 0, MALL, l == 0);
        if (l == 0) taps_phase(p, wid_s, 0, 0);
#ifdef REP_NORM
        norm_phase(p, wid_s, l, 0, MALL, l == 0);
#endif
        GSYNC();
        { EpiIn E; E.hyu = p.HYU; E.hyuc = p.HYUC; E.fnb = p.FNB; E.fnbc = p.FNBC; E.qk = p.QK; E.vt = p.VT; E.vtc = p.VTC;
          run_gemm(wid_s, smem, p.HB, p.WIN + (size_t)l * NPROJ * 1024, MALL, NPROJ, 1024, E);
#ifdef REP_IN
          __syncthreads(); run_gemm(wid_s, smem, p.HB, p.WIN + (size_t)l * NPROJ * 1024, MALL, NPROJ, 1024, E);
#endif
 }
        GSYNC();
        if (l == 0) { EpiFn E; E.mix = p.HB; E.rowbase = MMAIN; E.Lr = CTXL; run_gemm(wid_s, smem, p.DFTC, p.FNBC, CTXL, 1024, 512, E); }
        {
            unsigned* qctr = p.BAR + 64 * l;
            const int ntot = (l == 0) ? 1088 : 768;
            for (;;) {
                __syncthreads();
                if (my_tid(wid_s) == 0) *(volatile LAS unsigned*)(smem + LDS_CTL + 8) = __hip_atomic_fetch_add(qctr, 1u, __ATOMIC_RELAXED, __HIP_MEMORY_SCOPE_AGENT);
                __syncthreads();
                const int task = __builtin_amdgcn_readfirstlane((int)*(volatile LAS unsigned*)(smem + LDS_CTL + 8));
                if (task >= ntot) break;
                if (task < 256) hyena_mfma(p, wid_s, l, task, smem);
                else if (task < 512) attn_block_main(p, wid_s, l, task - 256, smem);
                else if (task < 768) fnet_task(p, wid_s, task - 512, smem);
                else if (task < 1024) hyena_naive<CTXL>(p, wid_s, l, task - 768, smem);
                else attn_block_ctx(p, wid_s, l, task - 1024, smem);
            }
        }
        GSYNC();
        if (l == 0) { EpiResT<true> E; E.res_main = p.x; E.res_ctx = p.ctx; E.xb = p.XB; E.gate = modl + 2048;
          run_gemm(wid_s, smem, p.HB, p.WOUT + (size_t)l * 1024 * 1024, Mff, 1024, 1024, E); }
        else { EpiResT<false> E; E.res_main = nullptr; E.res_ctx = nullptr; E.xb = p.XB; E.gate = modl + 2048;
          run_gemm(wid_s, smem, p.HB, p.WOUT + (size_t)l * 1024 * 1024, Mff, 1024, 1024, E); }
        if (l == 0) taps_phase(p, wid_s, 1, 16);
        GSYNC();
        norm_phase(p, wid_s, l, 1, Mff, false);
        GSYNC();
        { EpiGU E; E.act = p.ACT; run_gemm(wid_s, smem, p.HB, p.WGU + (size_t)l * 5632 * 1024, Mff, 5632, 1024, E);
#ifdef REP_GU
          __syncthreads(); run_gemm(wid_s, smem, p.HB, p.WGU + (size_t)l * 5632 * 1024, Mff, 5632, 1024, E);
#endif
 }
        GSYNC();
        { EpiResT<false> E; E.res_main = nullptr; E.res_ctx = nullptr; E.xb = p.XB; E.gate = modl + 5120;
          run_gemm(wid_s, smem, p.ACT, p.WDN + (size_t)l * 1024 * DFF, Mff, 1024, DFF, E); }
        if (l == 0) { __syncthreads(); prep_phase<2>(p, wid_s, smem); __syncthreads(); prep_phase<1>(p, wid_s, smem); }
        GSYNC();
    }
    final_norm(p, wid_s);
}

extern "C" void kernel_launch(void* const* d_in, const int* in_sizes, int n_in, void* d_out, int out_size, void* d_ws, size_t ws_size, hipStream_t stream) {
    (void)in_sizes; (void)n_in; (void)out_size;
    static int grid_blocks = 0;
    if (!grid_blocks) {
        int dev = 0, cus = 0, per_cu = 0;
        hipGetDevice(&dev);
        hipDeviceGetAttribute(&cus, hipDeviceAttributeMultiprocessorCount, dev);
        hipFuncSetAttribute((const void*)mega_kernel, hipFuncAttributeMaxDynamicSharedMemorySize, LDS_BYTES);
        hipOccupancyMaxActiveBlocksPerMultiprocessor(&per_cu, mega_kernel, 512, LDS_BYTES);
        if (per_cu < 1) per_cu = 1;
        if (per_cu > 1) per_cu = 1;
        grid_blocks = cus * per_cu;
    }
    Params p{};
    const float* const* in = (const float* const*)d_in;
    p.x = in[0]; p.c = in[1]; p.ctx = in[2]; p.c_ctx = in[3]; p.w_mod = in[4]; p.b_mod = in[5]; p.norm1_g = in[6]; p.norm2_g = in[7]; p.w_in = in[8]; p.w_out = in[9];
    p.hy_conv_w = in[10]; p.hy_conv_b = in[11]; p.filt_w1 = in[12]; p.filt_b1 = in[13]; p.filt_freq = in[14]; p.filt_w2 = in[15]; p.filt_b2 = in[16]; p.filt_w3 = in[17];
    p.hy_skip = in[18]; p.na_rpb = in[19]; p.w_gate = in[20]; p.w_up = in[21]; p.w_down = in[22]; p.final_g = in[23];
    p.out = (float*)d_out;
    unsigned char* ws = (unsigned char*)d_ws; size_t off = 0;
    auto take = [&](size_t bytes) { unsigned char* r = ws + off; off += (bytes + 255) & ~(size_t)255; return r; };
    p.WIN = (bf16_t*)take((size_t)2 * NPROJ * 1024 * 2);
    p.WOUT = (bf16_t*)take((size_t)2 * 1024 * 1024 * 2);
    p.WGU = (bf16_t*)take((size_t)2 * 5632 * 1024 * 2);
    p.WDN = (bf16_t*)take((size_t)2 * 1024 * DFF * 2);
    p.DFT = nullptr;
    p.FM1 = (bf16_t*)take((size_t)128 * 128 * 2);
    p.FM2 = (bf16_t*)take((size_t)64 * 128 * 2);
    p.DFTC = (bf16_t*)take((size_t)256 * 512 * 2);
    p.MOD = (float*)take((size_t)2 * 5 * 6144 * 4);
    p.H2F = (float*)take((size_t)2 * 4096 * 64 * 4);
    p.H2C = (float*)take((size_t)256 * 64 * 4);
    p.XRC = nullptr;
    p.XB = (bf16_t*)take((size_t)MALL * 1024 * 2);
    p.HB = (bf16_t*)take((size_t)MALL * 1024 * 2);
    p.TAPS2 = nullptr;
    p.TAPS = (bf16_t*)take((size_t)2 * 2 * 256 * 8192 * 2);
    p.NRM = (float*)take((size_t)2048 * 4);
    p.BAR = (unsigned*)take((size_t)XCD_BAR_WORDS * 4);
    unsigned char* big = ws + off;
    p.ACT = (bf16_t*)big;
    size_t boff = 0;
    auto takeb = [&](size_t bytes) { unsigned char* r = big + boff; boff += (bytes + 255) & ~(size_t)255; return r; };
    p.HYU = (bf16_t*)takeb((size_t)NB * 768 * SEQL * 2);
    p.HYUC = (bf16_t*)takeb((size_t)NB * 768 * CTXL * 2);
    p.FNB = (bf16_t*)takeb((size_t)1024 * 8192 * 2);
    p.FNBC = (bf16_t*)takeb((size_t)1024 * 512 * 2);
    p.QK = (bf16_t*)takeb((size_t)MALL * 1024 * 2);
    p.VT = (bf16_t*)takeb((size_t)NB * 512 * SEQL * 2);
    p.VTC = (bf16_t*)takeb((size_t)NB * 512 * CTXL * 2);
    const size_t actb = (size_t)MALL * DFF * 2;
    const size_t need = off + (boff > actb ? boff : actb);
    if (need > ws_size) { fprintf(stderr, "workspace too small: need %zu have %zu\n", need, ws_size); return; }
    hipMemsetAsync(p.BAR, 0, (size_t)XCD_BAR_WORDS * 4, stream);
    void* args[] = {&p};
    hipError_t e = hipLaunchCooperativeKernel((const void*)mega_kernel, dim3(grid_blocks), dim3(512), args, LDS_BYTES, stream);
    if (e != hipSuccess) fprintf(stderr, "cooperative launch failed: %s (grid %d)\n", hipGetErrorString(e), grid_blocks);
}
```

```cpp
#include <hip/hip_runtime.h>
#include <hip/hip_cooperative_groups.h>
#include <cstdio>
namespace cg = cooperative_groups;
#include <cstdint>

#define XB_TMO      128
#define XB_XCNT(j)  (256  + 64 * (j))
#define XB_XSUB(j)  (1280 + 64 * (j))
#define XB_XGEN(j)  (2304 + 64 * (j))
#define XB_TOP      3328
#define XB_TOPGEN   3392
#define XCD_BAR_WORDS 3456
#define XB_SPIN_CAP (1u << 18)
#define LAS __attribute__((address_space(3)))

__device__ __forceinline__ unsigned xb_ld(unsigned* p)              { return __hip_atomic_load(p, __ATOMIC_RELAXED, __HIP_MEMORY_SCOPE_AGENT); }
__device__ __forceinline__ unsigned xb_add(unsigned* p, unsigned v) { return __hip_atomic_fetch_add(p, v, __ATOMIC_RELAXED, __HIP_MEMORY_SCOPE_AGENT); }
__device__ __forceinline__ unsigned xb_xcc_id() { return (unsigned)__builtin_amdgcn_s_getreg((3 << 11) | 20) & 0xFu; }
#define XB_SPIN(cond, bar) do { unsigned _sp = 0; while (cond) { __builtin_amdgcn_s_sleep(1); \
    if ((++_sp & 255u) == 0u) { if (xb_ld(&(bar)[XB_TMO])) break; if (_sp > XB_SPIN_CAP) { atomicAdd(&(bar)[XB_TMO], 1u); break; } } } } while (0)

struct XcdBarrier {
    unsigned* bar; unsigned x;
    volatile LAS unsigned* st;
};

__device__ __forceinline__ XcdBarrier xcd_barrier_post(unsigned* bar, volatile LAS unsigned* st) {
    XcdBarrier b; b.bar = bar; b.x = xb_xcc_id(); b.st = st;
    if (threadIdx.x == 0) (void)xb_add(&bar[XB_XCNT(b.x)], 1u);
    return b;
}
__device__ __forceinline__ void xcd_barrier_complete(unsigned* bar, unsigned x, unsigned& nloc, unsigned& nx) {
    const unsigned G = gridDim.x * gridDim.y * gridDim.z;
    unsigned sum, cnt, mine, sp = 0u;
    for (;;) {
        sum = 0u; cnt = 0u; mine = 0u;
#pragma unroll
        for (unsigned j = 0; j < 16; ++j) { const unsigned c = xb_ld(&bar[XB_XCNT(j)]); sum += c; cnt += (c > 0u) ? 1u : 0u; mine = (j == x) ? c : mine; }
        if (sum == G) break;
        __builtin_amdgcn_s_sleep(1);
        if ((++sp & 255u) == 0u) { if (xb_ld(&bar[XB_TMO])) break; if (sp > XB_SPIN_CAP) { atomicAdd(&bar[XB_TMO], 1u); break; } }
    }
    nloc = mine > 0u ? mine : 1u; nx = cnt > 0u ? cnt : 1u;
}
__device__ __forceinline__ void xcd_barrier(const XcdBarrier& b, int wid_s) {
    asm volatile("s_waitcnt vmcnt(0)" ::: "memory");
    __syncthreads();
    int ln; asm volatile("v_mbcnt_lo_u32_b32 %0, -1, 0\n\tv_mbcnt_hi_u32_b32 %0, -1, %0" : "=v"(ln));
    if (wid_s == 0 && ln == 0) {
        unsigned* bar = b.bar; unsigned bx = b.x; asm volatile("" : "+s"(bar), "+s"(bx));
        __builtin_amdgcn_s_waitcnt(0);
        unsigned nloc = b.st[0], nx = b.st[1];
        if (nloc == 0u) { xcd_barrier_complete(bar, bx, nloc, nx); b.st[0] = nloc; b.st[1] = nx; }
        const unsigned old = xb_add(&bar[XB_XSUB(bx)], 1u);
        const unsigned gen = old / nloc;
        if (old + 1u == (gen + 1u) * nloc) {
            __builtin_amdgcn_fence(__ATOMIC_RELEASE, "agent");
            asm volatile("s_waitcnt vmcnt(0)" ::: "memory");
            const unsigned og = xb_add(&bar[XB_TOP], 1u);
            const unsigned tg = og / nx;
            if (og + 1u == (tg + 1u) * nx) xb_add(&bar[XB_TOPGEN], 1u);
            else XB_SPIN(xb_ld(&bar[XB_TOPGEN]) == tg, bar);
            __builtin_amdgcn_fence(__ATOMIC_ACQUIRE, "agent");
            xb_add(&bar[XB_XGEN(bx)], 1u);
            asm volatile("s_waitcnt vmcnt(0)" ::: "memory");
        } else {
            XB_SPIN(xb_ld(&bar[XB_XGEN(bx)]) == gen, bar);
            __builtin_amdgcn_fence(__ATOMIC_ACQUIRE, "agent");
            asm volatile("s_waitcnt vmcnt(0)" ::: "memory");
        }
    }
    __syncthreads();
}
namespace pg8 {
#define PG8_LAS __attribute__((address_space(3)))
typedef unsigned short bf16_t;
typedef short bf16x8 __attribute__((ext_vector_type(8)));
typedef float f32x4 __attribute__((ext_vector_type(4)));
typedef unsigned u32x4 __attribute__((ext_vector_type(4)));
constexpr int BM = 256, BK = 64, HALF = 128, HTB = HALF * BK * 2  , STAGE_BYTES = 8 * HTB, NXCD = 8, WGM = 8;

__host__ __device__ __forceinline__ int lds_byte(int r, int c) { const int st = (r >> 4) * 2 + (c >> 5), rr = r & 15, cc = c & 31, ob = rr * 64 + cc * 2; return st * 1024 + (ob ^ (((ob >> 9) & 1) << 5)); }
__host__ __device__ __forceinline__ void stage_rc(int b, int& R, int& C) { const int st = b / 1024, sb = b % 1024, swz = sb ^ (((sb >> 9) & 1) << 5); R = (st >> 1) * 16 + swz / 64; C = (st & 1) * 32 + (swz % 64) / 2; }
__host__ __device__ __forceinline__ int perm32(int rho) { const int n = rho >> 4, i = rho & 15; return 8 * (i >> 2) + 4 * n + (i & 3); }

struct Unit { int pm, pn, pk; };
struct Gemm { const bf16_t* A; const bf16_t* Bt; int M, N, K, wid_s, ld; };

struct StaticOrder {
    int nM, nN, nwg, G, c;
    __host__ __device__ void init(int M, int N, int G_, int c_) { nM = M / BM; nN = N / BM; nwg = nM * nN; G = G_; c = c_; }
    __host__ __device__ bool next(int i, Unit& u) const {
        const long L = (long)i * G + c; if (L >= nwg) return false;
        int wgid = (int)L; { const int q = nwg / NXCD, r = nwg % NXCD, xcd = wgid % NXCD, off = wgid / NXCD; wgid = (xcd < r ? xcd * (q + 1) : r * (q + 1) + (xcd - r) * q) + off; }
        const int nig = WGM * nN, gid = wgid / nig, fm = gid * WGM, gsz = (nM - fm) < WGM ? (nM - fm) : WGM;
        u.pm = fm + ((wgid % nig) % gsz); u.pn = (wgid % nig) / gsz; u.pk = 0; return true;
    }
    __device__ __forceinline__ void a_ready(const Unit&) const {}
    __device__ __forceinline__ void done(const Unit&) const {}
};
struct SplitOrder {
    int nM, nN, nK, nwg, G, c;
    __host__ __device__ void init(int M, int N, int nK_, int G_, int c_) { nM = M / BM; nN = N / BM; nK = nK_; nwg = nM * nN * nK; G = G_; c = c_; }
    __host__ __device__ bool next(int i, Unit& u) const { const long L = (long)i * G + c; if (L >= nwg) return false; const int w = (int)L; u.pk = w % nK; const int r = w / nK; u.pn = r % nN; u.pm = r / nN; return true; }
    __device__ __forceinline__ void a_ready(const Unit&) const {}
    __device__ __forceinline__ void done(const Unit&) const {}
};
__device__ __forceinline__ unsigned cvt_pk_bf16(float lo, float hi) { unsigned r; asm volatile("v_cvt_pk_bf16_f32 %0, %1, %2" : "=v"(r) : "v"(lo), "v"(hi)); return r; }
typedef float f32x2 __attribute__((ext_vector_type(2)));
template <class Epi, class Sched, bool STAMP = false>
__device__ __forceinline__ void gemm_phase(PG8_LAS unsigned char* lds, const Gemm g, const Sched& S, const Epi& E, unsigned long long* stamps) {
    int ln_; asm volatile("v_mbcnt_lo_u32_b32 %0, -1, 0\n\tv_mbcnt_hi_u32_b32 %0, -1, %0" : "=v"(ln_)); int tid_ = g.wid_s * 64 + ln_; const int tid = tid_, wid = __builtin_amdgcn_readfirstlane(tid >> 6), lane = tid & 63, wr = wid >> 2, wc = wid & 3, fr = lane & 15, fq = lane >> 4;
    int K_ = g.K, LD_ = g.ld; asm volatile("" : "+s"(K_), "+s"(LD_)); const int K = K_, LD = LD_, nt = K / BK;
    int ts_lo = 0, ts_hi = 0, nts = 0; const unsigned long long rt_entry = STAMP ? (unsigned long long)wall_clock64() : 0ull;
#define PG8_STAMP() do { if (STAMP && wid == 0 && nts < 64) { const unsigned long long _c = (unsigned long long)clock64(); \
        ts_lo = (lane == nts) ? (int)(unsigned)_c : ts_lo; ts_hi = (lane == nts) ? (int)(unsigned)(_c >> 32) : ts_hi; ++nts; } } while (0)
    PG8_STAMP();
    unsigned voffA[2], voffB[2];
#pragma unroll
    for (int i = 0; i < 2; ++i) { int R, C; stage_rc(tid * 16 + i * 8192, R, C); const int Rb = Epi::PERM ? ((R & ~31) + perm32(R & 31)) : R;
        voffA[i] = (unsigned)(R * LD + C) * 2u; voffB[i] = (unsigned)(Rb * LD + C) * 2u; }
    const size_t kstep = (size_t)(BK * 2);
    const size_t hstep = (size_t)HALF * LD * 2;
    const size_t tstep = 2 * hstep;
    const unsigned ldsw = (unsigned)wid * 1024u;
    const int aoff = lds_byte(wr * 64 + fr, fq * 8), boff = lds_byte(wc * 32 + fr, fq * 8);
#define PG8_SA(b, h) (((b) * 2 + (h)) * HTB)
#define PG8_SB(b, h) ((4 + (b) * 2 + (h)) * HTB)
#define PG8_STAGE(bufoff, gbase, voff) do { _Pragma("unroll") for (int _i = 0; _i < 2; ++_i) \
        __builtin_amdgcn_global_load_lds((const unsigned*)((const char*)(gbase) + (voff)[_i]), (PG8_LAS unsigned*)(lds + (bufoff) + ldsw + _i * 8192), 16, 0, 0); } while (0)
#define PG8_LDA(dst, b, h) do { _Pragma("unroll") for (int m = 0; m < 4; ++m) _Pragma("unroll") for (int k = 0; k < 2; ++k) dst[m][k] = *(const PG8_LAS bf16x8*)(lds + PG8_SA(b, h) + aoff + m * 2048 + k * 1024); } while (0)
#define PG8_LDB(dst, b, h) do { _Pragma("unroll") for (int n = 0; n < 2; ++n) _Pragma("unroll") for (int k = 0; k < 2; ++k) dst[n][k] = *(const PG8_LAS bf16x8*)(lds + PG8_SB(b, h) + boff + n * 2048 + k * 1024); } while (0)
#define PG8_MMA(ai, bj, At, Bt) do { __builtin_amdgcn_s_setprio(1); _Pragma("unroll") for (int m = 0; m < 4; ++m) _Pragma("unroll") for (int n = 0; n < 2; ++n) _Pragma("unroll") for (int k = 0; k < 2; ++k) \
        acc[ai][bj][m][n] = __builtin_amdgcn_mfma_f32_16x16x32_bf16(Bt[n][k], At[m][k], acc[ai][bj][m][n], 0, 0, 0); __builtin_amdgcn_s_setprio(0); } while (0)
#define PG8_WAIT_V(n) asm volatile("s_waitcnt vmcnt(" #n ")" ::: "memory")
#define PG8_WAIT_L(n) asm volatile("s_waitcnt lgkmcnt(" #n ")" ::: "memory")
#define PG8_BAR __builtin_amdgcn_s_barrier()
#define PG8_SCHED __builtin_amdgcn_sched_barrier(0)
    Unit cur, nxt; int ui = 0;
    if (!S.next(0, cur)) return;
    f32x4 acc[2][2][4][2];
#pragma unroll
    for (int a = 0; a < 2; ++a)
#pragma unroll
        for (int b = 0; b < 2; ++b)
#pragma unroll
            for (int m = 0; m < 4; ++m)
#pragma unroll
                for (int n = 0; n < 2; ++n) acc[a][b][m][n] = (f32x4){0.f, 0.f, 0.f, 0.f};
    bf16x8 At[4][2], B0[2][2], B1[2][2];
    const size_t kchunk = (size_t)K * 2;
    const char* cA = (const char*)g.A + (size_t)cur.pm * tstep + (size_t)cur.pk * kchunk; const char* cB = (const char*)g.Bt + (size_t)cur.pn * tstep + (size_t)cur.pk * kchunk;
    S.a_ready(cur);
    PG8_STAGE(PG8_SB(0, 0), cB, voffB); PG8_STAGE(PG8_SA(0, 0), cA, voffA); PG8_STAGE(PG8_SB(0, 1), cB + hstep, voffB); PG8_STAGE(PG8_SA(0, 1), cA + hstep, voffA);
    if (wr == 1) PG8_BAR;
    PG8_WAIT_V(4); PG8_BAR;
    PG8_STAGE(PG8_SB(1, 0), cB + kstep, voffB); PG8_STAGE(PG8_SA(1, 0), cA + kstep, voffA); PG8_STAGE(PG8_SB(1, 1), cB + hstep + kstep, voffB);
    PG8_WAIT_V(6); PG8_BAR;
    PG8_STAMP();
    for (;;) {
        const bool has_next = S.next(ui + 1, nxt);
        const char* nA = has_next ? (const char*)g.A + (size_t)nxt.pm * tstep + (size_t)nxt.pk * kchunk : cA; const char* nB = has_next ? (const char*)g.Bt + (size_t)nxt.pn * tstep + (size_t)nxt.pk * kchunk : cB;
        for (int t = 0; t < nt; t += 2) {
            const bool last = (t == nt - 2);
            const char* a1 = cA + (size_t)(t + 1) * kstep;
            const char* a2 = last ? nA : cA + (size_t)(t + 2) * kstep; const char* b2 = last ? nB : cB + (size_t)(t + 2) * kstep;
            const char* a3 = a2 + kstep; const char* b3 = b2 + kstep;
            if (last && has_next) S.a_ready(nxt);
            PG8_LDB(B0, 0, 0); PG8_SCHED; PG8_LDA(At, 0, 0); PG8_STAGE(PG8_SA(1, 1), a1 + hstep, voffA);
            PG8_WAIT_L(8); PG8_BAR; PG8_WAIT_L(0); PG8_MMA(0, 0, At, B0); PG8_BAR; PG8_SCHED;
            PG8_LDB(B1, 0, 1); PG8_STAGE(PG8_SB(0, 0), b2, voffB);
            PG8_BAR; PG8_WAIT_L(0); PG8_MMA(0, 1, At, B1); PG8_BAR;
            PG8_LDA(At, 0, 1); PG8_STAGE(PG8_SA(0, 0), a2, voffA);
            PG8_BAR; PG8_WAIT_L(0); PG8_MMA(1, 0, At, B0); PG8_BAR; PG8_SCHED;
            PG8_STAGE(PG8_SB(0, 1), b2 + hstep, voffB);
            PG8_WAIT_V(6); PG8_BAR; PG8_MMA(1, 1, At, B1); PG8_BAR;
            PG8_LDB(B0, 1, 0); PG8_SCHED; PG8_LDA(At, 1, 0); PG8_STAGE(PG8_SA(0, 1), a2 + hstep, voffA);
            PG8_WAIT_L(8); PG8_BAR; PG8_WAIT_L(0); PG8_MMA(0, 0, At, B0); PG8_BAR; PG8_SCHED;
            PG8_LDB(B1, 1, 1); PG8_STAGE(PG8_SB(1, 0), b3, voffB);
            PG8_BAR; PG8_WAIT_L(0); PG8_MMA(0, 1, At, B1); PG8_BAR;
            PG8_LDA(At, 1, 1); PG8_STAGE(PG8_SA(1, 0), a3, voffA);
            PG8_BAR; PG8_WAIT_L(0); PG8_MMA(1, 0, At, B0); PG8_BAR; PG8_SCHED;
            PG8_STAGE(PG8_SB(1, 1), b3 + hstep, voffB);
            PG8_WAIT_V(6); PG8_BAR; PG8_MMA(1, 1, At, B1); PG8_BAR;
        }
        PG8_STAMP();
        if constexpr (!Epi::AFTER_DRAIN) { E(acc, cur, wr, wc, fr, fq); S.done(cur); }
        PG8_STAMP();
        if (!has_next) break;
#pragma unroll
        for (int a = 0; a < 2; ++a)
#pragma unroll
            for (int b = 0; b < 2; ++b)
#pragma unroll
                for (int m = 0; m < 4; ++m)
#pragma unroll
                    for (int n = 0; n < 2; ++n) acc[a][b][m][n] = (f32x4){0.f, 0.f, 0.f, 0.f};
        cur = nxt; cA = nA; cB = nB; ++ui;
    }
    PG8_WAIT_V(0);
    if (wr == 0) PG8_BAR;
    PG8_BAR;
    if constexpr (Epi::AFTER_DRAIN) { E.fused(acc, cur, wr, wc, fr, fq, lds, wid, lane); S.done(cur); }
    PG8_STAMP();
    if (STAMP && wid == 0) { stamps[lane] = lane < nts ? (((unsigned long long)(unsigned)ts_hi << 32) | (unsigned)ts_lo) : 0ull;
        if (lane == 62) stamps[62] = rt_entry; if (lane == 63) stamps[63] = (unsigned long long)wall_clock64(); }
#undef PG8_STAMP
#undef PG8_SA
#undef PG8_SB
#undef PG8_STAGE
#undef PG8_LDA
#undef PG8_LDB
#undef PG8_MMA
#undef PG8_WAIT_V
#undef PG8_WAIT_L
#undef PG8_BAR
#undef PG8_SCHED
}
}

using pg8::bf16_t; using pg8::bf16x8; using pg8::f32x4; using pg8::u32x4; using pg8::Unit; using pg8::cvt_pk_bf16;
typedef unsigned u32x2 __attribute__((ext_vector_type(2)));
#define LAS3 __attribute__((address_space(3)))

constexpr int DM = 1024, SEQL = 4096, NB = 4, CTXL = 256, DFF = 2816, NPROJ = 2816  ;
constexpr int MMAIN = NB * SEQL  , MCTX = NB * CTXL  , MALL = MMAIN + MCTX  ;
constexpr int LDS_CTL = 139264;
constexpr int LDS_BYTES = LDS_CTL + 16;

struct Params {
    const float *x, *c, *ctx, *c_ctx, *w_mod, *b_mod, *norm1_g, *norm2_g, *w_in, *w_out, *hy_conv_w, *hy_conv_b, *filt_w1, *filt_b1, *filt_freq, *filt_w2, *filt_b2, *filt_w3,
        *hy_skip, *na_rpb, *w_gate, *w_up, *w_down, *final_g;
    float* out;
    bf16_t *WIN, *WOUT, *WGU, *WDN;
    bf16_t *DFT, *DFTC;
    float *MOD, *H2F, *H2C, *XRC;
    bf16_t* XB;
    bf16_t *HB;
    bf16_t *HYU, *HYUC, *FNB, *FNBC, *QK, *VT, *VTC, *ACT, *TAPS2;
    unsigned* BAR;
    bf16_t *FM1, *FM2;
    bf16_t* TAPS;
    float* NRM;
};

__device__ __forceinline__ float shx(float v, int o, int lane) { return __int_as_float(__builtin_amdgcn_ds_bpermute((lane ^ o) << 2, __float_as_int(v))); }
__device__ __forceinline__ int my_tid(int wid_s) { int ln; asm volatile("v_mbcnt_lo_u32_b32 %0, -1, 0\n\tv_mbcnt_hi_u32_b32 %0, -1, %0" : "=v"(ln)); return wid_s * 64 + ln; }
__device__ __forceinline__ int perm256(int lc) { return 64 * ((lc >> 5) & 3) + 16 * ((lc >> 2) & 3) + 8 * (lc >> 7) + 4 * ((lc >> 4) & 1) + (lc & 3); }
__device__ __forceinline__ float silu_f(float x) { return x * __builtin_amdgcn_rcpf(1.0f + __builtin_amdgcn_exp2f(-1.4426950408889634f * x)); }
__device__ __forceinline__ bf16_t f2bf(float f) { unsigned u = __float_as_uint(f); u += 0x7FFFu + ((u >> 16) & 1u); return (bf16_t)(u >> 16); }
__device__ __forceinline__ float bf2f(bf16_t b) { return __uint_as_float(((unsigned)b) << 16); }

struct EpiIn {
    static constexpr bool PERM = false, AFTER_DRAIN = false;
    bf16_t *hyu, *hyuc, *fnb, *fnbc, *qk, *vt, *vtc;
    __device__ __forceinline__ void operator()(const f32x4 (&acc)[2][2][4][2], const Unit& u, int wr, int wc, int fr, int fq) const {
        const bool isctx = u.pm >= 64; const int L = isctx ? CTXL : SEQL;
        const int b = isctx ? (u.pm - 64) : (u.pm >> 4), posbase = isctx ? 0 : (u.pm & 15) * 256;
        const int pn = u.pn;
        if (pn >= 5 && pn < 9) {
            const int row0 = u.pm * 256 + wr * 64 + fr, col0 = (pn - 5) * 256 + wc * 32 + 8 * fq;
#pragma unroll
            for (int ai = 0; ai < 2; ++ai)
#pragma unroll
                for (int m = 0; m < 4; ++m) { bf16_t* rowp = qk + (size_t)(row0 + ai * 128 + m * 16) * 1024 + col0;
#pragma unroll
                    for (int bj = 0; bj < 2; ++bj) { const f32x4 v0 = acc[ai][bj][m][0], v1 = acc[ai][bj][m][1];
                        u32x4 w; w.x = cvt_pk_bf16(v0[0], v0[1]); w.y = cvt_pk_bf16(v0[2], v0[3]); w.z = cvt_pk_bf16(v1[0], v1[1]); w.w = cvt_pk_bf16(v1[2], v1[3]); *(u32x4*)(rowp + bj * 128) = w; } }
        } else {
            unsigned stride; int chan0, off;
            unsigned long long bh = (unsigned long long)(isctx ? hyuc : hyu), bf = (unsigned long long)(isctx ? fnbc : fnb), bv = (unsigned long long)(isctx ? vtc : vt);
            asm volatile("" : "+s"(bh), "+s"(bf), "+s"(bv));
            unsigned long long bsel = bv;
            if (pn < 3) { bsel = bh; chan0 = b * 768 + pn * 256; stride = (unsigned)L; off = 0; }
            else if (pn < 5) { bsel = bf; chan0 = b * 256; stride = (unsigned)(2 * L); off = (pn - 3) * L; }
            else { chan0 = b * 512 + (pn - 9) * 256; stride = (unsigned)L; off = 0; }
            asm volatile("" : "+s"(bsel));
            bf16_t* base = (bf16_t*)bsel;
            const unsigned eoff = (unsigned)(chan0 + wc * 32 + 4 * fq) * stride + (unsigned)(posbase + wr * 64 + fr + off);
#pragma unroll
            for (int bj = 0; bj < 2; ++bj)
#pragma unroll
                for (int n = 0; n < 2; ++n)
#pragma unroll
                    for (int e = 0; e < 4; ++e) { unsigned eo = eoff + (unsigned)(bj * 128 + n * 16 + e) * stride; asm volatile("" : "+v"(eo)); bf16_t* cp = base + eo;
#pragma unroll
                        for (int ai = 0; ai < 2; ++ai)
#pragma unroll
                            for (int m = 0; m < 4; m += 2) { const unsigned pk = cvt_pk_bf16(acc[ai][bj][m][n][e], acc[ai][bj][m + 1][n][e]); cp[ai * 128 + m * 16] = (bf16_t)(pk & 0xffffu); cp[ai * 128 + (m + 1) * 16] = (bf16_t)(pk >> 16); } }
        }
    }
};
template <bool RES_F32> struct EpiResT {
    static constexpr bool PERM = false, AFTER_DRAIN = false;
    const float *res_main, *res_ctx; bf16_t* xb; const float* gate;
    __device__ __forceinline__ void operator()(const f32x4 (&acc)[2][2][4][2], const Unit& u, int wr, int wc, int fr, int fq) const {
        const bool isctx = u.pm >= 64; const int bi = isctx ? 4 : (u.pm >> 4);
        const float* res = isctx ? res_ctx + (size_t)(u.pm - 64) * 256 * 1024 : res_main + (size_t)u.pm * 256 * 1024;
        bf16_t* dst = xb + (size_t)u.pm * 256 * 1024;
        const int col0 = u.pn * 256 + wc * 64 + 16 * fq; const float* gp = gate + bi * 6144 + col0;
        f32x4 gv[2][2];
#pragma unroll
        for (int bj = 0; bj < 2; ++bj)
#pragma unroll
            for (int n = 0; n < 2; ++n) gv[bj][n] = *(const f32x4*)(gp + bj * 8 + n * 4);
#pragma unroll
        for (int ai = 0; ai < 2; ++ai)
#pragma unroll
            for (int m = 0; m < 4; ++m) { const size_t ro = (size_t)(ai * 128 + wr * 64 + m * 16 + fr) * 1024 + col0;
#pragma unroll
                for (int bj = 0; bj < 2; ++bj) { f32x4 r0, r1;
                    if (RES_F32) { r0 = *(const f32x4*)(res + ro + bj * 8); r1 = *(const f32x4*)(res + ro + bj * 8 + 4); }
                    else { const u32x4 q = *(const u32x4*)(dst + ro + bj * 8);
                        r0[0] = __uint_as_float(q.x << 16); r0[1] = __uint_as_float(q.x & 0xffff0000u); r0[2] = __uint_as_float(q.y << 16); r0[3] = __uint_as_float(q.y & 0xffff0000u);
                        r1[0] = __uint_as_float(q.z << 16); r1[1] = __uint_as_float(q.z & 0xffff0000u); r1[2] = __uint_as_float(q.w << 16); r1[3] = __uint_as_float(q.w & 0xffff0000u); }
                    const f32x4 x0 = r0 + gv[bj][0] * acc[ai][bj][m][0], x1 = r1 + gv[bj][1] * acc[ai][bj][m][1];
                    u32x4 o; o.x = cvt_pk_bf16(x0[0], x0[1]); o.y = cvt_pk_bf16(x0[2], x0[3]); o.z = cvt_pk_bf16(x1[0], x1[1]); o.w = cvt_pk_bf16(x1[2], x1[3]); *(u32x4*)(dst + ro + bj * 8) = o; } }
    }
};
struct EpiGU {
    static constexpr bool PERM = false, AFTER_DRAIN = false;
    bf16_t* act;
    __device__ __forceinline__ void operator()(const f32x4 (&acc)[2][2][4][2], const Unit& u, int wr, int wc, int fr, int fq) const {
        const int row0 = u.pm * 256 + wr * 64 + fr, col0 = u.pn * 128 + wc * 32 + 8 * fq;
#pragma unroll
        for (int ai = 0; ai < 2; ++ai)
#pragma unroll
            for (int m = 0; m < 4; ++m) { bf16_t* rowp = act + (size_t)(row0 + ai * 128 + m * 16) * DFF + col0;
                float v[8];
#pragma unroll
                for (int n = 0; n < 2; ++n)
#pragma unroll
                    for (int e = 0; e < 4; ++e) v[n * 4 + e] = silu_f(acc[ai][0][m][n][e]) * acc[ai][1][m][n][e];
                u32x4 w; w.x = cvt_pk_bf16(v[0], v[1]); w.y = cvt_pk_bf16(v[2], v[3]); w.z = cvt_pk_bf16(v[4], v[5]); w.w = cvt_pk_bf16(v[6], v[7]);
                *(u32x4*)rowp = w; }
    }
};
struct EpiFn {
    static constexpr bool PERM = false, AFTER_DRAIN = false;
    bf16_t* mix; int rowbase, Lr;
    __device__ __forceinline__ void operator()(const f32x4 (&acc)[2][2][4][2], const Unit& u, int wr, int wc, int fr, int fq) const {
        const int row0 = rowbase + u.pn * Lr + u.pm * 256 + wr * 64 + fr, col0 = 256 + wc * 32 + 4 * fq;
#pragma unroll
        for (int ai = 0; ai < 2; ++ai)
#pragma unroll
            for (int m = 0; m < 4; ++m) { bf16_t* rowp = mix + (size_t)(row0 + ai * 128 + m * 16) * 1024 + col0;
#pragma unroll
                for (int bj = 0; bj < 2; ++bj)
#pragma unroll
                    for (int n = 0; n < 2; ++n) { const f32x4 v = acc[ai][bj][m][n]; u32x2 w; w.x = cvt_pk_bf16(v[0], v[1]); w.y = cvt_pk_bf16(v[2], v[3]); *(u32x2*)(rowp + bj * 128 + n * 16) = w; } }
    }
};

template <class Epi> __device__ __forceinline__ void run_gemm(int wid_s, unsigned char* smem, const bf16_t* A, const bf16_t* Bt, int M, int N, int K, const Epi& E) {
    pg8::Gemm g; g.A = A; g.Bt = Bt; g.M = M; g.N = N; g.K = K; g.wid_s = wid_s; g.ld = K;
    pg8::StaticOrder S; S.init(M, N, (int)gridDim.x, (int)blockIdx.x);
    pg8::gemm_phase<Epi, pg8::StaticOrder, false>((PG8_LAS unsigned char*)smem, g, S, E, nullptr);
}

struct EpiCtxAtomic {
    static constexpr bool PERM = false, AFTER_DRAIN = false;
    float* dst; const float* gate;
    __device__ __forceinline__ void operator()(const f32x4 (&acc)[2][2][4][2], const Unit& u, int wr, int wc, int fr, int fq) const {
        const int col0 = u.pn * 256 + wc * 32 + 4 * fq; float* d0 = dst + (size_t)u.pm * 256 * 1024;
        f32x4 gv[2][2];
#pragma unroll
        for (int bj = 0; bj < 2; ++bj)
#pragma unroll
            for (int n = 0; n < 2; ++n) gv[bj][n] = *(const f32x4*)(gate + col0 + bj * 128 + n * 16);
#pragma unroll
        for (int ai = 0; ai < 2; ++ai)
#pragma unroll
            for (int m = 0; m < 4; ++m) { float* rp = d0 + (size_t)(ai * 128 + wr * 64 + m * 16 + fr) * 1024 + col0;
#pragma unroll
                for (int bj = 0; bj < 2; ++bj)
#pragma unroll
                    for (int n = 0; n < 2; ++n) { const f32x4 v = gv[bj][n] * acc[ai][bj][m][n];
#pragma unroll
                        for (int e = 0; e < 4; ++e) __hip_atomic_fetch_add(rp + bj * 128 + n * 16 + e, v[e], __ATOMIC_RELAXED, __HIP_MEMORY_SCOPE_AGENT); } }
    }
};
template <class Epi> __device__ __forceinline__ void run_gemm_splitk(int wid_s, unsigned char* smem, const bf16_t* A, const bf16_t* Bt, int M, int N, int Kfull, int Kchunk, const Epi& E) {
    pg8::Gemm g; g.A = A; g.Bt = Bt; g.M = M; g.N = N; g.K = Kchunk; g.wid_s = wid_s; g.ld = Kfull;
    pg8::SplitOrder S; S.init(M, N, Kfull / Kchunk, (int)gridDim.x, (int)blockIdx.x);
    pg8::gemm_phase<Epi, pg8::SplitOrder, false>((PG8_LAS unsigned char*)smem, g, S, E, nullptr);
}

#ifdef PROBE_SEL
#define PREP_MARK(k) do { if (MODE == 0 && blockIdx.x == 5 && my_tid(wid_s) == 0) __hip_atomic_store(p.BAR + 96 + (k), (unsigned)__builtin_amdgcn_s_memrealtime(), __ATOMIC_RELAXED, __HIP_MEMORY_SCOPE_AGENT); } while (0)
#else
#define PREP_MARK(k) do {} while (0)
#endif
template <int MODE> __device__ void prep_phase(const Params& p, int wid_s, unsigned char* smem) {
    int tid_ = my_tid(wid_s); const int tid = tid_, lane = tid & 63, w = tid >> 6;
    float* tab = (float*)smem;
    float* tab64 = (float*)(smem + 16384);
    float* sv = (float*)(smem + 20480);
    float* red = (float*)(smem + 40960);
    const int bidx = MODE == 0 ? (int)blockIdx.x : (int)blockIdx.x - 16, nb = MODE == 0 ? (int)gridDim.x : (int)gridDim.x - 16;
    if (bidx < 0) return;
    for (int i = tid; i < 4096; i += 512) tab[i] = cospif((float)i * (1.0f / 2048.0f));
    if (tid < 64) tab64[tid] = cospif((float)tid * (1.0f / 32.0f));
    for (int i = tid; i < 5120; i += 512) { const int v = i >> 10, k = i & 1023; const float xv = v < 4 ? p.c[v * 1024 + k] : p.c_ctx[k]; sv[i] = xv / (1.0f + expf(-xv)); }
    __syncthreads();
    PREP_MARK(40);
    if (MODE != 1) {
        const int nl = lane, kg = w, lw = MODE == 0 ? 0 : 1;
#define WT_DESC(r, sp, ld, dst) do { \
            if ((r) < 704) { const int nt = (r) >> 4, kt = (r) & 15, n = nt * 64 + nl, k0 = kt * 64 + kg * 8; const int np = (n >= 1280 && n < 2304) ? ((n & ~31) + pg8::perm32(n & 31)) : n; const int src = np < 768 ? np : np - 256; \
                ld = 2560; sp = p.w_in + (size_t)lw * 1024 * 2560 + (size_t)k0 * 2560 + src; dst = p.WIN + (size_t)lw * NPROJ * 1024 + (size_t)n * 1024 + k0; } \
            else if ((r) < 960) { const int rr = (r) - 704, nt = rr >> 4, kt = rr & 15, n = nt * 64 + nl, k0 = kt * 64 + kg * 8; \
                ld = 1024; sp = p.w_out + (size_t)lw * 1024 * 1024 + (size_t)k0 * 1024 + ((n & ~255) + perm256(n & 255)); dst = p.WOUT + (size_t)lw * 1024 * 1024 + (size_t)n * 1024 + k0; } \
            else if ((r) < 2368) { const int rr = (r) - 960, nt = rr >> 4, kt = rr & 15, n = nt * 64 + nl, k0 = kt * 64 + kg * 8; \
                const int pn = n >> 8, lc = n & 255, bj = lc >> 7, wc = (lc >> 5) & 3, nn = (lc >> 4) & 1, fq = (lc >> 2) & 3, e4 = lc & 3; \
                const int j = 128 * pn + 32 * wc + 8 * fq + 4 * nn + e4; \
                ld = DFF; sp = (bj ? p.w_up : p.w_gate) + (size_t)lw * 1024 * DFF + (size_t)k0 * DFF + j; dst = p.WGU + (size_t)lw * 5632 * 1024 + (size_t)n * 1024 + k0; } \
            else { const int rr = (r) - 2368, nt = rr / 44, kt = rr % 44, n = nt * 64 + nl, k0 = kt * 64 + kg * 8; \
                ld = 1024; sp = p.w_down + (size_t)lw * DFF * 1024 + (size_t)k0 * 1024 + ((n & ~255) + perm256(n & 255)); dst = p.WDN + (size_t)lw * 1024 * DFF + (size_t)n * DFF + k0; } } while (0)
        for (int r0 = bidx; r0 < 3072; r0 += 4 * nb) {
            const float* sp[4]; int ld[4]; bf16_t* dd[4]; bool ok[4]; float v[4][8];
#pragma unroll
            for (int i = 0; i < 4; ++i) { const int r = r0 + i * nb; ok[i] = r < 3072 && !(r >= 192 && r < 320); sp[i] = p.w_out; ld[i] = 0; dd[i] = nullptr;
                if (r < 3072) WT_DESC(r, sp[i], ld[i], dd[i]); }
#pragma unroll
            for (int i = 0; i < 4; ++i)
#pragma unroll
                for (int e = 0; e < 8; ++e) v[i][e] = ok[i] ? __builtin_nontemporal_load(sp[i] + (size_t)e * ld[i]) : 0.f;
#pragma unroll
            for (int i = 0; i < 4; ++i) if (ok[i]) { u32x4 o; o.x = cvt_pk_bf16(v[i][0], v[i][1]); o.y = cvt_pk_bf16(v[i][2], v[i][3]); o.z = cvt_pk_bf16(v[i][4], v[i][5]); o.w = cvt_pk_bf16(v[i][6], v[i][7]); *(u32x4*)dd[i] = o; }
        }
#undef WT_DESC
        for (int ft = (MODE == 0 ? bidx - 128 : bidx); ft >= 0 && ft < 128; ft += nb) {
            const int r = 192 + ft, nt = r >> 4, kt = r & 15, n = nt * 64 + nl, k0 = kt * 64 + kg * 8; const float* W = p.w_in + (size_t)lw * 1024 * 2560;
            int cp = n - 768; const bool isq = cp >= 256; cp &= 255; const int g = cp >> 6, j = cp & 63;
            float v[8];
#pragma unroll
            for (int e = 0; e < 8; ++e) v[e] = 0.f;
#pragma unroll 8
            for (int m = 0; m < 64; ++m) { int idx = (j * m) & 63; if (isq) idx = (idx - 16) & 63; const float tv = tab64[idx];
#pragma unroll
                for (int e = 0; e < 8; ++e) v[e] += W[(size_t)(k0 + e) * 2560 + 768 + g * 64 + m] * tv; }
            u32x4 o; o.x = cvt_pk_bf16(v[0], v[1]); o.y = cvt_pk_bf16(v[2], v[3]); o.z = cvt_pk_bf16(v[4], v[5]); o.w = cvt_pk_bf16(v[6], v[7]);
            *(u32x4*)(p.WIN + (size_t)lw * NPROJ * 1024 + (size_t)n * 1024 + k0) = o;
        }
    }
    __syncthreads(); PREP_MARK(41);
    if (MODE == 0) for (int i = blockIdx.x * 512 + tid; i < 2048; i += gridDim.x * 512) p.NRM[i] = 0.f;
    if (MODE != 2) for (int task = (MODE == 0 ? 0 : 96) + bidx; task < (MODE == 0 ? 96 : 192); task += nb) {
        const int l = task / 96, n = (task % 96) * 64 + lane;
        float a0 = 0.f, a1 = 0.f, a2 = 0.f, a3 = 0.f, a4 = 0.f;
        const float* W = p.w_mod + (size_t)l * 1024 * 6144 + n;
#pragma unroll 16
        for (int kk = 0; kk < 128; ++kk) { const int k = w * 128 + kk; const float wv = W[(size_t)k * 6144];
            a0 += sv[k] * wv; a1 += sv[1024 + k] * wv; a2 += sv[2048 + k] * wv; a3 += sv[3072 + k] * wv; a4 += sv[4096 + k] * wv; }
        red[(w * 5 + 0) * 64 + lane] = a0; red[(w * 5 + 1) * 64 + lane] = a1; red[(w * 5 + 2) * 64 + lane] = a2; red[(w * 5 + 3) * 64 + lane] = a3; red[(w * 5 + 4) * 64 + lane] = a4;
        __syncthreads();
        if (w < 5) { float s = p.b_mod[l * 6144 + n]; for (int ww = 0; ww < 8; ++ww) s += red[(ww * 5 + w) * 64 + lane]; p.MOD[(size_t)(l * 5 + w) * 6144 + n] = s; }
        __syncthreads();
    }
    __syncthreads(); PREP_MARK(42);
    if (MODE == 0) {
        const int gw = blockIdx.x * 8 + w, nw = gridDim.x * 8;
        for (int pid = gw; pid < 8448; pid += nw) {
            int l, t, L; float* outp;
            if (pid < 8192) { l = pid >> 12; t = pid & 4095; L = 4096; outp = p.H2F + (size_t)pid * 64; } else { l = 0; t = pid - 8192; L = 256; outp = p.H2C + (size_t)t * 64; }
            const float tt = (float)t / (float)(L - 1), wa = 6.283185307179586f * (float)t / (float)L;
            const float* w1 = p.filt_w1 + l * 33 * 64; const float* w2 = p.filt_w2 + l * 64 * 64;
            float a = p.filt_b1[l * 64 + lane] + tt * w1[lane];
            for (int bnd = 0; bnd < 16; ++bnd) { const float f = 1e-4f + (float)bnd * ((15.0f - 1e-4f) / 15.0f); const float rev2 = f * ((float)(2 * t) / (float)L);
                a += cospif(rev2) * w1[(1 + bnd) * 64 + lane] - sinpif(rev2) * w1[(17 + bnd) * 64 + lane]; }
            const float h1 = sinf(p.filt_freq[l * 128 + lane] * a);
            float a2 = p.filt_b2[l * 64 + lane];
            for (int i = 0; i < 64; ++i) a2 += __int_as_float(__builtin_amdgcn_ds_bpermute(i << 2, __float_as_int(h1))) * w2[i * 64 + lane];
            outp[lane] = sinf(p.filt_freq[l * 128 + 64 + lane] * a2);
        }
    }
    __syncthreads(); PREP_MARK(43);
    if (MODE == 0) {
        const size_t gt = (size_t)blockIdx.x * 512 + tid, gs = (size_t)gridDim.x * 512;
        for (size_t idx = gt; idx < (size_t)128 * 128; idx += gs) {
            const int m = (int)(idx >> 7), k = (int)(idx & 127), ri = m >> 6, k1 = m & 63, pq = k >> 6, n1 = k & 63, ii = (k1 * n1) & 63;
            const float c = tab64[ii], sn = tab64[(ii - 16) & 63];
            p.FM1[idx] = f2bf(ri == 0 ? (pq == 0 ? c : -sn) : (pq == 0 ? -sn : -c));
        }
        for (size_t idx = gt; idx < (size_t)64 * 128; idx += gs) {
            const int k2 = (int)(idx >> 7), k = (int)(idx & 127), ri = k >> 6, n2 = k & 63, ii = (k2 * n2) & 63;
            p.FM2[idx] = f2bf((ri == 0 ? tab64[ii] : tab64[(ii - 16) & 63]) * (1.0f / 512.0f));
        }
        for (size_t idx = gt; idx < (size_t)256 * 64; idx += gs) {
            const int k = (int)(idx >> 6), kk0 = (int)(idx & 63) * 8; float v[8];
#pragma unroll
            for (int e = 0; e < 8; ++e) { const int kk = kk0 + e, n = kk & 255, ii = ((k * n) & 255) * 16; v[e] = (kk < 256 ? tab[ii] : -tab[(ii - 1024) & 4095]) * (1.0f / 128.0f); }
            u32x4 o; o.x = cvt_pk_bf16(v[0], v[1]); o.y = cvt_pk_bf16(v[2], v[3]); o.z = cvt_pk_bf16(v[4], v[5]); o.w = cvt_pk_bf16(v[6], v[7]);
            *(u32x4*)(p.DFTC + idx * 8) = o;
        }
    }
}

__device__ __forceinline__ void split_bf16x8(const f32x4 a, const f32x4 b, bf16x8& hi, bf16x8& lo) {
    union { u32x4 u; bf16x8 v; } ph, pl;
    ph.u.x = cvt_pk_bf16(a[0], a[1]); ph.u.y = cvt_pk_bf16(a[2], a[3]); ph.u.z = cvt_pk_bf16(b[0], b[1]); ph.u.w = cvt_pk_bf16(b[2], b[3]);
    pl.u.x = cvt_pk_bf16(a[0] - __uint_as_float(ph.u.x << 16), a[1] - __uint_as_float(ph.u.x & 0xffff0000u));
    pl.u.y = cvt_pk_bf16(a[2] - __uint_as_float(ph.u.y << 16), a[3] - __uint_as_float(ph.u.y & 0xffff0000u));
    pl.u.z = cvt_pk_bf16(b[0] - __uint_as_float(ph.u.z << 16), b[1] - __uint_as_float(ph.u.z & 0xffff0000u));
    pl.u.w = cvt_pk_bf16(b[2] - __uint_as_float(ph.u.w << 16), b[3] - __uint_as_float(ph.u.w & 0xffff0000u));
    hi = ph.v; lo = pl.v;
}
__device__ void taps_phase(const Params& p, int wid_s, int l, int bstart) {
    if ((int)blockIdx.x < bstart) return;
    int tid_ = my_tid(wid_s); const int tid = tid_, lane = tid & 63, w = tid >> 6, n = lane & 15, g = lane >> 4;
    const float min_decay = -4.605170185988091f / 1.5f, max_decay = -4.605170185988091f / 0.3f;
    for (int wt = ((int)blockIdx.x - bstart) * 8 + w; wt < 2048; wt += ((int)gridDim.x - bstart) * 8) {
        const int ct = wt >> 5, tq = wt & 31;
        const int col = ct * 16 + n, c = col & 255, dir = (col >> 8) & 1, o = col >> 9;
        bf16x8 Bh[2], Bl[2];
#pragma unroll
        for (int ks = 0; ks < 2; ++ks) { f32x4 x0, x1; const float* wp = p.filt_w3 + (size_t)(l * 64 + 32 * ks + 8 * g) * 1024 + col;
#pragma unroll
            for (int e = 0; e < 4; ++e) { x0[e] = wp[(size_t)e * 1024]; x1[e] = wp[(size_t)(4 + e) * 1024]; }
            split_bf16x8(x0, x1, Bh[ks], Bl[ks]); }
        const float delta = fabsf(min_decay + (float)c * ((max_decay - min_decay) / 255.0f)), dl2 = -delta * (1.4426950408889634f / 4095.0f);
        bf16_t* outp = p.TAPS + ((size_t)((l * 2 + o) * 256 + c)) * 8192 + dir * 4096;
        float asum = 0.f;
        for (int tt = 0; tt < 8; ++tt) {
            const int tb = tq * 128 + tt * 16;
            const float* hp = p.H2F + ((size_t)l * 4096 + tb + n) * 64 + 8 * g;
            f32x4 acc = {0.f, 0.f, 0.f, 0.f};
#pragma unroll
            for (int ks = 0; ks < 2; ++ks) { const f32x4 a0 = *(const f32x4*)(hp + 32 * ks), a1 = *(const f32x4*)(hp + 32 * ks + 4); bf16x8 Ah, Al; split_bf16x8(a0, a1, Ah, Al);
                acc = __builtin_amdgcn_mfma_f32_16x16x32_bf16(Ah, Bh[ks], acc, 0, 0, 0); acc = __builtin_amdgcn_mfma_f32_16x16x32_bf16(Al, Bh[ks], acc, 0, 0, 0); acc = __builtin_amdgcn_mfma_f32_16x16x32_bf16(Ah, Bl[ks], acc, 0, 0, 0); }
            float v[4];
#pragma unroll
            for (int e = 0; e < 4; ++e) { const int t = tb + 4 * g + e; v[e] = acc[e] * __builtin_amdgcn_exp2f((float)t * dl2); if (!(dir == 1 && t == 0)) asum += fabsf(v[e]); }
            u32x2 pk; pk.x = cvt_pk_bf16(v[0], v[1]); pk.y = cvt_pk_bf16(v[2], v[3]);
            *(u32x2*)(outp + tb + 4 * g) = pk;
        }
        asum += shx(asum, 16, lane); asum += shx(asum, 32, lane);
        if (g == 0) __hip_atomic_fetch_add(p.NRM + l * 1024 + col, asum, __ATOMIC_RELAXED, __HIP_MEMORY_SCOPE_AGENT);
    }
}

__device__ void norm_phase(const Params& p, int wid_s, int l, int which, int Mrows, bool from_input) {
    int tid_ = my_tid(wid_s); const int tid = tid_, lane = tid & 63, w = tid >> 6;
    const float* gam = (which ? p.norm2_g : p.norm1_g) + l * 1024;
    const int moff = which ? 3072 : 0;
    for (int row0 = (blockIdx.x * 8 + w) * 4; row0 < Mrows; row0 += gridDim.x * 32) {
        f32x4 v[4][4];
#pragma unroll
        for (int rr = 0; rr < 4; ++rr) { const int row = row0 + rr; const bool isctx = row >= MMAIN;
            if (from_input) { const float* src = isctx ? p.ctx + (size_t)(row - MMAIN) * 1024 : p.x + (size_t)row * 1024;
#pragma unroll
                for (int i = 0; i < 4; ++i) v[rr][i] = *(const f32x4*)(src + i * 256 + lane * 4);
            } else { const bf16_t* src = p.XB + (size_t)row * 1024;
#pragma unroll
                for (int i = 0; i < 4; ++i) { const u32x2 q = *(const u32x2*)(src + i * 256 + lane * 4); v[rr][i][0] = __uint_as_float(q.x << 16); v[rr][i][1] = __uint_as_float(q.x & 0xffff0000u); v[rr][i][2] = __uint_as_float(q.y << 16); v[rr][i][3] = __uint_as_float(q.y & 0xffff0000u); } } }
#pragma unroll
        for (int rr = 0; rr < 4; ++rr) { const int row = row0 + rr; const bool isctx = row >= MMAIN; const int bi = isctx ? 4 : (row >> 12);
            float ss = 0.f;
#pragma unroll
            for (int i = 0; i < 4; ++i) ss += v[rr][i][0] * v[rr][i][0] + v[rr][i][1] * v[rr][i][1] + v[rr][i][2] * v[rr][i][2] + v[rr][i][3] * v[rr][i][3];
#pragma unroll
            for (int o = 32; o >= 1; o >>= 1) ss += shx(ss, o, lane);
            const float rstd = rsqrtf(ss * (1.0f / 1024.0f) + 1e-6f);
            const float* mod = p.MOD + (size_t)(l * 5 + bi) * 6144 + moff;
#pragma unroll
            for (int i = 0; i < 4; ++i) { const int col = i * 256 + lane * 4;
                const f32x4 g = *(const f32x4*)(gam + col), sh = *(const f32x4*)(mod + col), sc = *(const f32x4*)(mod + 1024 + col);
                f32x4 y = v[rr][i] * rstd * g * (sc + 1.0f) + sh;
                u32x2 o; o.x = cvt_pk_bf16(y[0], y[1]); o.y = cvt_pk_bf16(y[2], y[3]);
                *(u32x2*)(p.HB + (size_t)row * 1024 + col) = o; } }
    }
}
__device__ void final_norm(const Params& p, int wid_s) {
    int tid_ = my_tid(wid_s); const int tid = tid_, lane = tid & 63, w = tid >> 6;
    for (int row0 = (blockIdx.x * 8 + w) * 4; row0 < MMAIN; row0 += gridDim.x * 32) {
        f32x4 v[4][4];
#pragma unroll
        for (int rr = 0; rr < 4; ++rr)
#pragma unroll
            for (int i = 0; i < 4; ++i) { const u32x2 q = *(const u32x2*)(p.XB + (size_t)(row0 + rr) * 1024 + i * 256 + lane * 4); v[rr][i][0] = __uint_as_float(q.x << 16); v[rr][i][1] = __uint_as_float(q.x & 0xffff0000u); v[rr][i][2] = __uint_as_float(q.y << 16); v[rr][i][3] = __uint_as_float(q.y & 0xffff0000u); }
#pragma unroll
        for (int rr = 0; rr < 4; ++rr) { const int row = row0 + rr; float* src = p.out + (size_t)row * 1024; float ss = 0.f;
#pragma unroll
            for (int i = 0; i < 4; ++i) ss += v[rr][i][0] * v[rr][i][0] + v[rr][i][1] * v[rr][i][1] + v[rr][i][2] * v[rr][i][2] + v[rr][i][3] * v[rr][i][3];
#pragma unroll
            for (int o = 32; o >= 1; o >>= 1) ss += shx(ss, o, lane);
            const float rstd = rsqrtf(ss * (1.0f / 1024.0f) + 1e-6f);
#pragma unroll
            for (int i = 0; i < 4; ++i) { const int col = i * 256 + lane * 4; const f32x4 g = *(const f32x4*)(p.final_g + col); *(f32x4*)(src + col) = v[rr][i] * rstd * g; }
#ifdef PROBE_SEL
            if (row == 0 && lane == 0) { const unsigned ta = __hip_atomic_load(p.BAR + 96 + PROBE_A, __ATOMIC_RELAXED, __HIP_MEMORY_SCOPE_AGENT), tb = __hip_atomic_load(p.BAR + 96 + PROBE_SEL, __ATOMIC_RELAXED, __HIP_MEMORY_SCOPE_AGENT); src[0] += (float)(tb - ta) * 1e-4f * PROBE_SCALE; }
#endif
        }
    }
}

__device__ __forceinline__ float short_conv_at(const bf16_t* base, int t, int L, float w0, float w1, float w2, float bb) {
    const float um = t > 0 ? bf2f(base[t - 1]) : 0.f, u0 = bf2f(base[t]), up = t < L - 1 ? bf2f(base[t + 1]) : 0.f;
    return um * w0 + u0 * w1 + up * w2 + bb;
}
template <int L> __device__ void hyena_naive(const Params& p, int wid_s, int l, int c, unsigned char* smem) {
    constexpr bool ISCTX = (L == CTXL); constexpr int NI = (L + 511) / 512;
    int tid_ = my_tid(wid_s); const int tid = tid_, lane = tid & 63, w = tid >> 6;
    float* Kf = (float*)smem;
    float* Uf = (float*)(smem + 32768);
    float* red = (float*)(smem + 32768 + 65536);
    const bf16_t* hy = ISCTX ? p.HYUC : p.HYU;
    const float* H2 = ISCTX ? p.H2C : p.H2F + (size_t)l * 4096 * 64;
    const float* cw = p.hy_conv_w + l * 3 * 768; const float* cb = p.hy_conv_b + l * 768;
    const float min_decay = -4.605170185988091f / 1.5f, max_decay = -4.605170185988091f / 0.3f;
    const float delta = fabsf(min_decay + (float)c * ((max_decay - min_decay) / 255.0f));
    const int rowbase = ISCTX ? MMAIN : 0;
    for (int o = 0; o < 2; ++o) {
        float part = 0.f;
        const float* w3 = p.filt_w3 + (size_t)l * 64 * 1024 + o * 512 + c;
        for (int t = tid; t < L; t += 512) {
            const f32x4* hr = (const f32x4*)(H2 + (size_t)t * 64); float kf = 0.f, kb = 0.f;
#pragma unroll
            for (int j4 = 0; j4 < 16; ++j4) { const f32x4 hv = hr[j4];
#pragma unroll
                for (int jj = 0; jj < 4; ++jj) { kf += hv[jj] * w3[(4 * j4 + jj) * 1024]; kb += hv[jj] * w3[(4 * j4 + jj) * 1024 + 256]; } }
            const float dec = expf(-((float)t / (float)(L - 1)) * delta); kf *= dec; kb *= dec;
            Kf[L + t] = kf; part += fabsf(kf);
            if (t >= 1) { Kf[L - t] = kb; part += fabsf(kb); } else Kf[0] = 0.f;
        }
#pragma unroll
        for (int s = 32; s >= 1; s >>= 1) part += shx(part, s, lane);
        if (lane == 0) red[w] = part;
        if (o == 0) {
            const int ch = 512 + c; const float w0 = cw[ch], w1 = cw[768 + ch], w2 = cw[1536 + ch], bb = cb[ch];
            for (int idx = tid; idx < 4 * L; idx += 512) { const int b = idx / L, s = idx % L; Uf[s * 4 + b] = short_conv_at(hy + (size_t)(b * 768 + ch) * L, s, L, w0, w1, w2, bb); }
        }
        __syncthreads();
        float nrm = 0.f;
#pragma unroll
        for (int i = 0; i < 8; ++i) nrm += red[i];
        const float inv = 1.0f / nrm;
        float acc[NI][4];
#pragma unroll
        for (int i = 0; i < NI; ++i) { acc[i][0] = 0.f; acc[i][1] = 0.f; acc[i][2] = 0.f; acc[i][3] = 0.f; }
        if (tid < L) {
            const float* kp = Kf + L + tid;
#pragma unroll 8
            for (int s = 0; s < L; ++s) { const f32x4 u4 = *(const f32x4*)(Uf + s * 4);
#pragma unroll
                for (int i = 0; i < NI; ++i) { const float kv = kp[i * 512 - s]; acc[i][0] += kv * u4[0]; acc[i][1] += kv * u4[1]; acc[i][2] += kv * u4[2]; acc[i][3] += kv * u4[3]; } }
        }
        __syncthreads();
        if (tid < L) {
            const float sk = p.hy_skip[(l * 2 + o) * 256 + c];
            const int ch = o == 0 ? c : 256 + c; const float w0 = cw[ch], w1 = cw[768 + ch], w2 = cw[1536 + ch], bb = cb[ch];
#pragma unroll
            for (int i = 0; i < NI; ++i) { const int t = tid + i * 512;
#pragma unroll
                for (int b = 0; b < 4; ++b) { const float y = acc[i][b] * inv + sk * Uf[t * 4 + b];
                    const float xg = short_conv_at(hy + (size_t)(b * 768 + ch) * L, t, L, w0, w1, w2, bb);
                    if (o == 0) Uf[t * 4 + b] = xg * y; else p.HB[(size_t)(rowbase + b * L + t) * 1024 + c] = f2bf(xg * y); } }
        }
        __syncthreads();
    }
}


constexpr int HK_COPY = 8256, HK_OFF = 4128, HU_BLK = 136, HU_SB = 5280, HK_BYTES = 4 * HK_COPY * 2  , HU_BYTES = 4 * HU_SB * 2  ;
__device__ __forceinline__ int hy_swz(int idx) { return idx ^ ((((idx >> 9) & 3) << 2) | (((idx >> 7) & 1) << 4)); }
__device__ __forceinline__ int hu_idx(int b, int t) { return b * HU_SB + ((t >> 7) + 3) * HU_BLK + (t & 127); }

__device__ __forceinline__ void hyena_conv_mfma(const bf16_t* KC, const bf16_t* UU, float* Yf, int lane, int w) {
    const int qh = w & 1, ks = w >> 1, n = lane & 15, g = lane >> 4;
    f32x4 acc[8][4];
#pragma unroll
    for (int a = 0; a < 8; ++a)
#pragma unroll
        for (int qq = 0; qq < 4; ++qq) acc[a][qq] = (f32x4){0.f, 0.f, 0.f, 0.f};
    const int abase = HK_OFF + 32 * ks + 8 * g - 8 * n;
    const int bbase = (n & 3) * HU_SB + ((n >> 2) + 3) * HU_BLK + 32 * ks + 8 * g;
    for (int D = 16 * qh - 31; D <= 16 * qh + 15; ++D) {
        bf16x8 A[8];
#pragma unroll
        for (int a = 0; a < 8; ++a) { const bf16_t* ap = KC + (a & 3) * HK_COPY + abase - 128 * D - (a & 4);
            if (a < 4) A[a] = *(const bf16x8*)ap;
            else { union { u32x2 h[2]; bf16x8 v; } t; t.h[0] = *(const u32x2*)ap; t.h[1] = *(const u32x2*)(ap + 4); A[a] = t.v; } }
        bf16x8 B[4];
#pragma unroll
        for (int qq = 0; qq < 4; ++qq) B[qq] = *(const bf16x8*)(UU + bbase + min(max(4 * (4 * qh + qq) - D, -3), 31) * HU_BLK);
#pragma unroll
        for (int qq = 0; qq < 4; ++qq) { const int q = 4 * qh + qq;
            if (D >= 4 * q - 31 && D <= 4 * q + 3) {
#pragma unroll
                for (int a = 0; a < 8; ++a) acc[a][qq] = __builtin_amdgcn_mfma_f32_16x16x32_bf16(A[a], B[qq], acc[a][qq], 0, 0, 0);
            } }
    }
    __syncthreads();
    const int Il = n >> 2, b = n & 3;
    const int L3 = Il | ((g & 1) << 2), lbase = 8192 * qh + 512 * Il + 128 * g + b;
    int xa[8];
#pragma unroll
    for (int a = 0; a < 8; ++a) xa[a] = lbase + ((a ^ L3) << 2);
    for (int r = 0; r < 4; ++r) {
        if (ks == r) {
#pragma unroll
            for (int a = 0; a < 8; ++a) { float* yp = Yf + xa[a];
#pragma unroll
                for (int qq = 0; qq < 4; ++qq)
#pragma unroll
                    for (int e = 0; e < 4; ++e) { if (r == 0) yp[2048 * qq + 32 * e] = acc[a][qq][e]; else yp[2048 * qq + 32 * e] += acc[a][qq][e]; } }
        }
        __syncthreads();
    }
}

#ifdef PROBE_SEL
#define PROBE_MARK(k) do { if (l == 0 && c == 0 && my_tid(wid_s) == 0) { __hip_atomic_store(p.BAR + 96 + (k), (unsigned)__builtin_amdgcn_s_memrealtime(), __ATOMIC_RELAXED, __HIP_MEMORY_SCOPE_AGENT); } } while (0)
#else
#define PROBE_MARK(k) do {} while (0)
#endif
__device__ __forceinline__ void short_conv8(const bf16_t* base, int t0, int L, float w0, float w1, float w2, float bb, float (&o)[8]) {
    const u32x4 v = *(const u32x4*)(base + t0);
    const float um = t0 > 0 ? bf2f(base[t0 - 1]) : 0.f, up = t0 + 8 < L ? bf2f(base[t0 + 8]) : 0.f;
    float x[10]; x[0] = um; x[9] = up;
#pragma unroll
    for (int e = 0; e < 4; ++e) { x[1 + 2 * e] = __uint_as_float(v[e] << 16); x[2 + 2 * e] = __uint_as_float(v[e] & 0xffff0000u); }
#pragma unroll
    for (int e = 0; e < 8; ++e) o[e] = x[e] * w0 + x[e + 1] * w1 + x[e + 2] * w2 + bb;
}

__device__ void hyena_mfma(const Params& p, int wid_s, int l, int c, unsigned char* smem) {
    int tid_ = my_tid(wid_s); const int tid = tid_, lane = tid & 63, w = tid >> 6;
    bf16_t* KC = (bf16_t*)smem; bf16_t* UU = (bf16_t*)(smem + HK_BYTES); float* Yf = (float*)smem; float* red = (float*)(smem + HK_BYTES + HU_BYTES);
    constexpr int L = SEQL;
    const bf16_t* hy = p.HYU; const float* H2 = p.H2F + (size_t)l * 4096 * 64;
    const float* cw = p.hy_conv_w + l * 3 * 768; const float* cb = p.hy_conv_b + l * 768;
    const float min_decay = -4.605170185988091f / 1.5f, max_decay = -4.605170185988091f / 0.3f;
    const float delta = fabsf(min_decay + (float)c * ((max_decay - min_decay) / 255.0f));
    u32x4 zero4 = (u32x4){0u, 0u, 0u, 0u}; asm volatile("" : "+v"(zero4));
    PROBE_MARK(0);
    for (int i = tid; i < (HK_BYTES + HU_BYTES) / 16; i += 512) ((u32x4*)smem)[i] = zero4;
    __syncthreads();
#define HY_COPIES(ord) do { const bf16_t* tp = p.TAPS + ((size_t)((l * 2 + (ord)) * 256 + c)) * 8192; \
        for (int i = tid; i < 1024; i += 512) { const u32x4 v = *(const u32x4*)(tp + i * 8); const int dir = i >> 9, tq = (i & 511) * 8; \
            _Pragma("unroll") for (int e = 0; e < 8; ++e) { const bf16_t val = (bf16_t)((e & 1) ? (v[e >> 1] >> 16) : (v[e >> 1] & 0xffffu)); const int t = tq + e; \
                if (dir == 0) { _Pragma("unroll") for (int s4 = 0; s4 < 4; ++s4) KC[s4 * HK_COPY + HK_OFF + s4 - t] = val; } \
                else if (t >= 1) { _Pragma("unroll") for (int s4 = 0; s4 < 4; ++s4) KC[s4 * HK_COPY + HK_OFF + s4 + t] = val; } } } } while (0)
    HY_COPIES(0);
    { int t0 = tid * 8; asm volatile("" : "+v"(t0));
      const int ch = 512 + c; const float w0 = cw[ch], w1 = cw[768 + ch], w2 = cw[1536 + ch], bb = cb[ch];
#pragma unroll
      for (int b = 0; b < 4; ++b) { float o[8]; short_conv8(hy + (size_t)(b * 768 + ch) * L, t0, L, w0, w1, w2, bb, o);
          u32x4 pk; pk.x = cvt_pk_bf16(o[0], o[1]); pk.y = cvt_pk_bf16(o[2], o[3]); pk.z = cvt_pk_bf16(o[4], o[5]); pk.w = cvt_pk_bf16(o[6], o[7]);
          *(u32x4*)(UU + hu_idx(b, t0)) = pk; } }
    __syncthreads();
    const float inv1 = 1.0f / (p.NRM[l * 1024 + c] + p.NRM[l * 1024 + 256 + c]), inv2 = 1.0f / (p.NRM[l * 1024 + 512 + c] + p.NRM[l * 1024 + 768 + c]);
    PROBE_MARK(1);
    hyena_conv_mfma(KC, UU, Yf, lane, w);
    PROBE_MARK(2);
    { int t0 = tid * 8; asm volatile("" : "+v"(t0));
      const float sk = p.hy_skip[(l * 2 + 0) * 256 + c]; const int ch = c; const float w0 = cw[ch], w1 = cw[768 + ch], w2 = cw[1536 + ch], bb = cb[ch];
#pragma unroll
      for (int b = 0; b < 4; ++b) { float xg[8]; short_conv8(hy + (size_t)(b * 768 + ch) * L, t0, L, w0, w1, w2, bb, xg);
          float yv[8];
#pragma unroll
          for (int e = 0; e < 8; ++e) yv[e] = Yf[hy_swz((t0 + e) * 4) + b];
          const u32x4 uq = *(const u32x4*)(UU + hu_idx(b, t0)); float uf[8];
#pragma unroll
          for (int e = 0; e < 4; ++e) { uf[2 * e] = __uint_as_float(uq[e] << 16); uf[2 * e + 1] = __uint_as_float(uq[e] & 0xffff0000u); }
          float z[8];
#pragma unroll
          for (int e = 0; e < 8; ++e) z[e] = xg[e] * (yv[e] * inv1 + sk * uf[e]);
          u32x4 pk; pk.x = cvt_pk_bf16(z[0], z[1]); pk.y = cvt_pk_bf16(z[2], z[3]); pk.z = cvt_pk_bf16(z[4], z[5]); pk.w = cvt_pk_bf16(z[6], z[7]);
          *(u32x4*)(UU + hu_idx(b, t0)) = pk; } }
    __syncthreads();
    PROBE_MARK(3);
    for (int i = tid; i < HK_BYTES / 16; i += 512) ((u32x4*)smem)[i] = zero4;
    __syncthreads();
    HY_COPIES(1);
#undef HY_COPIES
    __syncthreads();
    PROBE_MARK(4);
    hyena_conv_mfma(KC, UU, Yf, lane, w);
    PROBE_MARK(5);
    { int t0 = tid * 8; asm volatile("" : "+v"(t0));
      const float sk = p.hy_skip[(l * 2 + 1) * 256 + c]; const int ch = 256 + c; const float w0 = cw[ch], w1 = cw[768 + ch], w2 = cw[1536 + ch], bb = cb[ch];
#pragma unroll
      for (int b = 0; b < 4; ++b) { float xg[8]; short_conv8(hy + (size_t)(b * 768 + ch) * L, t0, L, w0, w1, w2, bb, xg);
          float yv[8];
#pragma unroll
          for (int e = 0; e < 8; ++e) yv[e] = Yf[hy_swz((t0 + e) * 4) + b];
          const u32x4 uq = *(const u32x4*)(UU + hu_idx(b, t0)); float uf[8];
#pragma unroll
          for (int e = 0; e < 4; ++e) { uf[2 * e] = __uint_as_float(uq[e] << 16); uf[2 * e + 1] = __uint_as_float(uq[e] & 0xffff0000u); }
#pragma unroll
          for (int e = 0; e < 8; ++e) p.HB[(size_t)(b * L + t0 + e) * 1024 + c] = f2bf(xg[e] * (yv[e] * inv2 + sk * uf[e])); } }
    __syncthreads();
    PROBE_MARK(6);
}


constexpr int FN_PITCH = 136, FN_BUF = 256 * FN_PITCH * 2  ;
__device__ void fnet_task(const Params& p, int wid_s, int task, unsigned char* smem) {
    int tid_ = my_tid(wid_s); const int tid = tid_, lane = tid & 63, w = tid >> 6, n = lane & 15, g = lane >> 4;
    const int b = task >> 6, cg = task & 63;
    const int l = 0, c = (task == 50) ? 0 : 1; PROBE_MARK(30);
    bf16_t* In = (bf16_t*)smem; bf16_t* Tb = (bf16_t*)(smem + FN_BUF); bf16_t* Yb = (bf16_t*)smem;
    {
        const bf16_t* src = p.FNB + (size_t)(b * 256 + 4 * cg) * 8192;
#pragma unroll
        for (int i = 0; i < 8; ++i) { const int ch = tid + 512 * i;
            const int cl = ch >> 10, pq = (ch >> 9) & 1, n1 = (ch >> 3) & 63, n20 = (ch & 7) * 8;
            const u32x4 v = *(const u32x4*)(src + (size_t)cl * 8192 + pq * 4096 + n1 * 64 + n20);
            bf16_t* dst = In + (cl * 64 + n20) * FN_PITCH + pq * 64 + n1;
#pragma unroll
            for (int e = 0; e < 4; ++e) { dst[(2 * e) * FN_PITCH] = (bf16_t)(v[e] & 0xffffu); dst[(2 * e + 1) * FN_PITCH] = (bf16_t)(v[e] >> 16); } }
    }
    __syncthreads();
    {
        f32x4 acc[8][2];
#pragma unroll
        for (int mt = 0; mt < 8; ++mt) { acc[mt][0] = (f32x4){0.f, 0.f, 0.f, 0.f}; acc[mt][1] = (f32x4){0.f, 0.f, 0.f, 0.f}; }
        bf16x8 Af[2][8];
#pragma unroll
        for (int mt = 0; mt < 8; ++mt) Af[0][mt] = *(const bf16x8*)(p.FM1 + (16 * mt + n) * 128 + 8 * g);
#pragma unroll
        for (int ks = 0; ks < 4; ++ks) {
            bf16x8 Bf[2];
#pragma unroll
            for (int j = 0; j < 2; ++j) Bf[j] = *(const bf16x8*)(In + (16 * (2 * w + j) + n) * FN_PITCH + 32 * ks + 8 * g);
            if (ks < 3) {
#pragma unroll
                for (int mt = 0; mt < 8; ++mt) Af[(ks + 1) & 1][mt] = *(const bf16x8*)(p.FM1 + (16 * mt + n) * 128 + 32 * (ks + 1) + 8 * g); }
#pragma unroll
            for (int mt = 0; mt < 8; ++mt) {
                acc[mt][0] = __builtin_amdgcn_mfma_f32_16x16x32_bf16(Af[ks & 1][mt], Bf[0], acc[mt][0], 0, 0, 0); acc[mt][1] = __builtin_amdgcn_mfma_f32_16x16x32_bf16(Af[ks & 1][mt], Bf[1], acc[mt][1], 0, 0, 0); }
        }
#pragma unroll
        for (int j = 0; j < 2; ++j) { const int nn = 16 * (2 * w + j) + n, cl = nn >> 6, n2 = nn & 63;
#pragma unroll
            for (int kt = 0; kt < 4; ++kt)
#pragma unroll
                for (int e = 0; e < 4; ++e) { const int k1 = 16 * kt + 4 * g + e; const float ph = (float)(k1 * n2) * (1.0f / 4096.0f);
                    const float cph = __builtin_amdgcn_cosf(ph), sph = __builtin_amdgcn_sinf(ph);
                    const float tr = acc[kt][j][e], ti = acc[kt + 4][j][e];
                    bf16_t* dst = Tb + (cl * 64 + k1) * FN_PITCH + n2;
                    dst[0] = f2bf(cph * tr + sph * ti); dst[64] = f2bf(cph * ti - sph * tr); } }
    }
    __syncthreads();
    {
        f32x4 acc[4][2];
#pragma unroll
        for (int mt = 0; mt < 4; ++mt) { acc[mt][0] = (f32x4){0.f, 0.f, 0.f, 0.f}; acc[mt][1] = (f32x4){0.f, 0.f, 0.f, 0.f}; }
        bf16x8 Af[4][4];
#pragma unroll
        for (int ks = 0; ks < 4; ++ks)
#pragma unroll
            for (int mt = 0; mt < 4; ++mt) Af[ks][mt] = *(const bf16x8*)(p.FM2 + (16 * mt + n) * 128 + 32 * ks + 8 * g);
#pragma unroll
        for (int ks = 0; ks < 4; ++ks) {
            bf16x8 Bf[2];
#pragma unroll
            for (int j = 0; j < 2; ++j) Bf[j] = *(const bf16x8*)(Tb + (16 * (2 * w + j) + n) * FN_PITCH + 32 * ks + 8 * g);
#pragma unroll
            for (int mt = 0; mt < 4; ++mt) {
                acc[mt][0] = __builtin_amdgcn_mfma_f32_16x16x32_bf16(Af[ks][mt], Bf[0], acc[mt][0], 0, 0, 0); acc[mt][1] = __builtin_amdgcn_mfma_f32_16x16x32_bf16(Af[ks][mt], Bf[1], acc[mt][1], 0, 0, 0); }
        }
#pragma unroll
        for (int j = 0; j < 2; ++j) { const int nn = 16 * (2 * w + j) + n, cl = nn >> 6, k1 = nn & 63;
#pragma unroll
            for (int mt = 0; mt < 4; ++mt)
#pragma unroll
                for (int e = 0; e < 4; ++e) { const int k2 = 16 * mt + 4 * g + e; Yb[(k1 + 64 * k2) * 4 + cl] = f2bf(acc[mt][j][e]); } }
    }
    __syncthreads();
#pragma unroll
    for (int i = 0; i < 8; ++i) { const int k = tid + 512 * i; *(u32x2*)(p.HB + (size_t)(b * SEQL + k) * 1024 + 256 + 4 * cg) = *(const u32x2*)(Yb + k * 4); }
    __syncthreads();
    PROBE_MARK(31);
}

template <bool LOCAL> __device__ void attn_wave(const Params& p, int wid_s, int l, int b, int r, int h, int qt, const float* rpbl  ) {
    int tid_ = my_tid(wid_s); const int lane = tid_ & 63, q = lane & 15, g = lane >> 4;
    const int qrow = LOCAL ? (b * SEQL + r * 64 + qt * 16 + q) : (MMAIN + b * CTXL + qt * 16 + q);
    constexpr int T0 = LOCAL ? 0 : 16;
    bf16x8 Qf[2];
#pragma unroll
    for (int ds = 0; ds < 2; ++ds) Qf[ds] = *(const bf16x8*)(p.QK + (size_t)qrow * 1024 + h * 64 + ds * 32 + 8 * g);
    const int c = (LOCAL && b == 1 && r == 11 && h == 4 && qt == 0) ? 0 : 1; PROBE_MARK(10);
    f32x4 S[32];
    const int c0 = qt == 0 ? 0 : (qt == 1 ? 8 : (qt == 2 ? 24 : 32));
    const int rs = min(max(r - 4, 0), 56);
    const int ki = 8 * (q >> 2) + (q & 3);
    const bf16_t* kloc = p.QK + (size_t)(b * SEQL + rs * 64 + c0 + ki) * 1024 + 512 + h * 64 + 8 * g;
    const bf16_t* kctx = p.QK + (size_t)(MMAIN + b * CTXL + ki) * 1024 + 512 + h * 64 + 8 * g;
#pragma unroll
    for (int tb = T0; tb < 32; tb += 8) {
        bf16x8 kf[8][2];
#pragma unroll
        for (int j = 0; j < 8; ++j) { const int T = tb + j, hh = T & 1;
            const bf16_t* kp = (T < 16) ? kloc + (size_t)((T >> 1) * 64 + 4 * hh) * 1024 : kctx + (size_t)(32 * ((T - 16) >> 1) + 4 * hh) * 1024;
            kf[j][0] = *(const bf16x8*)kp; kf[j][1] = *(const bf16x8*)(kp + 32); }
        __builtin_amdgcn_sched_barrier(0);
#pragma unroll
        for (int j = 0; j < 8; ++j) { f32x4 a = {0.f, 0.f, 0.f, 0.f};
            a = __builtin_amdgcn_mfma_f32_16x16x32_bf16(kf[j][0], Qf[0], a, 0, 0, 0); a = __builtin_amdgcn_mfma_f32_16x16x32_bf16(kf[j][1], Qf[1], a, 0, 0, 0); S[tb + j] = a; }
        __builtin_amdgcn_sched_barrier(0);
    }
    PROBE_MARK(11);
    float mx = -1e30f;
    if (LOCAL) {
        const int qc = qt * 16 + q, cs = min(max(qc - 8, 0), 48);
#pragma unroll
        for (int T = 0; T < 16; ++T) { const int kr = T >> 1, hh = T & 1; const int brow = (rs + kr - r + 7) * 31;
#pragma unroll
            for (int e = 0; e < 4; ++e) { const int kc = c0 + 8 * g + 4 * hh + e; const bool valid = (kc >= cs) && (kc < cs + 16);
                const int bidx = min(max(kc - qc + 15, 0), 30);
                const float sval = valid ? S[T][e] * 0.125f + rpbl[brow + bidx] : -1e30f; S[T][e] = sval; mx = fmaxf(mx, sval); } }
    }
#pragma unroll
    for (int T = 16; T < 32; ++T)
#pragma unroll
        for (int e = 0; e < 4; ++e) { const float sval = S[T][e] * 0.125f; S[T][e] = sval; mx = fmaxf(mx, sval); }
    mx = fmaxf(mx, shx(mx, 16, lane)); mx = fmaxf(mx, shx(mx, 32, lane));
    float sum = 0.f;
    bf16x8 Pf[16];
#pragma unroll
    for (int ch = T0 / 2; ch < 16; ++ch) {
        float pv[8];
#pragma unroll
        for (int e = 0; e < 4; ++e) { pv[e] = __expf(S[2 * ch][e] - mx); pv[4 + e] = __expf(S[2 * ch + 1][e] - mx); }
#pragma unroll
        for (int e = 0; e < 8; ++e) sum += pv[e];
        union { u32x4 u; bf16x8 v; } pf;
        pf.u.x = cvt_pk_bf16(pv[0], pv[1]); pf.u.y = cvt_pk_bf16(pv[2], pv[3]); pf.u.z = cvt_pk_bf16(pv[4], pv[5]); pf.u.w = cvt_pk_bf16(pv[6], pv[7]);
        Pf[ch] = pf.v;
    }
    sum += shx(sum, 16, lane); sum += shx(sum, 32, lane);
    const float inv = 1.0f / sum;
    PROBE_MARK(12);
    f32x4 O[4];
#pragma unroll
    for (int dt = 0; dt < 4; ++dt) O[dt] = (f32x4){0.f, 0.f, 0.f, 0.f};
    const bf16_t* vloc = p.VT + ((size_t)(b * 512 + h * 64 + q) * SEQL + rs * 64 + c0 + 8 * g);
    const bf16_t* vctx = p.VTC + ((size_t)(b * 512 + h * 64 + q) * CTXL + 8 * g);
#pragma unroll
    for (int cb = T0 / 2; cb < 16; cb += 4) {
        bf16x8 vf[4][4];
#pragma unroll
        for (int j = 0; j < 4; ++j)
#pragma unroll
            for (int dt = 0; dt < 4; ++dt) { const int ch = cb + j;
                const bf16_t* vp = (ch < 8) ? vloc + (size_t)(16 * dt) * SEQL + ch * 64 : vctx + (size_t)(16 * dt) * CTXL + 32 * (ch - 8);
                vf[j][dt] = *(const bf16x8*)vp; }
        __builtin_amdgcn_sched_barrier(0);
#pragma unroll
        for (int j = 0; j < 4; ++j)
#pragma unroll
            for (int dt = 0; dt < 4; ++dt) O[dt] = __builtin_amdgcn_mfma_f32_16x16x32_bf16(vf[j][dt], Pf[cb + j], O[dt], 0, 0, 0);
        __builtin_amdgcn_sched_barrier(0);
    }
#pragma unroll
    for (int dt = 0; dt < 4; ++dt) { u32x2 o; o.x = cvt_pk_bf16(O[dt][0] * inv, O[dt][1] * inv); o.y = cvt_pk_bf16(O[dt][2] * inv, O[dt][3] * inv);
        *(u32x2*)(p.HB + (size_t)qrow * 1024 + 512 + h * 64 + 16 * dt + 4 * g) = o; }
    PROBE_MARK(13);
}

__device__ __forceinline__ void attn_ld(const bf16_t* kp, const bf16_t* vp, size_t vstride, bf16x8 (&kf)[2][2], bf16x8 (&vf)[4]) {
#pragma unroll
    for (int hh = 0; hh < 2; ++hh)
#pragma unroll
        for (int ds = 0; ds < 2; ++ds) kf[hh][ds] = *(const bf16x8*)(kp + (size_t)hh * 4 * 1024 + ds * 32);
#pragma unroll
    for (int dt = 0; dt < 4; ++dt) vf[dt] = *(const bf16x8*)(vp + (size_t)dt * 16 * vstride);
}
__device__ void attn_wave4(const Params& p, int wid_s, int l, int b, int h, int qt, int rg, const float* rpbl) {
    int tid_ = my_tid(wid_s); const int lane = tid_ & 63, q = lane & 15, g = lane >> 4;
    const int r0 = rg * 4, c0 = qt == 0 ? 0 : (qt == 1 ? 8 : (qt == 2 ? 24 : 32)), qc = qt * 16 + q, cs = min(max(qc - 8, 0), 48);
    int rsj[4];
#pragma unroll
    for (int j = 0; j < 4; ++j) rsj[j] = min(max(r0 + j - 4, 0), 56);
    const int rs0 = rsj[0], nl = rsj[3] + 8 - rs0, nch = nl + 8;
    bf16x8 Qf[4][2];
#pragma unroll
    for (int j = 0; j < 4; ++j)
#pragma unroll
        for (int ds = 0; ds < 2; ++ds) Qf[j][ds] = *(const bf16x8*)(p.QK + (size_t)(b * SEQL + (r0 + j) * 64 + qt * 16 + q) * 1024 + h * 64 + ds * 32 + 8 * g);
    int bidx[8];
#pragma unroll
    for (int hh = 0; hh < 2; ++hh)
#pragma unroll
        for (int e = 0; e < 4; ++e) { const int kc = c0 + 8 * g + 4 * hh + e; bidx[hh * 4 + e] = (kc >= cs && kc < cs + 16) ? (kc - qc + 15) : 31; }
    const float SC = 0.125f * 1.4426950408889634f;
    float m[4], ls[4]; f32x4 O[4][4];
#pragma unroll
    for (int j = 0; j < 4; ++j) { m[j] = -1e30f; ls[j] = 0.f;
#pragma unroll
        for (int dt = 0; dt < 4; ++dt) O[j][dt] = (f32x4){0.f, 0.f, 0.f, 0.f}; }
    const int ki = 8 * (q >> 2) + (q & 3);
    const bf16_t* kloc = p.QK + (size_t)(b * SEQL + c0 + ki) * 1024 + 512 + h * 64 + 8 * g;
    const bf16_t* kctx = p.QK + (size_t)(MMAIN + b * CTXL + ki) * 1024 + 512 + h * 64 + 8 * g;
    const bf16_t* vloc = p.VT + ((size_t)(b * 512 + h * 64 + q) * SEQL + c0 + 8 * g);
    const bf16_t* vctx = p.VTC + ((size_t)(b * 512 + h * 64 + q) * CTXL + 8 * g);
    bf16x8 kf[2][2], vf[4], kfn[2][2], vfn[4];
    attn_ld(kloc + (size_t)rs0 * 64 * 1024, vloc + rs0 * 64, SEQL, kf, vf);
    for (int i = 0; i < nch; ++i) {
        const int i1 = i + 1;
        if (i1 < nch) { if (i1 < nl) attn_ld(kloc + (size_t)(rs0 + i1) * 64 * 1024, vloc + (rs0 + i1) * 64, SEQL, kfn, vfn);
                        else attn_ld(kctx + (size_t)(i1 - nl) * 32 * 1024, vctx + (i1 - nl) * 32, CTXL, kfn, vfn); }
        const bool isloc = i < nl; const int kr = rs0 + i;
#pragma unroll
        for (int j = 0; j < 4; ++j) {
            if (!isloc || (kr >= rsj[j] && kr < rsj[j] + 8)) {
                f32x4 s0 = {0.f, 0.f, 0.f, 0.f}, s1 = {0.f, 0.f, 0.f, 0.f};
                s0 = __builtin_amdgcn_mfma_f32_16x16x32_bf16(kf[0][0], Qf[j][0], s0, 0, 0, 0); s0 = __builtin_amdgcn_mfma_f32_16x16x32_bf16(kf[0][1], Qf[j][1], s0, 0, 0, 0);
                s1 = __builtin_amdgcn_mfma_f32_16x16x32_bf16(kf[1][0], Qf[j][0], s1, 0, 0, 0); s1 = __builtin_amdgcn_mfma_f32_16x16x32_bf16(kf[1][1], Qf[j][1], s1, 0, 0, 0);
                float sv[8];
                if (isloc) { const float* rb = rpbl + (kr - (r0 + j) + 7) * 32;
#pragma unroll
                    for (int e = 0; e < 4; ++e) { sv[e] = s0[e] * SC + rb[bidx[e]]; sv[4 + e] = s1[e] * SC + rb[bidx[4 + e]]; }
                } else {
#pragma unroll
                    for (int e = 0; e < 4; ++e) { sv[e] = s0[e] * SC; sv[4 + e] = s1[e] * SC; }
                }
                float cmax = fmaxf(fmaxf(fmaxf(sv[0], sv[1]), fmaxf(sv[2], sv[3])), fmaxf(fmaxf(sv[4], sv[5]), fmaxf(sv[6], sv[7])));
                cmax = fmaxf(cmax, shx(cmax, 16, lane)); cmax = fmaxf(cmax, shx(cmax, 32, lane));
                const float mn = fmaxf(m[j], cmax); const bool moved = __builtin_amdgcn_ballot_w64(mn > m[j]) != 0ull;
                float pv[8], psum = 0.f;
#pragma unroll
                for (int e = 0; e < 8; ++e) { pv[e] = __builtin_amdgcn_exp2f(sv[e] - mn); psum += pv[e]; }
                if (moved) { const float alpha = __builtin_amdgcn_exp2f(m[j] - mn); m[j] = mn; ls[j] *= alpha;
#pragma unroll
                    for (int dt = 0; dt < 4; ++dt) O[j][dt] *= alpha; }
                ls[j] += psum;
                union { u32x4 u; bf16x8 v; } pf;
                pf.u.x = cvt_pk_bf16(pv[0], pv[1]); pf.u.y = cvt_pk_bf16(pv[2], pv[3]); pf.u.z = cvt_pk_bf16(pv[4], pv[5]); pf.u.w = cvt_pk_bf16(pv[6], pv[7]);
#pragma unroll
                for (int dt = 0; dt < 4; ++dt) O[j][dt] = __builtin_amdgcn_mfma_f32_16x16x32_bf16(vf[dt], pf.v, O[j][dt], 0, 0, 0);
            }
        }
#pragma unroll
        for (int hh = 0; hh < 2; ++hh)
#pragma unroll
            for (int ds = 0; ds < 2; ++ds) kf[hh][ds] = kfn[hh][ds];
#pragma unroll
        for (int dt = 0; dt < 4; ++dt) vf[dt] = vfn[dt];
    }
#pragma unroll
    for (int j = 0; j < 4; ++j) { float lt = ls[j]; lt += shx(lt, 16, lane); lt += shx(lt, 32, lane); const float inv = 1.0f / lt;
        bf16_t* op = p.HB + (size_t)(b * SEQL + (r0 + j) * 64 + qt * 16 + q) * 1024 + 512 + h * 64 + 4 * g;
#pragma unroll
        for (int dt = 0; dt < 4; ++dt) { u32x2 o; o.x = cvt_pk_bf16(O[j][dt][0] * inv, O[j][dt][1] * inv); o.y = cvt_pk_bf16(O[j][dt][2] * inv, O[j][dt][3] * inv); *(u32x2*)(op + 16 * dt) = o; } }
}
__device__ void attn_block_main(const Params& p, int wid_s, int l, int bt, unsigned char* smem) {
    int tid_ = my_tid(wid_s); const int tid = tid_, w = tid >> 6;
    float* rp = (float*)smem;
    const int wt = bt * 8 + w, qt = wt & 3, rg = (wt >> 2) & 15, h = (wt >> 6) & 7, b = wt >> 9;
    { const int c = (bt == 100 && l == 0) ? 0 : 1; PROBE_MARK(8); }
    if (tid < 480) { const int rr = tid >> 5, cc = tid & 31; rp[tid] = cc < 31 ? p.na_rpb[(size_t)(l * 8 + h) * 465 + rr * 31 + cc] * 1.4426950408889634f : -1e30f; }
    __syncthreads();
    attn_wave4(p, wid_s, l, b, h, qt, rg, rp);
    __syncthreads(); { const int c = (bt == 100 && l == 0) ? 0 : 1; PROBE_MARK(9); }
}
__device__ void attn_block_ctx(const Params& p, int wid_s, int l, int bt, unsigned char* smem) {
    int tid_ = my_tid(wid_s); const int tid = tid_, w = tid >> 6;
    const int wt = bt * 8 + w, qt = wt & 15, h = (wt >> 4) & 7, b = wt >> 7;
    attn_wave<false>(p, wid_s, l, b, 0, h, qt, (const float*)smem);
}

__global__ __launch_bounds__(512, 2) void mega_kernel(Params p) {
    extern __shared__ __attribute__((aligned(16))) unsigned char smem[];
    if (p.BAR == nullptr) cg::this_grid().sync();
    const int wid_s = __builtin_amdgcn_readfirstlane((int)(threadIdx.x >> 6));
#ifndef NO_PREP
    if (threadIdx.x == 0) { *(volatile LAS unsigned*)(smem + LDS_CTL) = 0u; *(volatile LAS unsigned*)(smem + LDS_CTL + 4) = 0u; }
    __syncthreads();
    const XcdBarrier xb = xcd_barrier_post(p.BAR, (volatile LAS unsigned*)(smem + LDS_CTL));
#ifdef PROBE_SEL
#define PHASE_MARK(k) do { if (blockIdx.x == 0 && my_tid(wid_s) == 0) __hip_atomic_store(p.BAR + 96 + (k), (unsigned)__builtin_amdgcn_s_memrealtime(), __ATOMIC_RELAXED, __HIP_MEMORY_SCOPE_AGENT); } while (0)
#else
#define PHASE_MARK(k) do {} while (0)
#endif
    int phase_ctr = 16;
#define GSYNC() do { xcd_barrier(xb, wid_s); PHASE_MARK(phase_ctr); ++phase_ctr; } while (0)
    prep_phase<0>(p, wid_s, smem);
#endif
    xcd_barrier(xb, wid_s);
    PHASE_MARK(15);
#ifdef REP_SYNC
    for (int i = 0; i < 10; ++i) GSYNC();
#endif
    for (int l = 0; l < 2; ++l) {
        const int Mff = (l == 0) ? MALL : MMAIN;
        const float* modl = p.MOD + (size_t)l * 5 * 6144;
        norm_phase(p, wid_s, l, 0, MALL, l == 0);
        if (l == 0) taps_phase(p, wid_s, 0, 0);
#ifdef REP_NORM
        norm_phase(p, wid_s, l, 0, MALL, l == 0);
#endif
        GSYNC();
        { EpiIn E; E.hyu = p.HYU; E.hyuc = p.HYUC; E.fnb = p.FNB; E.fnbc = p.FNBC; E.qk = p.QK; E.vt = p.VT; E.vtc = p.VTC;
          run_gemm(wid_s, smem, p.HB, p.WIN + (size_t)l * NPROJ * 1024, MALL, NPROJ, 1024, E);
#ifdef REP_IN
          __syncthreads(); run_gemm(wid_s, smem, p.HB, p.WIN + (size_t)l * NPROJ * 1024, MALL, NPROJ, 1024, E);
#endif
 }
        GSYNC();
        if (l == 0) { EpiFn E; E.mix = p.HB; E.rowbase = MMAIN; E.Lr = CTXL; run_gemm(wid_s, smem, p.DFTC, p.FNBC, CTXL, 1024, 512, E); }
        {
            unsigned* qctr = p.BAR + 64 * l;
            const int ntot = (l == 0) ? 1088 : 768;
            for (;;) {
                __syncthreads();
                if (my_tid(wid_s) == 0) *(volatile LAS unsigned*)(smem + LDS_CTL + 8) = __hip_atomic_fetch_add(qctr, 1u, __ATOMIC_RELAXED, __HIP_MEMORY_SCOPE_AGENT);
                __syncthreads();
                const int task = __builtin_amdgcn_readfirstlane((int)*(volatile LAS unsigned*)(smem + LDS_CTL + 8));
                if (task >= ntot) break;
                if (task < 256) hyena_mfma(p, wid_s, l, task, smem);
                else if (task < 512) attn_block_main(p, wid_s, l, task - 256, smem);
                else if (task < 768) fnet_task(p, wid_s, task - 512, smem);
                else if (task < 1024) hyena_naive<CTXL>(p, wid_s, l, task - 768, smem);
                else attn_block_ctx(p, wid_s, l, task - 1024, smem);
            }
        }
        GSYNC();
        if (l == 0) { EpiResT<true> E; E.res_main = p.x; E.res_ctx = p.ctx; E.xb = p.XB; E.gate = modl + 2048;
          run_gemm(wid_s, smem, p.HB, p.WOUT + (size_t)l * 1024 * 1024, Mff, 1024, 1024, E); }
        else { EpiResT<false> E; E.res_main = nullptr; E.res_ctx = nullptr; E.xb = p.XB; E.gate = modl + 2048;
          run_gemm(wid_s, smem, p.HB, p.WOUT + (size_t)l * 1024 * 1024, Mff, 1024, 1024, E); }
        if (l == 0) taps_phase(p, wid_s, 1, 16);
        GSYNC();
        norm_phase(p, wid_s, l, 1, Mff, false);
        GSYNC();
        { EpiGU E; E.act = p.ACT; run_gemm(wid_s, smem, p.HB, p.WGU + (size_t)l * 5632 * 1024, Mff, 5632, 1024, E);
#ifdef REP_GU
          __syncthreads(); run_gemm(wid_s, smem, p.HB, p.WGU + (size_t)l * 5632 * 1024, Mff, 5632, 1024, E);
#endif
 }
        GSYNC();
        { EpiResT<false> E; E.res_main = nullptr; E.res_ctx = nullptr; E.xb = p.XB; E.gate = modl + 5120;
          run_gemm(wid_s, smem, p.ACT, p.WDN + (size_t)l * 1024 * DFF, Mff, 1024, DFF, E); }
        if (l == 0) { __syncthreads(); prep_phase<2>(p, wid_s, smem); __syncthreads(); prep_phase<1>(p, wid_s, smem); }
        GSYNC();
    }
    final_norm(p, wid_s);
}

extern "C" void kernel_launch(void* const* d_in, const int* in_sizes, int n_in, void* d_out, int out_size, void* d_ws, size_t ws_size, hipStream_t stream) {
    (void)in_sizes; (void)n_in; (void)out_size;
    static int grid_blocks = 0;
    if (!grid_blocks) {
        int dev = 0, cus = 0, per_cu = 0;
        hipGetDevice(&dev);
        hipDeviceGetAttribute(&cus, hipDeviceAttributeMultiprocessorCount, dev);
        hipFuncSetAttribute((const void*)mega_kernel, hipFuncAttributeMaxDynamicSharedMemorySize, LDS_BYTES);
        hipOccupancyMaxActiveBlocksPerMultiprocessor(&per_cu, mega_kernel, 512, LDS_BYTES);
        if (per_cu < 1) per_cu = 1;
        if (per_cu > 1) per_cu = 1;
        grid_blocks = cus * per_cu;
    }
    Params p{};
    const float* const* in = (const float* const*)d_in;
    p.x = in[0]; p.c = in[1]; p.ctx = in[2]; p.c_ctx = in[3]; p.w_mod = in[4]; p.b_mod = in[5]; p.norm1_g = in[6]; p.norm2_g = in[7]; p.w_in = in[8]; p.w_out = in[9];
    p.hy_conv_w = in[10]; p.hy_conv_b = in[11]; p.filt_w1 = in[12]; p.filt_b1 = in[13]; p.filt_freq = in[14]; p.filt_w2 = in[15]; p.filt_b2 = in[16]; p.filt_w3 = in[17];
    p.hy_skip = in[18]; p.na_rpb = in[19]; p.w_gate = in[20]; p.w_up = in[21]; p.w_down = in[22]; p.final_g = in[23];
    p.out = (float*)d_out;
    unsigned char* ws = (unsigned char*)d_ws; size_t off = 0;
    auto take = [&](size_t bytes) { unsigned char* r = ws + off; off += (bytes + 255) & ~(size_t)255; return r; };
    p.WIN = (bf16_t*)take((size_t)2 * NPROJ * 1024 * 2);
    p.WOUT = (bf16_t*)take((size_t)2 * 1024 * 1024 * 2);
    p.WGU = (bf16_t*)take((size_t)2 * 5632 * 1024 * 2);
    p.WDN = (bf16_t*)take((size_t)2 * 1024 * DFF * 2);
    p.DFT = nullptr;
    p.FM1 = (bf16_t*)take((size_t)128 * 128 * 2);
    p.FM2 = (bf16_t*)take((size_t)64 * 128 * 2);
    p.DFTC = (bf16_t*)take((size_t)256 * 512 * 2);
    p.MOD = (float*)take((size_t)2 * 5 * 6144 * 4);
    p.H2F = (float*)take((size_t)2 * 4096 * 64 * 4);
    p.H2C = (float*)take((size_t)256 * 64 * 4);
    p.XRC = nullptr;
    p.XB = (bf16_t*)take((size_t)MALL * 1024 * 2);
    p.HB = (bf16_t*)take((size_t)MALL * 1024 * 2);
    p.TAPS2 = nullptr;
    p.TAPS = (bf16_t*)take((size_t)2 * 2 * 256 * 8192 * 2);
    p.NRM = (float*)take((size_t)2048 * 4);
    p.BAR = (unsigned*)take((size_t)XCD_BAR_WORDS * 4);
    unsigned char* big = ws + off;
    p.ACT = (bf16_t*)big;
    size_t boff = 0;
    auto takeb = [&](size_t bytes) { unsigned char* r = big + boff; boff += (bytes + 255) & ~(size_t)255; return r; };
    p.HYU = (bf16_t*)takeb((size_t)NB * 768 * SEQL * 2);
    p.HYUC = (bf16_t*)takeb((size_t)NB * 768 * CTXL * 2);
    p.FNB = (bf16_t*)takeb((size_t)1024 * 8192 * 2);
    p.FNBC = (bf16_t*)takeb((size_t)1024 * 512 * 2);
    p.QK = (bf16_t*)takeb((size_t)MALL * 1024 * 2);
    p.VT = (bf16_t*)takeb((size_t)NB * 512 * SEQL * 2);
    p.VTC = (bf16_t*)takeb((size_t)NB * 512 * CTXL * 2);
    const size_t actb = (size_t)MALL * DFF * 2;
    const size_t need = off + (boff > actb ? boff : actb);
    if (need > ws_size) { fprintf(stderr, "workspace too small: need %zu have %zu\n", need, ws_size); return; }
    hipMemsetAsync(p.BAR, 0, (size_t)XCD_BAR_WORDS * 4, stream);
    void* args[] = {&p};
    hipError_t e = hipLaunchCooperativeKernel((const void*)mega_kernel, dim3(grid_blocks), dim3(512), args, LDS_BYTES, stream);
    if (e != hipSuccess) fprintf(stderr, "cooperative launch failed: %s (grid %d)\n", hipGetErrorString(e), grid_blocks);
}
```

```cpp
#include <hip/hip_runtime.h>
#include <hip/hip_cooperative_groups.h>
#include <cstdio>
namespace cg = cooperative_groups;
#include <cstdint>

#define XB_TMO      128
#define XB_XCNT(j)  (256  + 64 * (j))
#define XB_XSUB(j)  (1280 + 64 * (j))
#define XB_XGEN(j)  (2304 + 64 * (j))
#define XB_TOP      3328
#define XB_TOPGEN   3392
#define XCD_BAR_WORDS 3456
#define XB_SPIN_CAP (1u << 18)
#define LAS __attribute__((address_space(3)))

__device__ __forceinline__ unsigned xb_ld(unsigned* p)              { return __hip_atomic_load(p, __ATOMIC_RELAXED, __HIP_MEMORY_SCOPE_AGENT); }
__device__ __forceinline__ unsigned xb_add(unsigned* p, unsigned v) { return __hip_atomic_fetch_add(p, v, __ATOMIC_RELAXED, __HIP_MEMORY_SCOPE_AGENT); }
__device__ __forceinline__ unsigned xb_xcc_id() { return (unsigned)__builtin_amdgcn_s_getreg((3 << 11) | 20) & 0xFu; }
#define XB_SPIN(cond, bar) do { unsigned _sp = 0; while (cond) { __builtin_amdgcn_s_sleep(1); \
    if ((++_sp & 255u) == 0u) { if (xb_ld(&(bar)[XB_TMO])) break; if (_sp > XB_SPIN_CAP) { atomicAdd(&(bar)[XB_TMO], 1u); break; } } } } while (0)

struct XcdBarrier {
    unsigned* bar; unsigned x;
    volatile LAS unsigned* st;
};

__device__ __forceinline__ XcdBarrier xcd_barrier_post(unsigned* bar, volatile LAS unsigned* st) {
    XcdBarrier b; b.bar = bar; b.x = xb_xcc_id(); b.st = st;
    if (threadIdx.x == 0) (void)xb_add(&bar[XB_XCNT(b.x)], 1u);
    return b;
}
__device__ __forceinline__ void xcd_barrier_complete(unsigned* bar, unsigned x, unsigned& nloc, unsigned& nx) {
    const unsigned G = gridDim.x * gridDim.y * gridDim.z;
    unsigned sum, cnt, mine, sp = 0u;
    for (;;) {
        sum = 0u; cnt = 0u; mine = 0u;
#pragma unroll
        for (unsigned j = 0; j < 16; ++j) { const unsigned c = xb_ld(&bar[XB_XCNT(j)]); sum += c; cnt += (c > 0u) ? 1u : 0u; mine = (j == x) ? c : mine; }
        if (sum == G) break;
        __builtin_amdgcn_s_sleep(1);
        if ((++sp & 255u) == 0u) { if (xb_ld(&bar[XB_TMO])) break; if (sp > XB_SPIN_CAP) { atomicAdd(&bar[XB_TMO], 1u); break; } }
    }
    nloc = mine > 0u ? mine : 1u; nx = cnt > 0u ? cnt : 1u;
}
__device__ __forceinline__ void xcd_barrier(const XcdBarrier& b, int wid_s) {
    asm volatile("s_waitcnt vmcnt(0)" ::: "memory");
    __syncthreads();
    int ln; asm volatile("v_mbcnt_lo_u32_b32 %0, -1, 0\n\tv_mbcnt_hi_u32_b32 %0, -1, %0" : "=v"(ln));
    if (wid_s == 0 && ln == 0) {
        unsigned* bar = b.bar; unsigned bx = b.x; asm volatile("" : "+s"(bar), "+s"(bx));
        __builtin_amdgcn_s_waitcnt(0);
        unsigned nloc = b.st[0], nx = b.st[1];
        if (nloc == 0u) { xcd_barrier_complete(bar, bx, nloc, nx); b.st[0] = nloc; b.st[1] = nx; }
        const unsigned old = xb_add(&bar[XB_XSUB(bx)], 1u);
        const unsigned gen = old / nloc;
        if (old + 1u == (gen + 1u) * nloc) {
            __builtin_amdgcn_fence(__ATOMIC_RELEASE, "agent");
            asm volatile("s_waitcnt vmcnt(0)" ::: "memory");
            const unsigned og = xb_add(&bar[XB_TOP], 1u);
            const unsigned tg = og / nx;
            if (og + 1u == (tg + 1u) * nx) xb_add(&bar[XB_TOPGEN], 1u);
            else XB_SPIN(xb_ld(&bar[XB_TOPGEN]) == tg, bar);
            __builtin_amdgcn_fence(__ATOMIC_ACQUIRE, "agent");
            xb_add(&bar[XB_XGEN(bx)], 1u);
            asm volatile("s_waitcnt vmcnt(0)" ::: "memory");
        } else {
            XB_SPIN(xb_ld(&bar[XB_XGEN(bx)]) == gen, bar);
            __builtin_amdgcn_fence(__ATOMIC_ACQUIRE, "agent");
            asm volatile("s_waitcnt vmcnt(0)" ::: "memory");
        }
    }
    __syncthreads();
}
namespace pg8 {
#define PG8_LAS __attribute__((address_space(3)))
typedef unsigned short bf16_t;
typedef short bf16x8 __attribute__((ext_vector_type(8)));
typedef float f32x4 __attribute__((ext_vector_type(4)));
typedef unsigned u32x4 __attribute__((ext_vector_type(4)));
constexpr int BM = 256, BK = 64, HALF = 128, HTB = HALF * BK * 2  , STAGE_BYTES = 8 * HTB, NXCD = 8, WGM = 8;

__host__ __device__ __forceinline__ int lds_byte(int r, int c) { const int st = (r >> 4) * 2 + (c >> 5), rr = r & 15, cc = c & 31, ob = rr * 64 + cc * 2; return st * 1024 + (ob ^ (((ob >> 9) & 1) << 5)); }
__host__ __device__ __forceinline__ void stage_rc(int b, int& R, int& C) { const int st = b / 1024, sb = b % 1024, swz = sb ^ (((sb >> 9) & 1) << 5); R = (st >> 1) * 16 + swz / 64; C = (st & 1) * 32 + (swz % 64) / 2; }
__host__ __device__ __forceinline__ int perm32(int rho) { const int n = rho >> 4, i = rho & 15; return 8 * (i >> 2) + 4 * n + (i & 3); }

struct Unit { int pm, pn, pk; };
struct Gemm { const bf16_t* A; const bf16_t* Bt; int M, N, K, wid_s, ld; };

struct StaticOrder {
    int nM, nN, nwg, G, c;
    __host__ __device__ void init(int M, int N, int G_, int c_) { nM = M / BM; nN = N / BM; nwg = nM * nN; G = G_; c = c_; }
    __host__ __device__ bool next(int i, Unit& u) const {
        const long L = (long)i * G + c; if (L >= nwg) return false;
        int wgid = (int)L; { const int q = nwg / NXCD, r = nwg % NXCD, xcd = wgid % NXCD, off = wgid / NXCD; wgid = (xcd < r ? xcd * (q + 1) : r * (q + 1) + (xcd - r) * q) + off; }
        const int nig = WGM * nN, gid = wgid / nig, fm = gid * WGM, gsz = (nM - fm) < WGM ? (nM - fm) : WGM;
        u.pm = fm + ((wgid % nig) % gsz); u.pn = (wgid % nig) / gsz; u.pk = 0; return true;
    }
    __device__ __forceinline__ void a_ready(const Unit&) const {}
    __device__ __forceinline__ void done(const Unit&) const {}
};
struct SplitOrder {
    int nM, nN, nK, nwg, G, c;
    __host__ __device__ void init(int M, int N, int nK_, int G_, int c_) { nM = M / BM; nN = N / BM; nK = nK_; nwg = nM * nN * nK; G = G_; c = c_; }
    __host__ __device__ bool next(int i, Unit& u) const { const long L = (long)i * G + c; if (L >= nwg) return false; const int w = (int)L; u.pk = w % nK; const int r = w / nK; u.pn = r % nN; u.pm = r / nN; return true; }
    __device__ __forceinline__ void a_ready(const Unit&) const {}
    __device__ __forceinline__ void done(const Unit&) const {}
};
__device__ __forceinline__ unsigned cvt_pk_bf16(float lo, float hi) { unsigned r; asm volatile("v_cvt_pk_bf16_f32 %0, %1, %2" : "=v"(r) : "v"(lo), "v"(hi)); return r; }
typedef float f32x2 __attribute__((ext_vector_type(2)));
template <class Epi, class Sched, bool STAMP = false>
__device__ __forceinline__ void gemm_phase(PG8_LAS unsigned char* lds, const Gemm g, const Sched& S, const Epi& E, unsigned long long* stamps) {
    int ln_; asm volatile("v_mbcnt_lo_u32_b32 %0, -1, 0\n\tv_mbcnt_hi_u32_b32 %0, -1, %0" : "=v"(ln_)); int tid_ = g.wid_s * 64 + ln_; const int tid = tid_, wid = __builtin_amdgcn_readfirstlane(tid >> 6), lane = tid & 63, wr = wid >> 2, wc = wid & 3, fr = lane & 15, fq = lane >> 4;
    int K_ = g.K, LD_ = g.ld; asm volatile("" : "+s"(K_), "+s"(LD_)); const int K = K_, LD = LD_, nt = K / BK;
    int ts_lo = 0, ts_hi = 0, nts = 0; const unsigned long long rt_entry = STAMP ? (unsigned long long)wall_clock64() : 0ull;
#define PG8_STAMP() do { if (STAMP && wid == 0 && nts < 64) { const unsigned long long _c = (unsigned long long)clock64(); \
        ts_lo = (lane == nts) ? (int)(unsigned)_c : ts_lo; ts_hi = (lane == nts) ? (int)(unsigned)(_c >> 32) : ts_hi; ++nts; } } while (0)
    PG8_STAMP();
    unsigned voffA[2], voffB[2];
#pragma unroll
    for (int i = 0; i < 2; ++i) { int R, C; stage_rc(tid * 16 + i * 8192, R, C); const int Rb = Epi::PERM ? ((R & ~31) + perm32(R & 31)) : R;
        voffA[i] = (unsigned)(R * LD + C) * 2u; voffB[i] = (unsigned)(Rb * LD + C) * 2u; }
    const size_t kstep = (size_t)(BK * 2);
    const size_t hstep = (size_t)HALF * LD * 2;
    const size_t tstep = 2 * hstep;
    const unsigned ldsw = (unsigned)wid * 1024u;
    const int aoff = lds_byte(wr * 64 + fr, fq * 8), boff = lds_byte(wc * 32 + fr, fq * 8);
#define PG8_SA(b, h) (((b) * 2 + (h)) * HTB)
#define PG8_SB(b, h) ((4 + (b) * 2 + (h)) * HTB)
#define PG8_STAGE(bufoff, gbase, voff) do { _Pragma("unroll") for (int _i = 0; _i < 2; ++_i) \
        __builtin_amdgcn_global_load_lds((const unsigned*)((const char*)(gbase) + (voff)[_i]), (PG8_LAS unsigned*)(lds + (bufoff) + ldsw + _i * 8192), 16, 0, 0); } while (0)
#define PG8_LDA(dst, b, h) do { _Pragma("unroll") for (int m = 0; m < 4; ++m) _Pragma("unroll") for (int k = 0; k < 2; ++k) dst[m][k] = *(const PG8_LAS bf16x8*)(lds + PG8_SA(b, h) + aoff + m * 2048 + k * 1024); } while (0)
#define PG8_LDB(dst, b, h) do { _Pragma("unroll") for (int n = 0; n < 2; ++n) _Pragma("unroll") for (int k = 0; k < 2; ++k) dst[n][k] = *(const PG8_LAS bf16x8*)(lds + PG8_SB(b, h) + boff + n * 2048 + k * 1024); } while (0)
#define PG8_MMA(ai, bj, At, Bt) do { __builtin_amdgcn_s_setprio(1); _Pragma("unroll") for (int m = 0; m < 4; ++m) _Pragma("unroll") for (int n = 0; n < 2; ++n) _Pragma("unroll") for (int k = 0; k < 2; ++k) \
        acc[ai][bj][m][n] = __builtin_amdgcn_mfma_f32_16x16x32_bf16(Bt[n][k], At[m][k], acc[ai][bj][m][n], 0, 0, 0); __builtin_amdgcn_s_setprio(0); } while (0)
#define PG8_WAIT_V(n) asm volatile("s_waitcnt vmcnt(" #n ")" ::: "memory")
#define PG8_WAIT_L(n) asm volatile("s_waitcnt lgkmcnt(" #n ")" ::: "memory")
#define PG8_BAR __builtin_amdgcn_s_barrier()
#define PG8_SCHED __builtin_amdgcn_sched_barrier(0)
    Unit cur, nxt; int ui = 0;
    if (!S.next(0, cur)) return;
    f32x4 acc[2][2][4][2];
#pragma unroll
    for (int a = 0; a < 2; ++a)
#pragma unroll
        for (int b = 0; b < 2; ++b)
#pragma unroll
            for (int m = 0; m < 4; ++m)
#pragma unroll
                for (int n = 0; n < 2; ++n) acc[a][b][m][n] = (f32x4){0.f, 0.f, 0.f, 0.f};
    bf16x8 At[4][2], B0[2][2], B1[2][2];
    const size_t kchunk = (size_t)K * 2;
    const char* cA = (const char*)g.A + (size_t)cur.pm * tstep + (size_t)cur.pk * kchunk; const char* cB = (const char*)g.Bt + (size_t)cur.pn * tstep + (size_t)cur.pk * kchunk;
    S.a_ready(cur);
    PG8_STAGE(PG8_SB(0, 0), cB, voffB); PG8_STAGE(PG8_SA(0, 0), cA, voffA); PG8_STAGE(PG8_SB(0, 1), cB + hstep, voffB); PG8_STAGE(PG8_SA(0, 1), cA + hstep, voffA);
    if (wr == 1) PG8_BAR;
    PG8_WAIT_V(4); PG8_BAR;
    PG8_STAGE(PG8_SB(1, 0), cB + kstep, voffB); PG8_STAGE(PG8_SA(1, 0), cA + kstep, voffA); PG8_STAGE(PG8_SB(1, 1), cB + hstep + kstep, voffB);
    PG8_WAIT_V(6); PG8_BAR;
    PG8_STAMP();
    for (;;) {
        const bool has_next = S.next(ui + 1, nxt);
        const char* nA = has_next ? (const char*)g.A + (size_t)nxt.pm * tstep + (size_t)nxt.pk * kchunk : cA; const char* nB = has_next ? (const char*)g.Bt + (size_t)nxt.pn * tstep + (size_t)nxt.pk * kchunk : cB;
        for (int t = 0; t < nt; t += 2) {
            const bool last = (t == nt - 2);
            const char* a1 = cA + (size_t)(t + 1) * kstep;
            const char* a2 = last ? nA : cA + (size_t)(t + 2) * kstep; const char* b2 = last ? nB : cB + (size_t)(t + 2) * kstep;
            const char* a3 = a2 + kstep; const char* b3 = b2 + kstep;
            if (last && has_next) S.a_ready(nxt);
            PG8_LDB(B0, 0, 0); PG8_SCHED; PG8_LDA(At, 0, 0); PG8_STAGE(PG8_SA(1, 1), a1 + hstep, voffA);
            PG8_WAIT_L(8); PG8_BAR; PG8_WAIT_L(0); PG8_MMA(0, 0, At, B0); PG8_BAR; PG8_SCHED;
            PG8_LDB(B1, 0, 1); PG8_STAGE(PG8_SB(0, 0), b2, voffB);
            PG8_BAR; PG8_WAIT_L(0); PG8_MMA(0, 1, At, B1); PG8_BAR;
            PG8_LDA(At, 0, 1); PG8_STAGE(PG8_SA(0, 0), a2, voffA);
            PG8_BAR; PG8_WAIT_L(0); PG8_MMA(1, 0, At, B0); PG8_BAR; PG8_SCHED;
            PG8_STAGE(PG8_SB(0, 1), b2 + hstep, voffB);
            PG8_WAIT_V(6); PG8_BAR; PG8_MMA(1, 1, At, B1); PG8_BAR;
            PG8_LDB(B0, 1, 0); PG8_SCHED; PG8_LDA(At, 1, 0); PG8_STAGE(PG8_SA(0, 1), a2 + hstep, voffA);
            PG8_WAIT_L(8); PG8_BAR; PG8_WAIT_L(0); PG8_MMA(0, 0, At, B0); PG8_BAR; PG8_SCHED;
            PG8_LDB(B1, 1, 1); PG8_STAGE(PG8_SB(1, 0), b3, voffB);
            PG8_BAR; PG8_WAIT_L(0); PG8_MMA(0, 1, At, B1); PG8_BAR;
            PG8_LDA(At, 1, 1); PG8_STAGE(PG8_SA(1, 0), a3, voffA);
            PG8_BAR; PG8_WAIT_L(0); PG8_MMA(1, 0, At, B0); PG8_BAR; PG8_SCHED;
            PG8_STAGE(PG8_SB(1, 1), b3 + hstep, voffB);
            PG8_WAIT_V(6); PG8_BAR; PG8_MMA(1, 1, At, B1); PG8_BAR;
        }
        PG8_STAMP();
        if constexpr (!Epi::AFTER_DRAIN) { E(acc, cur, wr, wc, fr, fq); S.done(cur); }
        PG8_STAMP();
        if (!has_next) break;
#pragma unroll
        for (int a = 0; a < 2; ++a)
#pragma unroll
            for (int b = 0; b < 2; ++b)
#pragma unroll
                for (int m = 0; m < 4; ++m)
#pragma unroll
                    for (int n = 0; n < 2; ++n) acc[a][b][m][n] = (f32x4){0.f, 0.f, 0.f, 0.f};
        cur = nxt; cA = nA; cB = nB; ++ui;
    }
    PG8_WAIT_V(0);
    if (wr == 0) PG8_BAR;
    PG8_BAR;
    if constexpr (Epi::AFTER_DRAIN) { E.fused(acc, cur, wr, wc, fr, fq, lds, wid, lane); S.done(cur); }
    PG8_STAMP();
    if (STAMP && wid == 0) { stamps[lane] = lane < nts ? (((unsigned long long)(unsigned)ts_hi << 32) | (unsigned)ts_lo) : 0ull;
        if (lane == 62) stamps[62] = rt_entry; if (lane == 63) stamps[63] = (unsigned long long)wall_clock64(); }
#undef PG8_STAMP
#undef PG8_SA
#undef PG8_SB
#undef PG8_STAGE
#undef PG8_LDA
#undef PG8_LDB
#undef PG8_MMA
#undef PG8_WAIT_V
#undef PG8_WAIT_L
#undef PG8_BAR
#undef PG8_SCHED
}
}

using pg8::bf16_t; using pg8::bf16x8; using pg8::f32x4; using pg8::u32x4; using pg8::Unit; using pg8::cvt_pk_bf16;
typedef unsigned u32x2 __attribute__((ext_vector_type(2)));
#define LAS3 __attribute__((address_space(3)))

constexpr int DM = 1024, SEQL = 4096, NB = 4, CTXL = 256, DFF = 2816, NPROJ = 2816  ;
constexpr int MMAIN = NB * SEQL  , MCTX = NB * CTXL  , MALL = MMAIN + MCTX  ;
constexpr int LDS_CTL = 139264;
constexpr int LDS_BYTES = LDS_CTL + 16;

struct Params {
    const float *x, *c, *ctx, *c_ctx, *w_mod, *b_mod, *norm1_g, *norm2_g, *w_in, *w_out, *hy_conv_w, *hy_conv_b, *filt_w1, *filt_b1, *filt_freq, *filt_w2, *filt_b2, *filt_w3,
        *hy_skip, *na_rpb, *w_gate, *w_up, *w_down, *final_g;
    float* out;
    bf16_t *WIN, *WOUT, *WGU, *WDN;
    bf16_t *DFT, *DFTC;
    float *MOD, *H2F, *H2C, *XRC;
    bf16_t* XB;
    bf16_t *HB;
    bf16_t *HYU, *HYUC, *FNB, *FNBC, *QK, *VT, *VTC, *ACT, *TAPS2;
    unsigned* BAR;
    bf16_t *FM1, *FM2;
    bf16_t* TAPS;
    float* NRM;
};

__device__ __forceinline__ float shx(float v, int o, int lane) { return __int_as_float(__builtin_amdgcn_ds_bpermute((lane ^ o) << 2, __float_as_int(v))); }
__device__ __forceinline__ int my_tid(int wid_s) { int ln; asm volatile("v_mbcnt_lo_u32_b32 %0, -1, 0\n\tv_mbcnt_hi_u32_b32 %0, -1, %0" : "=v"(ln)); return wid_s * 64 + ln; }
__device__ __forceinline__ int perm256(int lc) { return 64 * ((lc >> 5) & 3) + 16 * ((lc >> 2) & 3) + 8 * (lc >> 7) + 4 * ((lc >> 4) & 1) + (lc & 3); }
__device__ __forceinline__ float silu_f(float x) { return x * __builtin_amdgcn_rcpf(1.0f + __builtin_amdgcn_exp2f(-1.4426950408889634f * x)); }
__device__ __forceinline__ bf16_t f2bf(float f) { unsigned u = __float_as_uint(f); u += 0x7FFFu + ((u >> 16) & 1u); return (bf16_t)(u >> 16); }
__device__ __forceinline__ float bf2f(bf16_t b) { return __uint_as_float(((unsigned)b) << 16); }

struct EpiIn {
    static constexpr bool PERM = false, AFTER_DRAIN = false;
    bf16_t *hyu, *hyuc, *fnb, *fnbc, *qk, *vt, *vtc;
    __device__ __forceinline__ void operator()(const f32x4 (&acc)[2][2][4][2], const Unit& u, int wr, int wc, int fr, int fq) const {
        const bool isctx = u.pm >= 64; const int L = isctx ? CTXL : SEQL;
        const int b = isctx ? (u.pm - 64) : (u.pm >> 4), posbase = isctx ? 0 : (u.pm & 15) * 256;
        const int pn = u.pn;
        if (pn >= 5 && pn < 9) {
            const int row0 = u.pm * 256 + wr * 64 + fr, col0 = (pn - 5) * 256 + wc * 32 + 8 * fq;
#pragma unroll
            for (int ai = 0; ai < 2; ++ai)
#pragma unroll
                for (int m = 0; m < 4; ++m) { bf16_t* rowp = qk + (size_t)(row0 + ai * 128 + m * 16) * 1024 + col0;
#pragma unroll
                    for (int bj = 0; bj < 2; ++bj) { const f32x4 v0 = acc[ai][bj][m][0], v1 = acc[ai][bj][m][1];
                        u32x4 w; w.x = cvt_pk_bf16(v0[0], v0[1]); w.y = cvt_pk_bf16(v0[2], v0[3]); w.z = cvt_pk_bf16(v1[0], v1[1]); w.w = cvt_pk_bf16(v1[2], v1[3]); *(u32x4*)(rowp + bj * 128) = w; } }
        } else {
            unsigned stride; int chan0, off;
            unsigned long long bh = (unsigned long long)(isctx ? hyuc : hyu), bf = (unsigned long long)(isctx ? fnbc : fnb), bv = (unsigned long long)(isctx ? vtc : vt);
            asm volatile("" : "+s"(bh), "+s"(bf), "+s"(bv));
            unsigned long long bsel = bv;
            if (pn < 3) { bsel = bh; chan0 = b * 768 + pn * 256; stride = (unsigned)L; off = 0; }
            else if (pn < 5) { bsel = bf; chan0 = b * 256; stride = (unsigned)(2 * L); off = (pn - 3) * L; }
            else { chan0 = b * 512 + (pn - 9) * 256; stride = (unsigned)L; off = 0; }
            asm volatile("" : "+s"(bsel));
            bf16_t* base = (bf16_t*)bsel;
            const unsigned eoff = (unsigned)(chan0 + wc * 32 + 4 * fq) * stride + (unsigned)(posbase + wr * 64 + fr + off);
#pragma unroll
            for (int bj = 0; bj < 2; ++bj)
#pragma unroll
                for (int n = 0; n < 2; ++n)
#pragma unroll
                    for (int e = 0; e < 4; ++e) { unsigned eo = eoff + (unsigned)(bj * 128 + n * 16 + e) * stride; asm volatile("" : "+v"(eo)); bf16_t* cp = base + eo;
#pragma unroll
                        for (int ai = 0; ai < 2; ++ai)
#pragma unroll
                            for (int m = 0; m < 4; m += 2) { const unsigned pk = cvt_pk_bf16(acc[ai][bj][m][n][e], acc[ai][bj][m + 1][n][e]); cp[ai * 128 + m * 16] = (bf16_t)(pk & 0xffffu); cp[ai * 128 + (m + 1) * 16] = (bf16_t)(pk >> 16); } }
        }
    }
};
template <bool RES_F32> struct EpiResT {
    static constexpr bool PERM = false, AFTER_DRAIN = false;
    const float *res_main, *res_ctx; bf16_t* xb; const float* gate;
    __device__ __forceinline__ void operator()(const f32x4 (&acc)[2][2][4][2], const Unit& u, int wr, int wc, int fr, int fq) const {
        const bool isctx = u.pm >= 64; const int bi = isctx ? 4 : (u.pm >> 4);
        const float* res = isctx ? res_ctx + (size_t)(u.pm - 64) * 256 * 1024 : res_main + (size_t)u.pm * 256 * 1024;
        bf16_t* dst = xb + (size_t)u.pm * 256 * 1024;
        const int col0 = u.pn * 256 + wc * 64 + 16 * fq; const float* gp = gate + bi * 6144 + col0;
        f32x4 gv[2][2];
#pragma unroll
        for (int bj = 0; bj < 2; ++bj)
#pragma unroll
            for (int n = 0; n < 2; ++n) gv[bj][n] = *(const f32x4*)(gp + bj * 8 + n * 4);
#pragma unroll
        for (int ai = 0; ai < 2; ++ai)
#pragma unroll
            for (int m = 0; m < 4; ++m) { const size_t ro = (size_t)(ai * 128 + wr * 64 + m * 16 + fr) * 1024 + col0;
#pragma unroll
                for (int bj = 0; bj < 2; ++bj) { f32x4 r0, r1;
                    if (RES_F32) { r0 = *(const f32x4*)(res + ro + bj * 8); r1 = *(const f32x4*)(res + ro + bj * 8 + 4); }
                    else { const u32x4 q = *(const u32x4*)(dst + ro + bj * 8);
                        r0[0] = __uint_as_float(q.x << 16); r0[1] = __uint_as_float(q.x & 0xffff0000u); r0[2] = __uint_as_float(q.y << 16); r0[3] = __uint_as_float(q.y & 0xffff0000u);
                        r1[0] = __uint_as_float(q.z << 16); r1[1] = __uint_as_float(q.z & 0xffff0000u); r1[2] = __uint_as_float(q.w << 16); r1[3] = __uint_as_float(q.w & 0xffff0000u); }
                    const f32x4 x0 = r0 + gv[bj][0] * acc[ai][bj][m][0], x1 = r1 + gv[bj][1] * acc[ai][bj][m][1];
                    u32x4 o; o.x = cvt_pk_bf16(x0[0], x0[1]); o.y = cvt_pk_bf16(x0[2], x0[3]); o.z = cvt_pk_bf16(x1[0], x1[1]); o.w = cvt_pk_bf16(x1[2], x1[3]); *(u32x4*)(dst + ro + bj * 8) = o; } }
    }
};
struct EpiGU {
    static constexpr bool PERM = false, AFTER_DRAIN = false;
    bf16_t* act;
    __device__ __forceinline__ void operator()(const f32x4 (&acc)[2][2][4][2], const Unit& u, int wr, int wc, int fr, int fq) const {
        const int row0 = u.pm * 256 + wr * 64 + fr, col0 = u.pn * 128 + wc * 32 + 8 * fq;
#pragma unroll
        for (int ai = 0; ai < 2; ++ai)
#pragma unroll
            for (int m = 0; m < 4; ++m) { bf16_t* rowp = act + (size_t)(row0 + ai * 128 + m * 16) * DFF + col0;
                float v[8];
#pragma unroll
                for (int n = 0; n < 2; ++n)
#pragma unroll
                    for (int e = 0; e < 4; ++e) v[n * 4 + e] = silu_f(acc[ai][0][m][n][e]) * acc[ai][1][m][n][e];
                u32x4 w; w.x = cvt_pk_bf16(v[0], v[1]); w.y = cvt_pk_bf16(v[2], v[3]); w.z = cvt_pk_bf16(v[4], v[5]); w.w = cvt_pk_bf16(v[6], v[7]);
                *(u32x4*)rowp = w; }
    }
};
struct EpiFn {
    static constexpr bool PERM = false, AFTER_DRAIN = false;
    bf16_t* mix; int rowbase, Lr;
    __device__ __forceinline__ void operator()(const f32x4 (&acc)[2][2][4][2], const Unit& u, int wr, int wc, int fr, int fq) const {
        const int row0 = rowbase + u.pn * Lr + u.pm * 256 + wr * 64 + fr, col0 = 256 + wc * 32 + 4 * fq;
#pragma unroll
        for (int ai = 0; ai < 2; ++ai)
#pragma unroll
            for (int m = 0; m < 4; ++m) { bf16_t* rowp = mix + (size_t)(row0 + ai * 128 + m * 16) * 1024 + col0;
#pragma unroll
                for (int bj = 0; bj < 2; ++bj)
#pragma unroll
                    for (int n = 0; n < 2; ++n) { const f32x4 v = acc[ai][bj][m][n]; u32x2 w; w.x = cvt_pk_bf16(v[0], v[1]); w.y = cvt_pk_bf16(v[2], v[3]); *(u32x2*)(rowp + bj * 128 + n * 16) = w; } }
    }
};

template <class Epi> __device__ __forceinline__ void run_gemm(int wid_s, unsigned char* smem, const bf16_t* A, const bf16_t* Bt, int M, int N, int K, const Epi& E) {
    pg8::Gemm g; g.A = A; g.Bt = Bt; g.M = M; g.N = N; g.K = K; g.wid_s = wid_s; g.ld = K;
    pg8::StaticOrder S; S.init(M, N, (int)gridDim.x, (int)blockIdx.x);
    pg8::gemm_phase<Epi, pg8::StaticOrder, false>((PG8_LAS unsigned char*)smem, g, S, E, nullptr);
}

struct EpiCtxAtomic {
    static constexpr bool PERM = false, AFTER_DRAIN = false;
    float* dst; const float* gate;
    __device__ __forceinline__ void operator()(const f32x4 (&acc)[2][2][4][2], const Unit& u, int wr, int wc, int fr, int fq) const {
        const int col0 = u.pn * 256 + wc * 32 + 4 * fq; float* d0 = dst + (size_t)u.pm * 256 * 1024;
        f32x4 gv[2][2];
#pragma unroll
        for (int bj = 0; bj < 2; ++bj)
#pragma unroll
            for (int n = 0; n < 2; ++n) gv[bj][n] = *(const f32x4*)(gate + col0 + bj * 128 + n * 16);
#pragma unroll
        for (int ai = 0; ai < 2; ++ai)
#pragma unroll
            for (int m = 0; m < 4; ++m) { float* rp = d0 + (size_t)(ai * 128 + wr * 64 + m * 16 + fr) * 1024 + col0;
#pragma unroll
                for (int bj = 0; bj < 2; ++bj)
#pragma unroll
                    for (int n = 0; n < 2; ++n) { const f32x4 v = gv[bj][n] * acc[ai][bj][m][n];
#pragma unroll
                        for (int e = 0; e < 4; ++e) __hip_atomic_fetch_add(rp + bj * 128 + n * 16 + e, v[e], __ATOMIC_RELAXED, __HIP_MEMORY_SCOPE_AGENT); } }
    }
};
template <class Epi> __device__ __forceinline__ void run_gemm_splitk(int wid_s, unsigned char* smem, const bf16_t* A, const bf16_t* Bt, int M, int N, int Kfull, int Kchunk, const Epi& E) {
    pg8::Gemm g; g.A = A; g.Bt = Bt; g.M = M; g.N = N; g.K = Kchunk; g.wid_s = wid_s; g.ld = Kfull;
    pg8::SplitOrder S; S.init(M, N, Kfull / Kchunk, (int)gridDim.x, (int)blockIdx.x);
    pg8::gemm_phase<Epi, pg8::SplitOrder, false>((PG8_LAS unsigned char*)smem, g, S, E, nullptr);
}

#ifdef PROBE_SEL
#define PREP_MARK(k) do { if (MODE == 0 && blockIdx.x == 5 && my_tid(wid_s) == 0) __hip_atomic_store(p.BAR + 96 + (k), (unsigned)__builtin_amdgcn_s_memrealtime(), __ATOMIC_RELAXED, __HIP_MEMORY_SCOPE_AGENT); } while (0)
#else
#define PREP_MARK(k) do {} while (0)
#endif
template <int MODE> __device__ void prep_phase(const Params& p, int wid_s, unsigned char* smem) {
    int tid_ = my_tid(wid_s); const int tid = tid_, lane = tid & 63, w = tid >> 6;
    float* tab = (float*)smem;
    float* tab64 = (float*)(smem + 16384);
    float* sv = (float*)(smem + 20480);
    float* red = (float*)(smem + 40960);
    const int bidx = MODE == 0 ? (int)blockIdx.x : (int)blockIdx.x - 16, nb = MODE == 0 ? (int)gridDim.x : (int)gridDim.x - 16;
    if (bidx < 0) return;
    for (int i = tid; i < 4096; i += 512) tab[i] = cospif((float)i * (1.0f / 2048.0f));
    if (tid < 64) tab64[tid] = cospif((float)tid * (1.0f / 32.0f));
    for (int i = tid; i < 5120; i += 512) { const int v = i >> 10, k = i & 1023; const float xv = v < 4 ? p.c[v * 1024 + k] : p.c_ctx[k]; sv[i] = xv / (1.0f + expf(-xv)); }
    __syncthreads();
    PREP_MARK(40);
    if (MODE != 1) {
        const int nl = lane, kg = w, lw = MODE == 0 ? 0 : 1;
#define WT_DESC(r, sp, ld, dst) do { \
            if ((r) < 704) { const int nt = (r) >> 4, kt = (r) & 15, n = nt * 64 + nl, k0 = kt * 64 + kg * 8; const int np = (n >= 1280 && n < 2304) ? ((n & ~31) + pg8::perm32(n & 31)) : n; const int src = np < 768 ? np : np - 256; \
                ld = 2560; sp = p.w_in + (size_t)lw * 1024 * 2560 + (size_t)k0 * 2560 + src; dst = p.WIN + (size_t)lw * NPROJ * 1024 + (size_t)n * 1024 + k0; } \
            else if ((r) < 960) { const int rr = (r) - 704, nt = rr >> 4, kt = rr & 15, n = nt * 64 + nl, k0 = kt * 64 + kg * 8; \
                ld = 1024; sp = p.w_out + (size_t)lw * 1024 * 1024 + (size_t)k0 * 1024 + ((n & ~255) + perm256(n & 255)); dst = p.WOUT + (size_t)lw * 1024 * 1024 + (size_t)n * 1024 + k0; } \
            else if ((r) < 2368) { const int rr = (r) - 960, nt = rr >> 4, kt = rr & 15, n = nt * 64 + nl, k0 = kt * 64 + kg * 8; \
                const int pn = n >> 8, lc = n & 255, bj = lc >> 7, wc = (lc >> 5) & 3, nn = (lc >> 4) & 1, fq = (lc >> 2) & 3, e4 = lc & 3; \
                const int j = 128 * pn + 32 * wc + 8 * fq + 4 * nn + e4; \
                ld = DFF; sp = (bj ? p.w_up : p.w_gate) + (size_t)lw * 1024 * DFF + (size_t)k0 * DFF + j; dst = p.WGU + (size_t)lw * 5632 * 1024 + (size_t)n * 1024 + k0; } \
            else { const int rr = (r) - 2368, nt = rr / 44, kt = rr % 44, n = nt * 64 + nl, k0 = kt * 64 + kg * 8; \
                ld = 1024; sp = p.w_down + (size_t)lw * DFF * 1024 + (size_t)k0 * 1024 + ((n & ~255) + perm256(n & 255)); dst = p.WDN + (size_t)lw * 1024 * DFF + (size_t)n * DFF + k0; } } while (0)
        for (int r0 = bidx; r0 < 3072; r0 += 4 * nb) {
            const float* sp[4]; int ld[4]; bf16_t* dd[4]; bool ok[4]; float v[4][8];
#pragma unroll
            for (int i = 0; i < 4; ++i) { const int r = r0 + i * nb; ok[i] = r < 3072 && !(r >= 192 && r < 320); sp[i] = p.w_out; ld[i] = 0; dd[i] = nullptr;
                if (r < 3072) WT_DESC(r, sp[i], ld[i], dd[i]); }
#pragma unroll
            for (int i = 0; i < 4; ++i)
#pragma unroll
                for (int e = 0; e < 8; ++e) v[i][e] = ok[i] ? __builtin_nontemporal_load(sp[i] + (size_t)e * ld[i]) : 0.f;
#pragma unroll
            for (int i = 0; i < 4; ++i) if (ok[i]) { u32x4 o; o.x = cvt_pk_bf16(v[i][0], v[i][1]); o.y = cvt_pk_bf16(v[i][2], v[i][3]); o.z = cvt_pk_bf16(v[i][4], v[i][5]); o.w = cvt_pk_bf16(v[i][6], v[i][7]); *(u32x4*)dd[i] = o; }
        }
#undef WT_DESC
        for (int ft = (MODE == 0 ? bidx - 128 : bidx); ft >= 0 && ft < 128; ft += nb) {
            const int r = 192 + ft, nt = r >> 4, kt = r & 15, n = nt * 64 + nl, k0 = kt * 64 + kg * 8; const float* W = p.w_in + (size_t)lw * 1024 * 2560;
            int cp = n - 768; const bool isq = cp >= 256; cp &= 255; const int g = cp >> 6, j = cp & 63;
            float v[8];
#pragma unroll
            for (int e = 0; e < 8; ++e) v[e] = 0.f;
#pragma unroll 8
            for (int m = 0; m < 64; ++m) { int idx = (j * m) & 63; if (isq) idx = (idx - 16) & 63; const float tv = tab64[idx];
#pragma unroll
                for (int e = 0; e < 8; ++e) v[e] += W[(size_t)(k0 + e) * 2560 + 768 + g * 64 + m] * tv; }
            u32x4 o; o.x = cvt_pk_bf16(v[0], v[1]); o.y = cvt_pk_bf16(v[2], v[3]); o.z = cvt_pk_bf16(v[4], v[5]); o.w = cvt_pk_bf16(v[6], v[7]);
            *(u32x4*)(p.WIN + (size_t)lw * NPROJ * 1024 + (size_t)n * 1024 + k0) = o;
        }
    }
    __syncthreads(); PREP_MARK(41);
    if (MODE == 0) for (int i = blockIdx.x * 512 + tid; i < 2048; i += gridDim.x * 512) p.NRM[i] = 0.f;
    if (MODE != 2) for (int task = (MODE == 0 ? 0 : 96) + bidx; task < (MODE == 0 ? 96 : 192); task += nb) {
        const int l = task / 96, n = (task % 96) * 64 + lane;
        float a0 = 0.f, a1 = 0.f, a2 = 0.f, a3 = 0.f, a4 = 0.f;
        const float* W = p.w_mod + (size_t)l * 1024 * 6144 + n;
#pragma unroll 16
        for (int kk = 0; kk < 128; ++kk) { const int k = w * 128 + kk; const float wv = __builtin_nontemporal_load(W + (size_t)k * 6144);
            a0 += sv[k] * wv; a1 += sv[1024 + k] * wv; a2 += sv[2048 + k] * wv; a3 += sv[3072 + k] * wv; a4 += sv[4096 + k] * wv; }
        red[(w * 5 + 0) * 64 + lane] = a0; red[(w * 5 + 1) * 64 + lane] = a1; red[(w * 5 + 2) * 64 + lane] = a2; red[(w * 5 + 3) * 64 + lane] = a3; red[(w * 5 + 4) * 64 + lane] = a4;
        __syncthreads();
        if (w < 5) { float s = p.b_mod[l * 6144 + n]; for (int ww = 0; ww < 8; ++ww) s += red[(ww * 5 + w) * 64 + lane]; p.MOD[(size_t)(l * 5 + w) * 6144 + n] = s; }
        __syncthreads();
    }
    __syncthreads(); PREP_MARK(42);
    if (MODE == 0) {
        const int gw = blockIdx.x * 8 + w, nw = gridDim.x * 8;
        for (int pid = gw; pid < 8448; pid += nw) {
            int l, t, L; float* outp;
            if (pid < 8192) { l = pid >> 12; t = pid & 4095; L = 4096; outp = p.H2F + (size_t)pid * 64; } else { l = 0; t = pid - 8192; L = 256; outp = p.H2C + (size_t)t * 64; }
            const float tt = (float)t / (float)(L - 1), wa = 6.283185307179586f * (float)t / (float)L;
            const float* w1 = p.filt_w1 + l * 33 * 64; const float* w2 = p.filt_w2 + l * 64 * 64;
            float a = p.filt_b1[l * 64 + lane] + tt * w1[lane];
            for (int bnd = 0; bnd < 16; ++bnd) { const float f = 1e-4f + (float)bnd * ((15.0f - 1e-4f) / 15.0f); const float rev2 = f * ((float)(2 * t) / (float)L);
                a += cospif(rev2) * w1[(1 + bnd) * 64 + lane] - sinpif(rev2) * w1[(17 + bnd) * 64 + lane]; }
            const float h1 = sinf(p.filt_freq[l * 128 + lane] * a);
            float a2 = p.filt_b2[l * 64 + lane];
            for (int i = 0; i < 64; ++i) a2 += __int_as_float(__builtin_amdgcn_ds_bpermute(i << 2, __float_as_int(h1))) * w2[i * 64 + lane];
            outp[lane] = sinf(p.filt_freq[l * 128 + 64 + lane] * a2);
        }
    }
    __syncthreads(); PREP_MARK(43);
    if (MODE == 0) {
        const size_t gt = (size_t)blockIdx.x * 512 + tid, gs = (size_t)gridDim.x * 512;
        for (size_t idx = gt; idx < (size_t)128 * 128; idx += gs) {
            const int m = (int)(idx >> 7), k = (int)(idx & 127), ri = m >> 6, k1 = m & 63, pq = k >> 6, n1 = k & 63, ii = (k1 * n1) & 63;
            const float c = tab64[ii], sn = tab64[(ii - 16) & 63];
            p.FM1[idx] = f2bf(ri == 0 ? (pq == 0 ? c : -sn) : (pq == 0 ? -sn : -c));
        }
        for (size_t idx = gt; idx < (size_t)64 * 128; idx += gs) {
            const int k2 = (int)(idx >> 7), k = (int)(idx & 127), ri = k >> 6, n2 = k & 63, ii = (k2 * n2) & 63;
            p.FM2[idx] = f2bf((ri == 0 ? tab64[ii] : tab64[(ii - 16) & 63]) * (1.0f / 512.0f));
        }
        for (size_t idx = gt; idx < (size_t)256 * 64; idx += gs) {
            const int k = (int)(idx >> 6), kk0 = (int)(idx & 63) * 8; float v[8];
#pragma unroll
            for (int e = 0; e < 8; ++e) { const int kk = kk0 + e, n = kk & 255, ii = ((k * n) & 255) * 16; v[e] = (kk < 256 ? tab[ii] : -tab[(ii - 1024) & 4095]) * (1.0f / 128.0f); }
            u32x4 o; o.x = cvt_pk_bf16(v[0], v[1]); o.y = cvt_pk_bf16(v[2], v[3]); o.z = cvt_pk_bf16(v[4], v[5]); o.w = cvt_pk_bf16(v[6], v[7]);
            *(u32x4*)(p.DFTC + idx * 8) = o;
        }
    }
}

__device__ __forceinline__ void split_bf16x8(const f32x4 a, const f32x4 b, bf16x8& hi, bf16x8& lo) {
    union { u32x4 u; bf16x8 v; } ph, pl;
    ph.u.x = cvt_pk_bf16(a[0], a[1]); ph.u.y = cvt_pk_bf16(a[2], a[3]); ph.u.z = cvt_pk_bf16(b[0], b[1]); ph.u.w = cvt_pk_bf16(b[2], b[3]);
    pl.u.x = cvt_pk_bf16(a[0] - __uint_as_float(ph.u.x << 16), a[1] - __uint_as_float(ph.u.x & 0xffff0000u));
    pl.u.y = cvt_pk_bf16(a[2] - __uint_as_float(ph.u.y << 16), a[3] - __uint_as_float(ph.u.y & 0xffff0000u));
    pl.u.z = cvt_pk_bf16(b[0] - __uint_as_float(ph.u.z << 16), b[1] - __uint_as_float(ph.u.z & 0xffff0000u));
    pl.u.w = cvt_pk_bf16(b[2] - __uint_as_float(ph.u.w << 16), b[3] - __uint_as_float(ph.u.w & 0xffff0000u));
    hi = ph.v; lo = pl.v;
}
__device__ void taps_phase(const Params& p, int wid_s, int l, int bstart) {
    if ((int)blockIdx.x < bstart) return;
    int tid_ = my_tid(wid_s); const int tid = tid_, lane = tid & 63, w = tid >> 6, n = lane & 15, g = lane >> 4;
    const float min_decay = -4.605170185988091f / 1.5f, max_decay = -4.605170185988091f / 0.3f;
    for (int wt = ((int)blockIdx.x - bstart) * 8 + w; wt < 2048; wt += ((int)gridDim.x - bstart) * 8) {
        const int ct = wt >> 5, tq = wt & 31;
        const int col = ct * 16 + n, c = col & 255, dir = (col >> 8) & 1, o = col >> 9;
        bf16x8 Bh[2], Bl[2];
#pragma unroll
        for (int ks = 0; ks < 2; ++ks) { f32x4 x0, x1; const float* wp = p.filt_w3 + (size_t)(l * 64 + 32 * ks + 8 * g) * 1024 + col;
#pragma unroll
            for (int e = 0; e < 4; ++e) { x0[e] = wp[(size_t)e * 1024]; x1[e] = wp[(size_t)(4 + e) * 1024]; }
            split_bf16x8(x0, x1, Bh[ks], Bl[ks]); }
        const float delta = fabsf(min_decay + (float)c * ((max_decay - min_decay) / 255.0f)), dl2 = -delta * (1.4426950408889634f / 4095.0f);
        bf16_t* outp = p.TAPS + ((size_t)((l * 2 + o) * 256 + c)) * 8192 + dir * 4096;
        float asum = 0.f;
        for (int tt = 0; tt < 8; ++tt) {
            const int tb = tq * 128 + tt * 16;
            const float* hp = p.H2F + ((size_t)l * 4096 + tb + n) * 64 + 8 * g;
            f32x4 acc = {0.f, 0.f, 0.f, 0.f};
#pragma unroll
            for (int ks = 0; ks < 2; ++ks) { const f32x4 a0 = *(const f32x4*)(hp + 32 * ks), a1 = *(const f32x4*)(hp + 32 * ks + 4); bf16x8 Ah, Al; split_bf16x8(a0, a1, Ah, Al);
                acc = __builtin_amdgcn_mfma_f32_16x16x32_bf16(Ah, Bh[ks], acc, 0, 0, 0); acc = __builtin_amdgcn_mfma_f32_16x16x32_bf16(Al, Bh[ks], acc, 0, 0, 0); acc = __builtin_amdgcn_mfma_f32_16x16x32_bf16(Ah, Bl[ks], acc, 0, 0, 0); }
            float v[4];
#pragma unroll
            for (int e = 0; e < 4; ++e) { const int t = tb + 4 * g + e; v[e] = acc[e] * __builtin_amdgcn_exp2f((float)t * dl2); if (!(dir == 1 && t == 0)) asum += fabsf(v[e]); }
            u32x2 pk; pk.x = cvt_pk_bf16(v[0], v[1]); pk.y = cvt_pk_bf16(v[2], v[3]);
            *(u32x2*)(outp + tb + 4 * g) = pk;
        }
        asum += shx(asum, 16, lane); asum += shx(asum, 32, lane);
        if (g == 0) __hip_atomic_fetch_add(p.NRM + l * 1024 + col, asum, __ATOMIC_RELAXED, __HIP_MEMORY_SCOPE_AGENT);
    }
}

__device__ void norm_phase(const Params& p, int wid_s, int l, int which, int Mrows, bool from_input) {
    int tid_ = my_tid(wid_s); const int tid = tid_, lane = tid & 63, w = tid >> 6;
    const float* gam = (which ? p.norm2_g : p.norm1_g) + l * 1024;
    const int moff = which ? 3072 : 0;
    for (int row0 = (blockIdx.x * 8 + w) * 4; row0 < Mrows; row0 += gridDim.x * 32) {
        f32x4 v[4][4];
#pragma unroll
        for (int rr = 0; rr < 4; ++rr) { const int row = row0 + rr; const bool isctx = row >= MMAIN;
            if (from_input) { const float* src = isctx ? p.ctx + (size_t)(row - MMAIN) * 1024 : p.x + (size_t)row * 1024;
#pragma unroll
                for (int i = 0; i < 4; ++i) v[rr][i] = *(const f32x4*)(src + i * 256 + lane * 4);
            } else { const bf16_t* src = p.XB + (size_t)row * 1024;
#pragma unroll
                for (int i = 0; i < 4; ++i) { const u32x2 q = *(const u32x2*)(src + i * 256 + lane * 4); v[rr][i][0] = __uint_as_float(q.x << 16); v[rr][i][1] = __uint_as_float(q.x & 0xffff0000u); v[rr][i][2] = __uint_as_float(q.y << 16); v[rr][i][3] = __uint_as_float(q.y & 0xffff0000u); } } }
#pragma unroll
        for (int rr = 0; rr < 4; ++rr) { const int row = row0 + rr; const bool isctx = row >= MMAIN; const int bi = isctx ? 4 : (row >> 12);
            float ss = 0.f;
#pragma unroll
            for (int i = 0; i < 4; ++i) ss += v[rr][i][0] * v[rr][i][0] + v[rr][i][1] * v[rr][i][1] + v[rr][i][2] * v[rr][i][2] + v[rr][i][3] * v[rr][i][3];
#pragma unroll
            for (int o = 32; o >= 1; o >>= 1) ss += shx(ss, o, lane);
            const float rstd = rsqrtf(ss * (1.0f / 1024.0f) + 1e-6f);
            const float* mod = p.MOD + (size_t)(l * 5 + bi) * 6144 + moff;
#pragma unroll
            for (int i = 0; i < 4; ++i) { const int col = i * 256 + lane * 4;
                const f32x4 g = *(const f32x4*)(gam + col), sh = *(const f32x4*)(mod + col), sc = *(const f32x4*)(mod + 1024 + col);
                f32x4 y = v[rr][i] * rstd * g * (sc + 1.0f) + sh;
                u32x2 o; o.x = cvt_pk_bf16(y[0], y[1]); o.y = cvt_pk_bf16(y[2], y[3]);
                *(u32x2*)(p.HB + (size_t)row * 1024 + col) = o; } }
    }
}
__device__ void final_norm(const Params& p, int wid_s) {
    int tid_ = my_tid(wid_s); const int tid = tid_, lane = tid & 63, w = tid >> 6;
    for (int row0 = (blockIdx.x * 8 + w) * 4; row0 < MMAIN; row0 += gridDim.x * 32) {
        f32x4 v[4][4];
#pragma unroll
        for (int rr = 0; rr < 4; ++rr)
#pragma unroll
            for (int i = 0; i < 4; ++i) { const u32x2 q = *(const u32x2*)(p.XB + (size_t)(row0 + rr) * 1024 + i * 256 + lane * 4); v[rr][i][0] = __uint_as_float(q.x << 16); v[rr][i][1] = __uint_as_float(q.x & 0xffff0000u); v[rr][i][2] = __uint_as_float(q.y << 16); v[rr][i][3] = __uint_as_float(q.y & 0xffff0000u); }
#pragma unroll
        for (int rr = 0; rr < 4; ++rr) { const int row = row0 + rr; float* src = p.out + (size_t)row * 1024; float ss = 0.f;
#pragma unroll
            for (int i = 0; i < 4; ++i) ss += v[rr][i][0] * v[rr][i][0] + v[rr][i][1] * v[rr][i][1] + v[rr][i][2] * v[rr][i][2] + v[rr][i][3] * v[rr][i][3];
#pragma unroll
            for (int o = 32; o >= 1; o >>= 1) ss += shx(ss, o, lane);
            const float rstd = rsqrtf(ss * (1.0f / 1024.0f) + 1e-6f);
#pragma unroll
            for (int i = 0; i < 4; ++i) { const int col = i * 256 + lane * 4; const f32x4 g = *(const f32x4*)(p.final_g + col); *(f32x4*)(src + col) = v[rr][i] * rstd * g; }
#ifdef PROBE_SEL
            if (row == 0 && lane == 0) { const unsigned ta = __hip_atomic_load(p.BAR + 96 + PROBE_A, __ATOMIC_RELAXED, __HIP_MEMORY_SCOPE_AGENT), tb = __hip_atomic_load(p.BAR + 96 + PROBE_SEL, __ATOMIC_RELAXED, __HIP_MEMORY_SCOPE_AGENT); src[0] += (float)(tb - ta) * 1e-4f * PROBE_SCALE; }
#endif
        }
    }
}

__device__ __forceinline__ float short_conv_at(const bf16_t* base, int t, int L, float w0, float w1, float w2, float bb) {
    const float um = t > 0 ? bf2f(base[t - 1]) : 0.f, u0 = bf2f(base[t]), up = t < L - 1 ? bf2f(base[t + 1]) : 0.f;
    return um * w0 + u0 * w1 + up * w2 + bb;
}
template <int L> __device__ void hyena_naive(const Params& p, int wid_s, int l, int c, unsigned char* smem) {
    constexpr bool ISCTX = (L == CTXL); constexpr int NI = (L + 511) / 512;
    int tid_ = my_tid(wid_s); const int tid = tid_, lane = tid & 63, w = tid >> 6;
    float* Kf = (float*)smem;
    float* Uf = (float*)(smem + 32768);
    float* red = (float*)(smem + 32768 + 65536);
    const bf16_t* hy = ISCTX ? p.HYUC : p.HYU;
    const float* H2 = ISCTX ? p.H2C : p.H2F + (size_t)l * 4096 * 64;
    const float* cw = p.hy_conv_w + l * 3 * 768; const float* cb = p.hy_conv_b + l * 768;
    const float min_decay = -4.605170185988091f / 1.5f, max_decay = -4.605170185988091f / 0.3f;
    const float delta = fabsf(min_decay + (float)c * ((max_decay - min_decay) / 255.0f));
    const int rowbase = ISCTX ? MMAIN : 0;
    for (int o = 0; o < 2; ++o) {
        float part = 0.f;
        const float* w3 = p.filt_w3 + (size_t)l * 64 * 1024 + o * 512 + c;
        for (int t = tid; t < L; t += 512) {
            const f32x4* hr = (const f32x4*)(H2 + (size_t)t * 64); float kf = 0.f, kb = 0.f;
#pragma unroll
            for (int j4 = 0; j4 < 16; ++j4) { const f32x4 hv = hr[j4];
#pragma unroll
                for (int jj = 0; jj < 4; ++jj) { kf += hv[jj] * w3[(4 * j4 + jj) * 1024]; kb += hv[jj] * w3[(4 * j4 + jj) * 1024 + 256]; } }
            const float dec = expf(-((float)t / (float)(L - 1)) * delta); kf *= dec; kb *= dec;
            Kf[L + t] = kf; part += fabsf(kf);
            if (t >= 1) { Kf[L - t] = kb; part += fabsf(kb); } else Kf[0] = 0.f;
        }
#pragma unroll
        for (int s = 32; s >= 1; s >>= 1) part += shx(part, s, lane);
        if (lane == 0) red[w] = part;
        if (o == 0) {
            const int ch = 512 + c; const float w0 = cw[ch], w1 = cw[768 + ch], w2 = cw[1536 + ch], bb = cb[ch];
            for (int idx = tid; idx < 4 * L; idx += 512) { const int b = idx / L, s = idx % L; Uf[s * 4 + b] = short_conv_at(hy + (size_t)(b * 768 + ch) * L, s, L, w0, w1, w2, bb); }
        }
        __syncthreads();
        float nrm = 0.f;
#pragma unroll
        for (int i = 0; i < 8; ++i) nrm += red[i];
        const float inv = 1.0f / nrm;
        float acc[NI][4];
#pragma unroll
        for (int i = 0; i < NI; ++i) { acc[i][0] = 0.f; acc[i][1] = 0.f; acc[i][2] = 0.f; acc[i][3] = 0.f; }
        if (tid < L) {
            const float* kp = Kf + L + tid;
#pragma unroll 8
            for (int s = 0; s < L; ++s) { const f32x4 u4 = *(const f32x4*)(Uf + s * 4);
#pragma unroll
                for (int i = 0; i < NI; ++i) { const float kv = kp[i * 512 - s]; acc[i][0] += kv * u4[0]; acc[i][1] += kv * u4[1]; acc[i][2] += kv * u4[2]; acc[i][3] += kv * u4[3]; } }
        }
        __syncthreads();
        if (tid < L) {
            const float sk = p.hy_skip[(l * 2 + o) * 256 + c];
            const int ch = o == 0 ? c : 256 + c; const float w0 = cw[ch], w1 = cw[768 + ch], w2 = cw[1536 + ch], bb = cb[ch];
#pragma unroll
            for (int i = 0; i < NI; ++i) { const int t = tid + i * 512;
#pragma unroll
                for (int b = 0; b < 4; ++b) { const float y = acc[i][b] * inv + sk * Uf[t * 4 + b];
                    const float xg = short_conv_at(hy + (size_t)(b * 768 + ch) * L, t, L, w0, w1, w2, bb);
                    if (o == 0) Uf[t * 4 + b] = xg * y; else p.HB[(size_t)(rowbase + b * L + t) * 1024 + c] = f2bf(xg * y); } }
        }
        __syncthreads();
    }
}


constexpr int HK_COPY = 8256, HK_OFF = 4128, HU_BLK = 136, HU_SB = 5280, HK_BYTES = 4 * HK_COPY * 2  , HU_BYTES = 4 * HU_SB * 2  ;
__device__ __forceinline__ int hy_swz(int idx) { return idx ^ ((((idx >> 9) & 3) << 2) | (((idx >> 7) & 1) << 4)); }
__device__ __forceinline__ int hu_idx(int b, int t) { return b * HU_SB + ((t >> 7) + 3) * HU_BLK + (t & 127); }

__device__ __forceinline__ void hyena_conv_mfma(const bf16_t* KC, const bf16_t* UU, float* Yf, int lane, int w) {
    const int qh = w & 1, ks = w >> 1, n = lane & 15, g = lane >> 4;
    f32x4 acc[8][4];
#pragma unroll
    for (int a = 0; a < 8; ++a)
#pragma unroll
        for (int qq = 0; qq < 4; ++qq) acc[a][qq] = (f32x4){0.f, 0.f, 0.f, 0.f};
    const int abase = HK_OFF + 32 * ks + 8 * g - 8 * n;
    const int bbase = (n & 3) * HU_SB + ((n >> 2) + 3) * HU_BLK + 32 * ks + 8 * g;
    for (int D = 16 * qh - 31; D <= 16 * qh + 15; ++D) {
        bf16x8 A[8];
#pragma unroll
        for (int a = 0; a < 8; ++a) { const bf16_t* ap = KC + (a & 3) * HK_COPY + abase - 128 * D - (a & 4);
            if (a < 4) A[a] = *(const bf16x8*)ap;
            else { union { u32x2 h[2]; bf16x8 v; } t; t.h[0] = *(const u32x2*)ap; t.h[1] = *(const u32x2*)(ap + 4); A[a] = t.v; } }
        bf16x8 B[4];
#pragma unroll
        for (int qq = 0; qq < 4; ++qq) B[qq] = *(const bf16x8*)(UU + bbase + min(max(4 * (4 * qh + qq) - D, -3), 31) * HU_BLK);
#pragma unroll
        for (int qq = 0; qq < 4; ++qq) { const int q = 4 * qh + qq;
            if (D >= 4 * q - 31 && D <= 4 * q + 3) {
#pragma unroll
                for (int a = 0; a < 8; ++a) acc[a][qq] = __builtin_amdgcn_mfma_f32_16x16x32_bf16(A[a], B[qq], acc[a][qq], 0, 0, 0);
            } }
    }
    __syncthreads();
    const int Il = n >> 2, b = n & 3;
    const int L3 = Il | ((g & 1) << 2), lbase = 8192 * qh + 512 * Il + 128 * g + b;
    int xa[8];
#pragma unroll
    for (int a = 0; a < 8; ++a) xa[a] = lbase + ((a ^ L3) << 2);
    for (int r = 0; r < 4; ++r) {
        if (ks == r) {
#pragma unroll
            for (int a = 0; a < 8; ++a) { float* yp = Yf + xa[a];
#pragma unroll
                for (int qq = 0; qq < 4; ++qq)
#pragma unroll
                    for (int e = 0; e < 4; ++e) { if (r == 0) yp[2048 * qq + 32 * e] = acc[a][qq][e]; else yp[2048 * qq + 32 * e] += acc[a][qq][e]; } }
        }
        __syncthreads();
    }
}

#ifdef PROBE_SEL
#define PROBE_MARK(k) do { if (l == 0 && c == 0 && my_tid(wid_s) == 0) { __hip_atomic_store(p.BAR + 96 + (k), (unsigned)__builtin_amdgcn_s_memrealtime(), __ATOMIC_RELAXED, __HIP_MEMORY_SCOPE_AGENT); } } while (0)
#else
#define PROBE_MARK(k) do {} while (0)
#endif
__device__ __forceinline__ void short_conv8(const bf16_t* base, int t0, int L, float w0, float w1, float w2, float bb, float (&o)[8]) {
    const u32x4 v = *(const u32x4*)(base + t0);
    const float um = t0 > 0 ? bf2f(base[t0 - 1]) : 0.f, up = t0 + 8 < L ? bf2f(base[t0 + 8]) : 0.f;
    float x[10]; x[0] = um; x[9] = up;
#pragma unroll
    for (int e = 0; e < 4; ++e) { x[1 + 2 * e] = __uint_as_float(v[e] << 16); x[2 + 2 * e] = __uint_as_float(v[e] & 0xffff0000u); }
#pragma unroll
    for (int e = 0; e < 8; ++e) o[e] = x[e] * w0 + x[e + 1] * w1 + x[e + 2] * w2 + bb;
}

__device__ void hyena_mfma(const Params& p, int wid_s, int l, int c, unsigned char* smem) {
    int tid_ = my_tid(wid_s); const int tid = tid_, lane = tid & 63, w = tid >> 6;
    bf16_t* KC = (bf16_t*)smem; bf16_t* UU = (bf16_t*)(smem + HK_BYTES); float* Yf = (float*)smem; float* red = (float*)(smem + HK_BYTES + HU_BYTES);
    constexpr int L = SEQL;
    const bf16_t* hy = p.HYU; const float* H2 = p.H2F + (size_t)l * 4096 * 64;
    const float* cw = p.hy_conv_w + l * 3 * 768; const float* cb = p.hy_conv_b + l * 768;
    const float min_decay = -4.605170185988091f / 1.5f, max_decay = -4.605170185988091f / 0.3f;
    const float delta = fabsf(min_decay + (float)c * ((max_decay - min_decay) / 255.0f));
    u32x4 zero4 = (u32x4){0u, 0u, 0u, 0u}; asm volatile("" : "+v"(zero4));
    PROBE_MARK(0);
    for (int i = tid; i < (HK_BYTES + HU_BYTES) / 16; i += 512) ((u32x4*)smem)[i] = zero4;
    __syncthreads();
#define HY_COPIES(ord) do { const bf16_t* tp = p.TAPS + ((size_t)((l * 2 + (ord)) * 256 + c)) * 8192; \
        for (int i = tid; i < 1024; i += 512) { const u32x4 v = *(const u32x4*)(tp + i * 8); const int dir = i >> 9, tq = (i & 511) * 8; \
            _Pragma("unroll") for (int e = 0; e < 8; ++e) { const bf16_t val = (bf16_t)((e & 1) ? (v[e >> 1] >> 16) : (v[e >> 1] & 0xffffu)); const int t = tq + e; \
                if (dir == 0) { _Pragma("unroll") for (int s4 = 0; s4 < 4; ++s4) KC[s4 * HK_COPY + HK_OFF + s4 - t] = val; } \
                else if (t >= 1) { _Pragma("unroll") for (int s4 = 0; s4 < 4; ++s4) KC[s4 * HK_COPY + HK_OFF + s4 + t] = val; } } } } while (0)
    HY_COPIES(0);
    { int t0 = tid * 8; asm volatile("" : "+v"(t0));
      const int ch = 512 + c; const float w0 = cw[ch], w1 = cw[768 + ch], w2 = cw[1536 + ch], bb = cb[ch];
#pragma unroll
      for (int b = 0; b < 4; ++b) { float o[8]; short_conv8(hy + (size_t)(b * 768 + ch) * L, t0, L, w0, w1, w2, bb, o);
          u32x4 pk; pk.x = cvt_pk_bf16(o[0], o[1]); pk.y = cvt_pk_bf16(o[2], o[3]); pk.z = cvt_pk_bf16(o[4], o[5]); pk.w = cvt_pk_bf16(o[6], o[7]);
          *(u32x4*)(UU + hu_idx(b, t0)) = pk; } }
    __syncthreads();
    const float inv1 = 1.0f / (p.NRM[l * 1024 + c] + p.NRM[l * 1024 + 256 + c]), inv2 = 1.0f / (p.NRM[l * 1024 + 512 + c] + p.NRM[l * 1024 + 768 + c]);
    PROBE_MARK(1);
    hyena_conv_mfma(KC, UU, Yf, lane, w);
    PROBE_MARK(2);
    { int t0 = tid * 8; asm volatile("" : "+v"(t0));
      const float sk = p.hy_skip[(l * 2 + 0) * 256 + c]; const int ch = c; const float w0 = cw[ch], w1 = cw[768 + ch], w2 = cw[1536 + ch], bb = cb[ch];
#pragma unroll
      for (int b = 0; b < 4; ++b) { float xg[8]; short_conv8(hy + (size_t)(b * 768 + ch) * L, t0, L, w0, w1, w2, bb, xg);
          float yv[8];
#pragma unroll
          for (int e = 0; e < 8; ++e) yv[e] = Yf[hy_swz((t0 + e) * 4) + b];
          const u32x4 uq = *(const u32x4*)(UU + hu_idx(b, t0)); float uf[8];
#pragma unroll
          for (int e = 0; e < 4; ++e) { uf[2 * e] = __uint_as_float(uq[e] << 16); uf[2 * e + 1] = __uint_as_float(uq[e] & 0xffff0000u); }
          float z[8];
#pragma unroll
          for (int e = 0; e < 8; ++e) z[e] = xg[e] * (yv[e] * inv1 + sk * uf[e]);
          u32x4 pk; pk.x = cvt_pk_bf16(z[0], z[1]); pk.y = cvt_pk_bf16(z[2], z[3]); pk.z = cvt_pk_bf16(z[4], z[5]); pk.w = cvt_pk_bf16(z[6], z[7]);
          *(u32x4*)(UU + hu_idx(b, t0)) = pk; } }
    __syncthreads();
    PROBE_MARK(3);
    for (int i = tid; i < HK_BYTES / 16; i += 512) ((u32x4*)smem)[i] = zero4;
    __syncthreads();
    HY_COPIES(1);
#undef HY_COPIES
    __syncthreads();
    PROBE_MARK(4);
    hyena_conv_mfma(KC, UU, Yf, lane, w);
    PROBE_MARK(5);
    { int t0 = tid * 8; asm volatile("" : "+v"(t0));
      const float sk = p.hy_skip[(l * 2 + 1) * 256 + c]; const int ch = 256 + c; const float w0 = cw[ch], w1 = cw[768 + ch], w2 = cw[1536 + ch], bb = cb[ch];
#pragma unroll
      for (int b = 0; b < 4; ++b) { float xg[8]; short_conv8(hy + (size_t)(b * 768 + ch) * L, t0, L, w0, w1, w2, bb, xg);
          float yv[8];
#pragma unroll
          for (int e = 0; e < 8; ++e) yv[e] = Yf[hy_swz((t0 + e) * 4) + b];
          const u32x4 uq = *(const u32x4*)(UU + hu_idx(b, t0)); float uf[8];
#pragma unroll
          for (int e = 0; e < 4; ++e) { uf[2 * e] = __uint_as_float(uq[e] << 16); uf[2 * e + 1] = __uint_as_float(uq[e] & 0xffff0000u); }
#pragma unroll
          for (int e = 0; e < 8; ++e) p.HB[(size_t)(b * L + t0 + e) * 1024 + c] = f2bf(xg[e] * (yv[e] * inv2 + sk * uf[e])); } }
    __syncthreads();
    PROBE_MARK(6);
}


constexpr int FN_PITCH = 136, FN_BUF = 256 * FN_PITCH * 2  ;
__device__ void fnet_task(const Params& p, int wid_s, int task, unsigned char* smem) {
    int tid_ = my_tid(wid_s); const int tid = tid_, lane = tid & 63, w = tid >> 6, n = lane & 15, g = lane >> 4;
    const int b = task >> 6, cg = task & 63;
    const int l = 0, c = (task == 50) ? 0 : 1; PROBE_MARK(30);
    bf16_t* In = (bf16_t*)smem; bf16_t* Tb = (bf16_t*)(smem + FN_BUF); bf16_t* Yb = (bf16_t*)smem;
    {
        const bf16_t* src = p.FNB + (size_t)(b * 256 + 4 * cg) * 8192;
#pragma unroll
        for (int i = 0; i < 8; ++i) { const int ch = tid + 512 * i;
            const int cl = ch >> 10, pq = (ch >> 9) & 1, n1 = (ch >> 3) & 63, n20 = (ch & 7) * 8;
            const u32x4 v = *(const u32x4*)(src + (size_t)cl * 8192 + pq * 4096 + n1 * 64 + n20);
            bf16_t* dst = In + (cl * 64 + n20) * FN_PITCH + pq * 64 + n1;
#pragma unroll
            for (int e = 0; e < 4; ++e) { dst[(2 * e) * FN_PITCH] = (bf16_t)(v[e] & 0xffffu); dst[(2 * e + 1) * FN_PITCH] = (bf16_t)(v[e] >> 16); } }
    }
    __syncthreads();
    {
        f32x4 acc[8][2];
#pragma unroll
        for (int mt = 0; mt < 8; ++mt) { acc[mt][0] = (f32x4){0.f, 0.f, 0.f, 0.f}; acc[mt][1] = (f32x4){0.f, 0.f, 0.f, 0.f}; }
        bf16x8 Af[2][8];
#pragma unroll
        for (int mt = 0; mt < 8; ++mt) Af[0][mt] = *(const bf16x8*)(p.FM1 + (16 * mt + n) * 128 + 8 * g);
#pragma unroll
        for (int ks = 0; ks < 4; ++ks) {
            bf16x8 Bf[2];
#pragma unroll
            for (int j = 0; j < 2; ++j) Bf[j] = *(const bf16x8*)(In + (16 * (2 * w + j) + n) * FN_PITCH + 32 * ks + 8 * g);
            if (ks < 3) {
#pragma unroll
                for (int mt = 0; mt < 8; ++mt) Af[(ks + 1) & 1][mt] = *(const bf16x8*)(p.FM1 + (16 * mt + n) * 128 + 32 * (ks + 1) + 8 * g); }
#pragma unroll
            for (int mt = 0; mt < 8; ++mt) {
                acc[mt][0] = __builtin_amdgcn_mfma_f32_16x16x32_bf16(Af[ks & 1][mt], Bf[0], acc[mt][0], 0, 0, 0); acc[mt][1] = __builtin_amdgcn_mfma_f32_16x16x32_bf16(Af[ks & 1][mt], Bf[1], acc[mt][1], 0, 0, 0); }
        }
#pragma unroll
        for (int j = 0; j < 2; ++j) { const int nn = 16 * (2 * w + j) + n, cl = nn >> 6, n2 = nn & 63;
#pragma unroll
            for (int kt = 0; kt < 4; ++kt)
#pragma unroll
                for (int e = 0; e < 4; ++e) { const int k1 = 16 * kt + 4 * g + e; const float ph = (float)(k1 * n2) * (1.0f / 4096.0f);
                    const float cph = __builtin_amdgcn_cosf(ph), sph = __builtin_amdgcn_sinf(ph);
                    const float tr = acc[kt][j][e], ti = acc[kt + 4][j][e];
                    bf16_t* dst = Tb + (cl * 64 + k1) * FN_PITCH + n2;
                    dst[0] = f2bf(cph * tr + sph * ti); dst[64] = f2bf(cph * ti - sph * tr); } }
    }
    __syncthreads();
    {
        f32x4 acc[4][2];
#pragma unroll
        for (int mt = 0; mt < 4; ++mt) { acc[mt][0] = (f32x4){0.f, 0.f, 0.f, 0.f}; acc[mt][1] = (f32x4){0.f, 0.f, 0.f, 0.f}; }
        bf16x8 Af[4][4];
#pragma unroll
        for (int ks = 0; ks < 4; ++ks)
#pragma unroll
            for (int mt = 0; mt < 4; ++mt) Af[ks][mt] = *(const bf16x8*)(p.FM2 + (16 * mt + n) * 128 + 32 * ks + 8 * g);
#pragma unroll
        for (int ks = 0; ks < 4; ++ks) {
            bf16x8 Bf[2];
#pragma unroll
            for (int j = 0; j < 2; ++j) Bf[j] = *(const bf16x8*)(Tb + (16 * (2 * w + j) + n) * FN_PITCH + 32 * ks + 8 * g);
#pragma unroll
            for (int mt = 0; mt < 4; ++mt) {
                acc[mt][0] = __builtin_amdgcn_mfma_f32_16x16x32_bf16(Af[ks][mt], Bf[0], acc[mt][0], 0, 0, 0); acc[mt][1] = __builtin_amdgcn_mfma_f32_16x16x32_bf16(Af[ks][mt], Bf[1], acc[mt][1], 0, 0, 0); }
        }
#pragma unroll
        for (int j = 0; j < 2; ++j) { const int nn = 16 * (2 * w + j) + n, cl = nn >> 6, k1 = nn & 63;
#pragma unroll
            for (int mt = 0; mt < 4; ++mt)
#pragma unroll
                for (int e = 0; e < 4; ++e) { const int k2 = 16 * mt + 4 * g + e; Yb[(k1 + 64 * k2) * 4 + cl] = f2bf(acc[mt][j][e]); } }
    }
    __syncthreads();
#pragma unroll
    for (int i = 0; i < 8; ++i) { const int k = tid + 512 * i; *(u32x2*)(p.HB + (size_t)(b * SEQL + k) * 1024 + 256 + 4 * cg) = *(const u32x2*)(Yb + k * 4); }
    __syncthreads();
    PROBE_MARK(31);
}

template <bool LOCAL> __device__ void attn_wave(const Params& p, int wid_s, int l, int b, int r, int h, int qt, const float* rpbl  ) {
    int tid_ = my_tid(wid_s); const int lane = tid_ & 63, q = lane & 15, g = lane >> 4;
    const int qrow = LOCAL ? (b * SEQL + r * 64 + qt * 16 + q) : (MMAIN + b * CTXL + qt * 16 + q);
    constexpr int T0 = LOCAL ? 0 : 16;
    bf16x8 Qf[2];
#pragma unroll
    for (int ds = 0; ds < 2; ++ds) Qf[ds] = *(const bf16x8*)(p.QK + (size_t)qrow * 1024 + h * 64 + ds * 32 + 8 * g);
    const int c = (LOCAL && b == 1 && r == 11 && h == 4 && qt == 0) ? 0 : 1; PROBE_MARK(10);
    f32x4 S[32];
    const int c0 = qt == 0 ? 0 : (qt == 1 ? 8 : (qt == 2 ? 24 : 32));
    const int rs = min(max(r - 4, 0), 56);
    const int ki = 8 * (q >> 2) + (q & 3);
    const bf16_t* kloc = p.QK + (size_t)(b * SEQL + rs * 64 + c0 + ki) * 1024 + 512 + h * 64 + 8 * g;
    const bf16_t* kctx = p.QK + (size_t)(MMAIN + b * CTXL + ki) * 1024 + 512 + h * 64 + 8 * g;
#pragma unroll
    for (int tb = T0; tb < 32; tb += 8) {
        bf16x8 kf[8][2];
#pragma unroll
        for (int j = 0; j < 8; ++j) { const int T = tb + j, hh = T & 1;
            const bf16_t* kp = (T < 16) ? kloc + (size_t)((T >> 1) * 64 + 4 * hh) * 1024 : kctx + (size_t)(32 * ((T - 16) >> 1) + 4 * hh) * 1024;
            kf[j][0] = *(const bf16x8*)kp; kf[j][1] = *(const bf16x8*)(kp + 32); }
        __builtin_amdgcn_sched_barrier(0);
#pragma unroll
        for (int j = 0; j < 8; ++j) { f32x4 a = {0.f, 0.f, 0.f, 0.f};
            a = __builtin_amdgcn_mfma_f32_16x16x32_bf16(kf[j][0], Qf[0], a, 0, 0, 0); a = __builtin_amdgcn_mfma_f32_16x16x32_bf16(kf[j][1], Qf[1], a, 0, 0, 0); S[tb + j] = a; }
        __builtin_amdgcn_sched_barrier(0);
    }
    PROBE_MARK(11);
    float mx = -1e30f;
    if (LOCAL) {
        const int qc = qt * 16 + q, cs = min(max(qc - 8, 0), 48);
#pragma unroll
        for (int T = 0; T < 16; ++T) { const int kr = T >> 1, hh = T & 1; const int brow = (rs + kr - r + 7) * 31;
#pragma unroll
            for (int e = 0; e < 4; ++e) { const int kc = c0 + 8 * g + 4 * hh + e; const bool valid = (kc >= cs) && (kc < cs + 16);
                const int bidx = min(max(kc - qc + 15, 0), 30);
                const float sval = valid ? S[T][e] * 0.125f + rpbl[brow + bidx] : -1e30f; S[T][e] = sval; mx = fmaxf(mx, sval); } }
    }
#pragma unroll
    for (int T = 16; T < 32; ++T)
#pragma unroll
        for (int e = 0; e < 4; ++e) { const float sval = S[T][e] * 0.125f; S[T][e] = sval; mx = fmaxf(mx, sval); }
    mx = fmaxf(mx, shx(mx, 16, lane)); mx = fmaxf(mx, shx(mx, 32, lane));
    float sum = 0.f;
    bf16x8 Pf[16];
#pragma unroll
    for (int ch = T0 / 2; ch < 16; ++ch) {
        float pv[8];
#pragma unroll
        for (int e = 0; e < 4; ++e) { pv[e] = __expf(S[2 * ch][e] - mx); pv[4 + e] = __expf(S[2 * ch + 1][e] - mx); }
#pragma unroll
        for (int e = 0; e < 8; ++e) sum += pv[e];
        union { u32x4 u; bf16x8 v; } pf;
        pf.u.x = cvt_pk_bf16(pv[0], pv[1]); pf.u.y = cvt_pk_bf16(pv[2], pv[3]); pf.u.z = cvt_pk_bf16(pv[4], pv[5]); pf.u.w = cvt_pk_bf16(pv[6], pv[7]);
        Pf[ch] = pf.v;
    }
    sum += shx(sum, 16, lane); sum += shx(sum, 32, lane);
    const float inv = 1.0f / sum;
    PROBE_MARK(12);
    f32x4 O[4];
#pragma unroll
    for (int dt = 0; dt < 4; ++dt) O[dt] = (f32x4){0.f, 0.f, 0.f, 0.f};
    const bf16_t* vloc = p.VT + ((size_t)(b * 512 + h * 64 + q) * SEQL + rs * 64 + c0 + 8 * g);
    const bf16_t* vctx = p.VTC + ((size_t)(b * 512 + h * 64 + q) * CTXL + 8 * g);
#pragma unroll
    for (int cb = T0 / 2; cb < 16; cb += 4) {
        bf16x8 vf[4][4];
#pragma unroll
        for (int j = 0; j < 4; ++j)
#pragma unroll
            for (int dt = 0; dt < 4; ++dt) { const int ch = cb + j;
                const bf16_t* vp = (ch < 8) ? vloc + (size_t)(16 * dt) * SEQL + ch * 64 : vctx + (size_t)(16 * dt) * CTXL + 32 * (ch - 8);
                vf[j][dt] = *(const bf16x8*)vp; }
        __builtin_amdgcn_sched_barrier(0);
#pragma unroll
        for (int j = 0; j < 4; ++j)
#pragma unroll
            for (int dt = 0; dt < 4; ++dt) O[dt] = __builtin_amdgcn_mfma_f32_16x16x32_bf16(vf[j][dt], Pf[cb + j], O[dt], 0, 0, 0);
        __builtin_amdgcn_sched_barrier(0);
    }
#pragma unroll
    for (int dt = 0; dt < 4; ++dt) { u32x2 o; o.x = cvt_pk_bf16(O[dt][0] * inv, O[dt][1] * inv); o.y = cvt_pk_bf16(O[dt][2] * inv, O[dt][3] * inv);
        *(u32x2*)(p.HB + (size_t)qrow * 1024 + 512 + h * 64 + 16 * dt + 4 * g) = o; }
    PROBE_MARK(13);
}

__device__ __forceinline__ void attn_ld(const bf16_t* kp, const bf16_t* vp, size_t vstride, bf16x8 (&kf)[2][2], bf16x8 (&vf)[4]) {
#pragma unroll
    for (int hh = 0; hh < 2; ++hh)
#pragma unroll
        for (int ds = 0; ds < 2; ++ds) kf[hh][ds] = *(const bf16x8*)(kp + (size_t)hh * 4 * 1024 + ds * 32);
#pragma unroll
    for (int dt = 0; dt < 4; ++dt) vf[dt] = *(const bf16x8*)(vp + (size_t)dt * 16 * vstride);
}
__device__ void attn_wave4(const Params& p, int wid_s, int l, int b, int h, int qt, int rg, const float* rpbl) {
    int tid_ = my_tid(wid_s); const int lane = tid_ & 63, q = lane & 15, g = lane >> 4;
    const int r0 = rg * 4, c0 = qt == 0 ? 0 : (qt == 1 ? 8 : (qt == 2 ? 24 : 32)), qc = qt * 16 + q, cs = min(max(qc - 8, 0), 48);
    int rsj[4];
#pragma unroll
    for (int j = 0; j < 4; ++j) rsj[j] = min(max(r0 + j - 4, 0), 56);
    const int rs0 = rsj[0], nl = rsj[3] + 8 - rs0, nch = nl + 8;
    bf16x8 Qf[4][2];
#pragma unroll
    for (int j = 0; j < 4; ++j)
#pragma unroll
        for (int ds = 0; ds < 2; ++ds) Qf[j][ds] = *(const bf16x8*)(p.QK + (size_t)(b * SEQL + (r0 + j) * 64 + qt * 16 + q) * 1024 + h * 64 + ds * 32 + 8 * g);
    int bidx[8];
#pragma unroll
    for (int hh = 0; hh < 2; ++hh)
#pragma unroll
        for (int e = 0; e < 4; ++e) { const int kc = c0 + 8 * g + 4 * hh + e; bidx[hh * 4 + e] = (kc >= cs && kc < cs + 16) ? (kc - qc + 15) : 31; }
    const float SC = 0.125f * 1.4426950408889634f;
    float m[4], ls[4]; f32x4 O[4][4];
#pragma unroll
    for (int j = 0; j < 4; ++j) { m[j] = -1e30f; ls[j] = 0.f;
#pragma unroll
        for (int dt = 0; dt < 4; ++dt) O[j][dt] = (f32x4){0.f, 0.f, 0.f, 0.f}; }
    const int ki = 8 * (q >> 2) + (q & 3);
    const bf16_t* kloc = p.QK + (size_t)(b * SEQL + c0 + ki) * 1024 + 512 + h * 64 + 8 * g;
    const bf16_t* kctx = p.QK + (size_t)(MMAIN + b * CTXL + ki) * 1024 + 512 + h * 64 + 8 * g;
    const bf16_t* vloc = p.VT + ((size_t)(b * 512 + h * 64 + q) * SEQL + c0 + 8 * g);
    const bf16_t* vctx = p.VTC + ((size_t)(b * 512 + h * 64 + q) * CTXL + 8 * g);
    bf16x8 kf[2][2], vf[4], kfn[2][2], vfn[4];
    attn_ld(kloc + (size_t)rs0 * 64 * 1024, vloc + rs0 * 64, SEQL, kf, vf);
    for (int i = 0; i < nch; ++i) {
        const int i1 = i + 1;
        if (i1 < nch) { if (i1 < nl) attn_ld(kloc + (size_t)(rs0 + i1) * 64 * 1024, vloc + (rs0 + i1) * 64, SEQL, kfn, vfn);
                        else attn_ld(kctx + (size_t)(i1 - nl) * 32 * 1024, vctx + (i1 - nl) * 32, CTXL, kfn, vfn); }
        const bool isloc = i < nl; const int kr = rs0 + i;
#pragma unroll
        for (int j = 0; j < 4; ++j) {
            if (!isloc || (kr >= rsj[j] && kr < rsj[j] + 8)) {
                f32x4 s0 = {0.f, 0.f, 0.f, 0.f}, s1 = {0.f, 0.f, 0.f, 0.f};
                s0 = __builtin_amdgcn_mfma_f32_16x16x32_bf16(kf[0][0], Qf[j][0], s0, 0, 0, 0); s0 = __builtin_amdgcn_mfma_f32_16x16x32_bf16(kf[0][1], Qf[j][1], s0, 0, 0, 0);
                s1 = __builtin_amdgcn_mfma_f32_16x16x32_bf16(kf[1][0], Qf[j][0], s1, 0, 0, 0); s1 = __builtin_amdgcn_mfma_f32_16x16x32_bf16(kf[1][1], Qf[j][1], s1, 0, 0, 0);
                float sv[8];
                if (isloc) { const float* rb = rpbl + (kr - (r0 + j) + 7) * 32;
#pragma unroll
                    for (int e = 0; e < 4; ++e) { sv[e] = s0[e] * SC + rb[bidx[e]]; sv[4 + e] = s1[e] * SC + rb[bidx[4 + e]]; }
                } else {
#pragma unroll
                    for (int e = 0; e < 4; ++e) { sv[e] = s0[e] * SC; sv[4 + e] = s1[e] * SC; }
                }
                float cmax = fmaxf(fmaxf(fmaxf(sv[0], sv[1]), fmaxf(sv[2], sv[3])), fmaxf(fmaxf(sv[4], sv[5]), fmaxf(sv[6], sv[7])));
                cmax = fmaxf(cmax, shx(cmax, 16, lane)); cmax = fmaxf(cmax, shx(cmax, 32, lane));
                const float mn = fmaxf(m[j], cmax); const bool moved = __builtin_amdgcn_ballot_w64(mn > m[j]) != 0ull;
                float pv[8], psum = 0.f;
#pragma unroll
                for (int e = 0; e < 8; ++e) { pv[e] = __builtin_amdgcn_exp2f(sv[e] - mn); psum += pv[e]; }
                if (moved) { const float alpha = __builtin_amdgcn_exp2f(m[j] - mn); m[j] = mn; ls[j] *= alpha;
#pragma unroll
                    for (int dt = 0; dt < 4; ++dt) O[j][dt] *= alpha; }
                ls[j] += psum;
                union { u32x4 u; bf16x8 v; } pf;
                pf.u.x = cvt_pk_bf16(pv[0], pv[1]); pf.u.y = cvt_pk_bf16(pv[2], pv[3]); pf.u.z = cvt_pk_bf16(pv[4], pv[5]); pf.u.w = cvt_pk_bf16(pv[6], pv[7]);
#pragma unroll
                for (int dt = 0; dt < 4; ++dt) O[j][dt] = __builtin_amdgcn_mfma_f32_16x16x32_bf16(vf[dt], pf.v, O[j][dt], 0, 0, 0);
            }
        }
#pragma unroll
        for (int hh = 0; hh < 2; ++hh)
#pragma unroll
            for (int ds = 0; ds < 2; ++ds) kf[hh][ds] = kfn[hh][ds];
#pragma unroll
        for (int dt = 0; dt < 4; ++dt) vf[dt] = vfn[dt];
    }
#pragma unroll
    for (int j = 0; j < 4; ++j) { float lt = ls[j]; lt += shx(lt, 16, lane); lt += shx(lt, 32, lane); const float inv = 1.0f / lt;
        bf16_t* op = p.HB + (size_t)(b * SEQL + (r0 + j) * 64 + qt * 16 + q) * 1024 + 512 + h * 64 + 4 * g;
#pragma unroll
        for (int dt = 0; dt < 4; ++dt) { u32x2 o; o.x = cvt_pk_bf16(O[j][dt][0] * inv, O[j][dt][1] * inv); o.y = cvt_pk_bf16(O[j][dt][2] * inv, O[j][dt][3] * inv); *(u32x2*)(op + 16 * dt) = o; } }
}
__device__ void attn_block_main(const Params& p, int wid_s, int l, int bt, unsigned char* smem) {
    int tid_ = my_tid(wid_s); const int tid = tid_, w = tid >> 6;
    float* rp = (float*)smem;
    const int wt = bt * 8 + w, qt = wt & 3, rg = (wt >> 2) & 15, h = (wt >> 6) & 7, b = wt >> 9;
    { const int c = (bt == 100 && l == 0) ? 0 : 1; PROBE_MARK(8); }
    if (tid < 480) { const int rr = tid >> 5, cc = tid & 31; rp[tid] = cc < 31 ? p.na_rpb[(size_t)(l * 8 + h) * 465 + rr * 31 + cc] * 1.4426950408889634f : -1e30f; }
    __syncthreads();
    attn_wave4(p, wid_s, l, b, h, qt, rg, rp);
    __syncthreads(); { const int c = (bt == 100 && l == 0) ? 0 : 1; PROBE_MARK(9); }
}
__device__ void attn_block_ctx(const Params& p, int wid_s, int l, int bt, unsigned char* smem) {
    int tid_ = my_tid(wid_s); const int tid = tid_, w = tid >> 6;
    const int wt = bt * 8 + w, qt = wt & 15, h = (wt >> 4) & 7, b = wt >> 7;
    attn_wave<false>(p, wid_s, l, b, 0, h, qt, (const float*)smem);
}

__global__ __launch_bounds__(512, 2) void mega_kernel(Params p) {
    extern __shared__ __attribute__((aligned(16))) unsigned char smem[];
    if (p.BAR == nullptr) cg::this_grid().sync();
    const int wid_s = __builtin_amdgcn_readfirstlane((int)(threadIdx.x >> 6));
#ifndef NO_PREP
    if (threadIdx.x == 0) { *(volatile LAS unsigned*)(smem + LDS_CTL) = 0u; *(volatile LAS unsigned*)(smem + LDS_CTL + 4) = 0u; }
    __syncthreads();
    const XcdBarrier xb = xcd_barrier_post(p.BAR, (volatile LAS unsigned*)(smem + LDS_CTL));
#ifdef PROBE_SEL
#define PHASE_MARK(k) do { if (blockIdx.x == 0 && my_tid(wid_s) == 0) __hip_atomic_store(p.BAR + 96 + (k), (unsigned)__builtin_amdgcn_s_memrealtime(), __ATOMIC_RELAXED, __HIP_MEMORY_SCOPE_AGENT); } while (0)
#else
#define PHASE_MARK(k) do {} while (0)
#endif
    int phase_ctr = 16;
#define GSYNC() do { xcd_barrier(xb, wid_s); PHASE_MARK(phase_ctr); ++phase_ctr; } while (0)
    prep_phase<0>(p, wid_s, smem);
#endif
    xcd_barrier(xb, wid_s);
    PHASE_MARK(15);
#ifdef REP_SYNC
    for (int i = 0; i < 10; ++i) GSYNC();
#endif
    for (int l = 0; l < 2; ++l) {
        const int Mff = (l == 0) ? MALL : MMAIN;
        const float* modl = p.MOD + (size_t)l * 5 * 6144;
        norm_phase(p, wid_s, l, 0, MALL, l == 0);
        if (l == 0) taps_phase(p, wid_s, 0, 0);
#ifdef REP_NORM
        norm_phase(p, wid_s, l, 0, MALL, l == 0);
#endif
        GSYNC();
        { EpiIn E; E.hyu = p.HYU; E.hyuc = p.HYUC; E.fnb = p.FNB; E.fnbc = p.FNBC; E.qk = p.QK; E.vt = p.VT; E.vtc = p.VTC;
          run_gemm(wid_s, smem, p.HB, p.WIN + (size_t)l * NPROJ * 1024, MALL, NPROJ, 1024, E);
#ifdef REP_IN
          __syncthreads(); run_gemm(wid_s, smem, p.HB, p.WIN + (size_t)l * NPROJ * 1024, MALL, NPROJ, 1024, E);
#endif
 }
        GSYNC();
        if (l == 0) { EpiFn E; E.mix = p.HB; E.rowbase = MMAIN; E.Lr = CTXL; run_gemm(wid_s, smem, p.DFTC, p.FNBC, CTXL, 1024, 512, E); }
        {
            unsigned* qctr = p.BAR + 64 * l;
            const int ntot = (l == 0) ? 1088 : 768;
            for (;;) {
                __syncthreads();
                if (my_tid(wid_s) == 0) *(volatile LAS unsigned*)(smem + LDS_CTL + 8) = __hip_atomic_fetch_add(qctr, 1u, __ATOMIC_RELAXED, __HIP_MEMORY_SCOPE_AGENT);
                __syncthreads();
                const int task = __builtin_amdgcn_readfirstlane((int)*(volatile LAS unsigned*)(smem + LDS_CTL + 8));
                if (task >= ntot) break;
                if (task < 256) hyena_mfma(p, wid_s, l, task, smem);
                else if (task < 512) attn_block_main(p, wid_s, l, task - 256, smem);
                else if (task < 768) fnet_task(p, wid_s, task - 512, smem);
                else if (task < 1024) hyena_naive<CTXL>(p, wid_s, l, task - 768, smem);
                else attn_block_ctx(p, wid_s, l, task - 1024, smem);
            }
        }
        GSYNC();
        if (l == 0) { EpiResT<true> E; E.res_main = p.x; E.res_ctx = p.ctx; E.xb = p.XB; E.gate = modl + 2048;
          run_gemm(wid_s, smem, p.HB, p.WOUT + (size_t)l * 1024 * 1024, Mff, 1024, 1024, E); }
        else { EpiResT<false> E; E.res_main = nullptr; E.res_ctx = nullptr; E.xb = p.XB; E.gate = modl + 2048;
          run_gemm(wid_s, smem, p.HB, p.WOUT + (size_t)l * 1024 * 1024, Mff, 1024, 1024, E); }
        if (l == 0) taps_phase(p, wid_s, 1, 16);
        GSYNC();
        norm_phase(p, wid_s, l, 1, Mff, false);
        GSYNC();
        { EpiGU E; E.act = p.ACT; run_gemm(wid_s, smem, p.HB, p.WGU + (size_t)l * 5632 * 1024, Mff, 5632, 1024, E);
#ifdef REP_GU
          __syncthreads(); run_gemm(wid_s, smem, p.HB, p.WGU + (size_t)l * 5632 * 1024, Mff, 5632, 1024, E);
#endif
 }
        GSYNC();
        { EpiResT<false> E; E.res_main = nullptr; E.res_ctx = nullptr; E.xb = p.XB; E.gate = modl + 5120;
          run_gemm(wid_s, smem, p.ACT, p.WDN + (size_t)l * 1024 * DFF, Mff, 1024, DFF, E); }
        if (l == 0) { __syncthreads(); prep_phase<2>(p, wid_s, smem); __syncthreads(); prep_phase<1>(p, wid_s, smem); }
        GSYNC();
    }
    final_norm(p, wid_s);
}

extern "C" void kernel_launch(void* const* d_in, const int* in_sizes, int n_in, void* d_out, int out_size, void* d_ws, size_t ws_size, hipStream_t stream) {
    (void)in_sizes; (void)n_in; (void)out_size;
    static int grid_blocks = 0;
    if (!grid_blocks) {
        int dev = 0, cus = 0, per_cu = 0;
        hipGetDevice(&dev);
        hipDeviceGetAttribute(&cus, hipDeviceAttributeMultiprocessorCount, dev);
        hipFuncSetAttribute((const void*)mega_kernel, hipFuncAttributeMaxDynamicSharedMemorySize, LDS_BYTES);
        hipOccupancyMaxActiveBlocksPerMultiprocessor(&per_cu, mega_kernel, 512, LDS_BYTES);
        if (per_cu < 1) per_cu = 1;
        if (per_cu > 1) per_cu = 1;
        grid_blocks = cus * per_cu;
    }
    Params p{};
    const float* const* in = (const float* const*)d_in;
    p.x = in[0]; p.c = in[1]; p.ctx = in[2]; p.c_ctx = in[3]; p.w_mod = in[4]; p.b_mod = in[5]; p.norm1_g = in[6]; p.norm2_g = in[7]; p.w_in = in[8]; p.w_out = in[9];
    p.hy_conv_w = in[10]; p.hy_conv_b = in[11]; p.filt_w1 = in[12]; p.filt_b1 = in[13]; p.filt_freq = in[14]; p.filt_w2 = in[15]; p.filt_b2 = in[16]; p.filt_w3 = in[17];
    p.hy_skip = in[18]; p.na_rpb = in[19]; p.w_gate = in[20]; p.w_up = in[21]; p.w_down = in[22]; p.final_g = in[23];
    p.out = (float*)d_out;
    unsigned char* ws = (unsigned char*)d_ws; size_t off = 0;
    auto take = [&](size_t bytes) { unsigned char* r = ws + off; off += (bytes + 255) & ~(size_t)255; return r; };
    p.WIN = (bf16_t*)take((size_t)2 * NPROJ * 1024 * 2);
    p.WOUT = (bf16_t*)take((size_t)2 * 1024 * 1024 * 2);
    p.WGU = (bf16_t*)take((size_t)2 * 5632 * 1024 * 2);
    p.WDN = (bf16_t*)take((size_t)2 * 1024 * DFF * 2);
    p.DFT = nullptr;
    p.FM1 = (bf16_t*)take((size_t)128 * 128 * 2);
    p.FM2 = (bf16_t*)take((size_t)64 * 128 * 2);
    p.DFTC = (bf16_t*)take((size_t)256 * 512 * 2);
    p.MOD = (float*)take((size_t)2 * 5 * 6144 * 4);
    p.H2F = (float*)take((size_t)2 * 4096 * 64 * 4);
    p.H2C = (float*)take((size_t)256 * 64 * 4);
    p.XRC = nullptr;
    p.XB = (bf16_t*)take((size_t)MALL * 1024 * 2);
    p.HB = (bf16_t*)take((size_t)MALL * 1024 * 2);
    p.TAPS2 = nullptr;
    p.TAPS = (bf16_t*)take((size_t)2 * 2 * 256 * 8192 * 2);
    p.NRM = (float*)take((size_t)2048 * 4);
    p.BAR = (unsigned*)take((size_t)XCD_BAR_WORDS * 4);
    unsigned char* big = ws + off;
    p.ACT = (bf16_t*)big;
    size_t boff = 0;
    auto takeb = [&](size_t bytes) { unsigned char* r = big + boff; boff += (bytes + 255) & ~(size_t)255; return r; };
    p.HYU = (bf16_t*)takeb((size_t)NB * 768 * SEQL * 2);
    p.HYUC = (bf16_t*)takeb((size_t)NB * 768 * CTXL * 2);
    p.FNB = (bf16_t*)takeb((size_t)1024 * 8192 * 2);
    p.FNBC = (bf16_t*)takeb((size_t)1024 * 512 * 2);
    p.QK = (bf16_t*)takeb((size_t)MALL * 1024 * 2);
    p.VT = (bf16_t*)takeb((size_t)NB * 512 * SEQL * 2);
    p.VTC = (bf16_t*)takeb((size_t)NB * 512 * CTXL * 2);
    const size_t actb = (size_t)MALL * DFF * 2;
    const size_t need = off + (boff > actb ? boff : actb);
    if (need > ws_size) { fprintf(stderr, "workspace too small: need %zu have %zu\n", need, ws_size); return; }
    hipMemsetAsync(p.BAR, 0, (size_t)XCD_BAR_WORDS * 4, stream);
    void* args[] = {&p};
    hipError_t e = hipLaunchCooperativeKernel((const void*)mega_kernel, dim3(grid_blocks), dim3(512), args, LDS_BYTES, stream);
    if (e != hipSuccess) fprintf(stderr, "cooperative launch failed: %s (grid %d)\n", hipGetErrorString(e), grid_blocks);
}
```

```cpp
#include <hip/hip_runtime.h>
#include <hip/hip_cooperative_groups.h>
#include <cstdio>
namespace cg = cooperative_groups;
#include <cstdint>

#define XB_TMO      128
#define XB_XCNT(j)  (256  + 64 * (j))
#define XB_XSUB(j)  (1280 + 64 * (j))
#define XB_XGEN(j)  (2304 + 64 * (j))
#define XB_TOP      3328
#define XB_TOPGEN   3392
#define XCD_BAR_WORDS 3456
#define XB_SPIN_CAP (1u << 18)
#define LAS __attribute__((address_space(3)))

__device__ __forceinline__ unsigned xb_ld(unsigned* p)              { return __hip_atomic_load(p, __ATOMIC_RELAXED, __HIP_MEMORY_SCOPE_AGENT); }
__device__ __forceinline__ unsigned xb_add(unsigned* p, unsigned v) { return __hip_atomic_fetch_add(p, v, __ATOMIC_RELAXED, __HIP_MEMORY_SCOPE_AGENT); }
__device__ __forceinline__ unsigned xb_xcc_id() { return (unsigned)__builtin_amdgcn_s_getreg((3 << 11) | 20) & 0xFu; }
#define XB_SPIN(cond, bar) do { unsigned _sp = 0; while (cond) { __builtin_amdgcn_s_sleep(1); \
    if ((++_sp & 255u) == 0u) { if (xb_ld(&(bar)[XB_TMO])) break; if (_sp > XB_SPIN_CAP) { atomicAdd(&(bar)[XB_TMO], 1u); break; } } } } while (0)

struct XcdBarrier {
    unsigned* bar; unsigned x;
    volatile LAS unsigned* st;
};

__device__ __forceinline__ XcdBarrier xcd_barrier_post(unsigned* bar, volatile LAS unsigned* st) {
    XcdBarrier b; b.bar = bar; b.x = xb_xcc_id(); b.st = st;
    if (threadIdx.x == 0) (void)xb_add(&bar[XB_XCNT(b.x)], 1u);
    return b;
}
__device__ __forceinline__ void xcd_barrier_complete(unsigned* bar, unsigned x, unsigned& nloc, unsigned& nx) {
    const unsigned G = gridDim.x * gridDim.y * gridDim.z;
    unsigned sum, cnt, mine, sp = 0u;
    for (;;) {
        sum = 0u; cnt = 0u; mine = 0u;
#pragma unroll
        for (unsigned j = 0; j < 16; ++j) { const unsigned c = xb_ld(&bar[XB_XCNT(j)]); sum += c; cnt += (c > 0u) ? 1u : 0u; mine = (j == x) ? c : mine; }
        if (sum == G) break;
        __builtin_amdgcn_s_sleep(1);
        if ((++sp & 255u) == 0u) { if (xb_ld(&bar[XB_TMO])) break; if (sp > XB_SPIN_CAP) { atomicAdd(&bar[XB_TMO], 1u); break; } }
    }
    nloc = mine > 0u ? mine : 1u; nx = cnt > 0u ? cnt : 1u;
}
__device__ __forceinline__ void xcd_barrier(const XcdBarrier& b, int wid_s) {
    asm volatile("s_waitcnt vmcnt(0)" ::: "memory");
    __syncthreads();
    int ln; asm volatile("v_mbcnt_lo_u32_b32 %0, -1, 0\n\tv_mbcnt_hi_u32_b32 %0, -1, %0" : "=v"(ln));
    if (wid_s == 0 && ln == 0) {
        unsigned* bar = b.bar; unsigned bx = b.x; asm volatile("" : "+s"(bar), "+s"(bx));
        __builtin_amdgcn_s_waitcnt(0);
        unsigned nloc = b.st[0], nx = b.st[1];
        if (nloc == 0u) { xcd_barrier_complete(bar, bx, nloc, nx); b.st[0] = nloc; b.st[1] = nx; }
        const unsigned old = xb_add(&bar[XB_XSUB(bx)], 1u);
        const unsigned gen = old / nloc;
        if (old + 1u == (gen + 1u) * nloc) {
            __builtin_amdgcn_fence(__ATOMIC_RELEASE, "agent");
            asm volatile("s_waitcnt vmcnt(0)" ::: "memory");
            const unsigned og = xb_add(&bar[XB_TOP], 1u);
            const unsigned tg = og / nx;
            if (og + 1u == (tg + 1u) * nx) xb_add(&bar[XB_TOPGEN], 1u);
            else XB_SPIN(xb_ld(&bar[XB_TOPGEN]) == tg, bar);
            __builtin_amdgcn_fence(__ATOMIC_ACQUIRE, "agent");
            xb_add(&bar[XB_XGEN(bx)], 1u);
            asm volatile("s_waitcnt vmcnt(0)" ::: "memory");
        } else {
            XB_SPIN(xb_ld(&bar[XB_XGEN(bx)]) == gen, bar);
            __builtin_amdgcn_fence(__ATOMIC_ACQUIRE, "agent");
            asm volatile("s_waitcnt vmcnt(0)" ::: "memory");
        }
    }
    __syncthreads();
}
namespace pg8 {
#define PG8_LAS __attribute__((address_space(3)))
typedef unsigned short bf16_t;
typedef short bf16x8 __attribute__((ext_vector_type(8)));
typedef float f32x4 __attribute__((ext_vector_type(4)));
typedef unsigned u32x4 __attribute__((ext_vector_type(4)));
constexpr int BM = 256, BK = 64, HALF = 128, HTB = HALF * BK * 2  , STAGE_BYTES = 8 * HTB, NXCD = 8, WGM = 8;

__host__ __device__ __forceinline__ int lds_byte(int r, int c) { const int st = (r >> 4) * 2 + (c >> 5), rr = r & 15, cc = c & 31, ob = rr * 64 + cc * 2; return st * 1024 + (ob ^ (((ob >> 9) & 1) << 5)); }
__host__ __device__ __forceinline__ void stage_rc(int b, int& R, int& C) { const int st = b / 1024, sb = b % 1024, swz = sb ^ (((sb >> 9) & 1) << 5); R = (st >> 1) * 16 + swz / 64; C = (st & 1) * 32 + (swz % 64) / 2; }
__host__ __device__ __forceinline__ int perm32(int rho) { const int n = rho >> 4, i = rho & 15; return 8 * (i >> 2) + 4 * n + (i & 3); }

struct Unit { int pm, pn, pk; };
struct Gemm { const bf16_t* A; const bf16_t* Bt; int M, N, K, wid_s, ld; };

struct StaticOrder {
    int nM, nN, nwg, G, c;
    __host__ __device__ void init(int M, int N, int G_, int c_) { nM = M / BM; nN = N / BM; nwg = nM * nN; G = G_; c = c_; }
    __host__ __device__ bool next(int i, Unit& u) const {
        const long L = (long)i * G + c; if (L >= nwg) return false;
        int wgid = (int)L; { const int q = nwg / NXCD, r = nwg % NXCD, xcd = wgid % NXCD, off = wgid / NXCD; wgid = (xcd < r ? xcd * (q + 1) : r * (q + 1) + (xcd - r) * q) + off; }
        const int nig = WGM * nN, gid = wgid / nig, fm = gid * WGM, gsz = (nM - fm) < WGM ? (nM - fm) : WGM;
        u.pm = fm + ((wgid % nig) % gsz); u.pn = (wgid % nig) / gsz; u.pk = 0; return true;
    }
    __device__ __forceinline__ void a_ready(const Unit&) const {}
    __device__ __forceinline__ void done(const Unit&) const {}
};
struct SplitOrder {
    int nM, nN, nK, nwg, G, c;
    __host__ __device__ void init(int M, int N, int nK_, int G_, int c_) { nM = M / BM; nN = N / BM; nK = nK_; nwg = nM * nN * nK; G = G_; c = c_; }
    __host__ __device__ bool next(int i, Unit& u) const { const long L = (long)i * G + c; if (L >= nwg) return false; const int w = (int)L; u.pk = w % nK; const int r = w / nK; u.pn = r % nN; u.pm = r / nN; return true; }
    __device__ __forceinline__ void a_ready(const Unit&) const {}
    __device__ __forceinline__ void done(const Unit&) const {}
};
__device__ __forceinline__ unsigned cvt_pk_bf16(float lo, float hi) { unsigned r; asm volatile("v_cvt_pk_bf16_f32 %0, %1, %2" : "=v"(r) : "v"(lo), "v"(hi)); return r; }
typedef float f32x2 __attribute__((ext_vector_type(2)));
template <class Epi, class Sched, bool STAMP = false>
__device__ __forceinline__ void gemm_phase(PG8_LAS unsigned char* lds, const Gemm g, const Sched& S, const Epi& E, unsigned long long* stamps) {
    int ln_; asm volatile("v_mbcnt_lo_u32_b32 %0, -1, 0\n\tv_mbcnt_hi_u32_b32 %0, -1, %0" : "=v"(ln_)); int tid_ = g.wid_s * 64 + ln_; const int tid = tid_, wid = __builtin_amdgcn_readfirstlane(tid >> 6), lane = tid & 63, wr = wid >> 2, wc = wid & 3, fr = lane & 15, fq = lane >> 4;
    int K_ = g.K, LD_ = g.ld; asm volatile("" : "+s"(K_), "+s"(LD_)); const int K = K_, LD = LD_, nt = K / BK;
    int ts_lo = 0, ts_hi = 0, nts = 0; const unsigned long long rt_entry = STAMP ? (unsigned long long)wall_clock64() : 0ull;
#define PG8_STAMP() do { if (STAMP && wid == 0 && nts < 64) { const unsigned long long _c = (unsigned long long)clock64(); \
        ts_lo = (lane == nts) ? (int)(unsigned)_c : ts_lo; ts_hi = (lane == nts) ? (int)(unsigned)(_c >> 32) : ts_hi; ++nts; } } while (0)
    PG8_STAMP();
    unsigned voffA[2], voffB[2];
#pragma unroll
    for (int i = 0; i < 2; ++i) { int R, C; stage_rc(tid * 16 + i * 8192, R, C); const int Rb = Epi::PERM ? ((R & ~31) + perm32(R & 31)) : R;
        voffA[i] = (unsigned)(R * LD + C) * 2u; voffB[i] = (unsigned)(Rb * LD + C) * 2u; }
    const size_t kstep = (size_t)(BK * 2);
    const size_t hstep = (size_t)HALF * LD * 2;
    const size_t tstep = 2 * hstep;
    const unsigned ldsw = (unsigned)wid * 1024u;
    const int aoff = lds_byte(wr * 64 + fr, fq * 8), boff = lds_byte(wc * 32 + fr, fq * 8);
#define PG8_SA(b, h) (((b) * 2 + (h)) * HTB)
#define PG8_SB(b, h) ((4 + (b) * 2 + (h)) * HTB)
#define PG8_STAGE(bufoff, gbase, voff) do { _Pragma("unroll") for (int _i = 0; _i < 2; ++_i) \
        __builtin_amdgcn_global_load_lds((const unsigned*)((const char*)(gbase) + (voff)[_i]), (PG8_LAS unsigned*)(lds + (bufoff) + ldsw + _i * 8192), 16, 0, 0); } while (0)
#define PG8_LDA(dst, b, h) do { _Pragma("unroll") for (int m = 0; m < 4; ++m) _Pragma("unroll") for (int k = 0; k < 2; ++k) dst[m][k] = *(const PG8_LAS bf16x8*)(lds + PG8_SA(b, h) + aoff + m * 2048 + k * 1024); } while (0)
#define PG8_LDB(dst, b, h) do { _Pragma("unroll") for (int n = 0; n < 2; ++n) _Pragma("unroll") for (int k = 0; k < 2; ++k) dst[n][k] = *(const PG8_LAS bf16x8*)(lds + PG8_SB(b, h) + boff + n * 2048 + k * 1024); } while (0)
#define PG8_MMA(ai, bj, At, Bt) do { __builtin_amdgcn_s_setprio(1); _Pragma("unroll") for (int m = 0; m < 4; ++m) _Pragma("unroll") for (int n = 0; n < 2; ++n) _Pragma("unroll") for (int k = 0; k < 2; ++k) \
        acc[ai][bj][m][n] = __builtin_amdgcn_mfma_f32_16x16x32_bf16(Bt[n][k], At[m][k], acc[ai][bj][m][n], 0, 0, 0); __builtin_amdgcn_s_setprio(0); } while (0)
#define PG8_WAIT_V(n) asm volatile("s_waitcnt vmcnt(" #n ")" ::: "memory")
#define PG8_WAIT_L(n) asm volatile("s_waitcnt lgkmcnt(" #n ")" ::: "memory")
#define PG8_BAR __builtin_amdgcn_s_barrier()
#define PG8_SCHED __builtin_amdgcn_sched_barrier(0)
    Unit cur, nxt; int ui = 0;
    if (!S.next(0, cur)) return;
    f32x4 acc[2][2][4][2];
#pragma unroll
    for (int a = 0; a < 2; ++a)
#pragma unroll
        for (int b = 0; b < 2; ++b)
#pragma unroll
            for (int m = 0; m < 4; ++m)
#pragma unroll
                for (int n = 0; n < 2; ++n) acc[a][b][m][n] = (f32x4){0.f, 0.f, 0.f, 0.f};
    bf16x8 At[4][2], B0[2][2], B1[2][2];
    const size_t kchunk = (size_t)K * 2;
    const char* cA = (const char*)g.A + (size_t)cur.pm * tstep + (size_t)cur.pk * kchunk; const char* cB = (const char*)g.Bt + (size_t)cur.pn * tstep + (size_t)cur.pk * kchunk;
    S.a_ready(cur);
    PG8_STAGE(PG8_SB(0, 0), cB, voffB); PG8_STAGE(PG8_SA(0, 0), cA, voffA); PG8_STAGE(PG8_SB(0, 1), cB + hstep, voffB); PG8_STAGE(PG8_SA(0, 1), cA + hstep, voffA);
    if (wr == 1) PG8_BAR;
    PG8_WAIT_V(4); PG8_BAR;
    PG8_STAGE(PG8_SB(1, 0), cB + kstep, voffB); PG8_STAGE(PG8_SA(1, 0), cA + kstep, voffA); PG8_STAGE(PG8_SB(1, 1), cB + hstep + kstep, voffB);
    PG8_WAIT_V(6); PG8_BAR;
    PG8_STAMP();
    for (;;) {
        const bool has_next = S.next(ui + 1, nxt);
        const char* nA = has_next ? (const char*)g.A + (size_t)nxt.pm * tstep + (size_t)nxt.pk * kchunk : cA; const char* nB = has_next ? (const char*)g.Bt + (size_t)nxt.pn * tstep + (size_t)nxt.pk * kchunk : cB;
        for (int t = 0; t < nt; t += 2) {
            const bool last = (t == nt - 2);
            const char* a1 = cA + (size_t)(t + 1) * kstep;
            const char* a2 = last ? nA : cA + (size_t)(t + 2) * kstep; const char* b2 = last ? nB : cB + (size_t)(t + 2) * kstep;
            const char* a3 = a2 + kstep; const char* b3 = b2 + kstep;
            if (last && has_next) S.a_ready(nxt);
            PG8_LDB(B0, 0, 0); PG8_SCHED; PG8_LDA(At, 0, 0); PG8_STAGE(PG8_SA(1, 1), a1 + hstep, voffA);
            PG8_WAIT_L(8); PG8_BAR; PG8_WAIT_L(0); PG8_MMA(0, 0, At, B0); PG8_BAR; PG8_SCHED;
            PG8_LDB(B1, 0, 1); PG8_STAGE(PG8_SB(0, 0), b2, voffB);
            PG8_BAR; PG8_WAIT_L(0); PG8_MMA(0, 1, At, B1); PG8_BAR;
            PG8_LDA(At, 0, 1); PG8_STAGE(PG8_SA(0, 0), a2, voffA);
            PG8_BAR; PG8_WAIT_L(0); PG8_MMA(1, 0, At, B0); PG8_BAR; PG8_SCHED;
            PG8_STAGE(PG8_SB(0, 1), b2 + hstep, voffB);
            PG8_WAIT_V(6); PG8_BAR; PG8_MMA(1, 1, At, B1); PG8_BAR;
            PG8_LDB(B0, 1, 0); PG8_SCHED; PG8_LDA(At, 1, 0); PG8_STAGE(PG8_SA(0, 1), a2 + hstep, voffA);
            PG8_WAIT_L(8); PG8_BAR; PG8_WAIT_L(0); PG8_MMA(0, 0, At, B0); PG8_BAR; PG8_SCHED;
            PG8_LDB(B1, 1, 1); PG8_STAGE(PG8_SB(1, 0), b3, voffB);
            PG8_BAR; PG8_WAIT_L(0); PG8_MMA(0, 1, At, B1); PG8_BAR;
            PG8_LDA(At, 1, 1); PG8_STAGE(PG8_SA(1, 0), a3, voffA);
            PG8_BAR; PG8_WAIT_L(0); PG8_MMA(1, 0, At, B0); PG8_BAR; PG8_SCHED;
            PG8_STAGE(PG8_SB(1, 1), b3 + hstep, voffB);
            PG8_WAIT_V(6); PG8_BAR; PG8_MMA(1, 1, At, B1); PG8_BAR;
        }
        PG8_STAMP();
        if constexpr (!Epi::AFTER_DRAIN) { E(acc, cur, wr, wc, fr, fq); S.done(cur); }
        PG8_STAMP();
        if (!has_next) break;
#pragma unroll
        for (int a = 0; a < 2; ++a)
#pragma unroll
            for (int b = 0; b < 2; ++b)
#pragma unroll
                for (int m = 0; m < 4; ++m)
#pragma unroll
                    for (int n = 0; n < 2; ++n) acc[a][b][m][n] = (f32x4){0.f, 0.f, 0.f, 0.f};
        cur = nxt; cA = nA; cB = nB; ++ui;
    }
    PG8_WAIT_V(0);
    if (wr == 0) PG8_BAR;
    PG8_BAR;
    if constexpr (Epi::AFTER_DRAIN) { E.fused(acc, cur, wr, wc, fr, fq, lds, wid, lane); S.done(cur); }
    PG8_STAMP();
    if (STAMP && wid == 0) { stamps[lane] = lane < nts ? (((unsigned long long)(unsigned)ts_hi << 32) | (unsigned)ts_lo) : 0ull;
        if (lane == 62) stamps[62] = rt_entry; if (lane == 63) stamps[63] = (unsigned long long)wall_clock64(); }
#undef PG8_STAMP
#undef PG8_SA
#undef PG8_SB
#undef PG8_STAGE
#undef PG8_LDA
#undef PG8_LDB
#undef PG8_MMA
#undef PG8_WAIT_V
#undef PG8_WAIT_L
#undef PG8_BAR
#undef PG8_SCHED
}
}

using pg8::bf16_t; using pg8::bf16x8; using pg8::f32x4; using pg8::u32x4; using pg8::Unit; using pg8::cvt_pk_bf16;
typedef unsigned u32x2 __attribute__((ext_vector_type(2)));
#define LAS3 __attribute__((address_space(3)))

constexpr int DM = 1024, SEQL = 4096, NB = 4, CTXL = 256, DFF = 2816, NPROJ = 2816  ;
constexpr int MMAIN = NB * SEQL  , MCTX = NB * CTXL  , MALL = MMAIN + MCTX  ;
constexpr int LDS_CTL = 139264;
constexpr int LDS_BYTES = LDS_CTL + 16;

struct Params {
    const float *x, *c, *ctx, *c_ctx, *w_mod, *b_mod, *norm1_g, *norm2_g, *w_in, *w_out, *hy_conv_w, *hy_conv_b, *filt_w1, *filt_b1, *filt_freq, *filt_w2, *filt_b2, *filt_w3,
        *hy_skip, *na_rpb, *w_gate, *w_up, *w_down, *final_g;
    float* out;
    bf16_t *WIN, *WOUT, *WGU, *WDN;
    bf16_t *DFT, *DFTC;
    float *MOD, *H2F, *H2C, *XRC;
    bf16_t* XB;
    bf16_t *HB;
    bf16_t *HYU, *HYUC, *FNB, *FNBC, *QK, *VT, *VTC, *ACT, *TAPS2;
    unsigned* BAR;
    bf16_t *FM1, *FM2;
    bf16_t* TAPS;
    float* NRM;
};

__device__ __forceinline__ float shx(float v, int o, int lane) { return __int_as_float(__builtin_amdgcn_ds_bpermute((lane ^ o) << 2, __float_as_int(v))); }
__device__ __forceinline__ int my_tid(int wid_s) { int ln; asm volatile("v_mbcnt_lo_u32_b32 %0, -1, 0\n\tv_mbcnt_hi_u32_b32 %0, -1, %0" : "=v"(ln)); return wid_s * 64 + ln; }
__device__ __forceinline__ int perm256(int lc) { return 64 * ((lc >> 5) & 3) + 16 * ((lc >> 2) & 3) + 8 * (lc >> 7) + 4 * ((lc >> 4) & 1) + (lc & 3); }
__device__ __forceinline__ float silu_f(float x) { return x * __builtin_amdgcn_rcpf(1.0f + __builtin_amdgcn_exp2f(-1.4426950408889634f * x)); }
__device__ __forceinline__ bf16_t f2bf(float f) { unsigned u = __float_as_uint(f); u += 0x7FFFu + ((u >> 16) & 1u); return (bf16_t)(u >> 16); }
__device__ __forceinline__ float bf2f(bf16_t b) { return __uint_as_float(((unsigned)b) << 16); }

struct EpiIn {
    static constexpr bool PERM = false, AFTER_DRAIN = false;
    bf16_t *hyu, *hyuc, *fnb, *fnbc, *qk, *vt, *vtc;
    __device__ __forceinline__ void operator()(const f32x4 (&acc)[2][2][4][2], const Unit& u, int wr, int wc, int fr, int fq) const {
        const bool isctx = u.pm >= 64; const int L = isctx ? CTXL : SEQL;
        const int b = isctx ? (u.pm - 64) : (u.pm >> 4), posbase = isctx ? 0 : (u.pm & 15) * 256;
        const int pn = u.pn;
        if (pn >= 5 && pn < 9) {
            const int row0 = u.pm * 256 + wr * 64 + fr, col0 = (pn - 5) * 256 + wc * 32 + 8 * fq;
#pragma unroll
            for (int ai = 0; ai < 2; ++ai)
#pragma unroll
                for (int m = 0; m < 4; ++m) { bf16_t* rowp = qk + (size_t)(row0 + ai * 128 + m * 16) * 1024 + col0;
#pragma unroll
                    for (int bj = 0; bj < 2; ++bj) { const f32x4 v0 = acc[ai][bj][m][0], v1 = acc[ai][bj][m][1];
                        u32x4 w; w.x = cvt_pk_bf16(v0[0], v0[1]); w.y = cvt_pk_bf16(v0[2], v0[3]); w.z = cvt_pk_bf16(v1[0], v1[1]); w.w = cvt_pk_bf16(v1[2], v1[3]); *(u32x4*)(rowp + bj * 128) = w; } }
        } else {
            unsigned stride; int chan0, off;
            unsigned long long bh = (unsigned long long)(isctx ? hyuc : hyu), bf = (unsigned long long)(isctx ? fnbc : fnb), bv = (unsigned long long)(isctx ? vtc : vt);
            asm volatile("" : "+s"(bh), "+s"(bf), "+s"(bv));
            unsigned long long bsel = bv;
            if (pn < 3) { bsel = bh; chan0 = b * 768 + pn * 256; stride = (unsigned)L; off = 0; }
            else if (pn < 5) { bsel = bf; chan0 = b * 256; stride = (unsigned)(2 * L); off = (pn - 3) * L; }
            else { chan0 = b * 512 + (pn - 9) * 256; stride = (unsigned)L; off = 0; }
            asm volatile("" : "+s"(bsel));
            bf16_t* base = (bf16_t*)bsel;
            const unsigned eoff = (unsigned)(chan0 + wc * 32 + 4 * fq) * stride + (unsigned)(posbase + wr * 64 + fr + off);
#pragma unroll
            for (int bj = 0; bj < 2; ++bj)
#pragma unroll
                for (int n = 0; n < 2; ++n)
#pragma unroll
                    for (int e = 0; e < 4; ++e) { unsigned eo = eoff + (unsigned)(bj * 128 + n * 16 + e) * stride; asm volatile("" : "+v"(eo)); bf16_t* cp = base + eo;
#pragma unroll
                        for (int ai = 0; ai < 2; ++ai)
#pragma unroll
                            for (int m = 0; m < 4; m += 2) { const unsigned pk = cvt_pk_bf16(acc[ai][bj][m][n][e], acc[ai][bj][m + 1][n][e]); cp[ai * 128 + m * 16] = (bf16_t)(pk & 0xffffu); cp[ai * 128 + (m + 1) * 16] = (bf16_t)(pk >> 16); } }
        }
    }
};
template <bool RES_F32> struct EpiResT {
    static constexpr bool PERM = false, AFTER_DRAIN = false;
    const float *res_main, *res_ctx; bf16_t* xb; const float* gate;
    __device__ __forceinline__ void operator()(const f32x4 (&acc)[2][2][4][2], const Unit& u, int wr, int wc, int fr, int fq) const {
        const bool isctx = u.pm >= 64; const int bi = isctx ? 4 : (u.pm >> 4);
        const float* res = isctx ? res_ctx + (size_t)(u.pm - 64) * 256 * 1024 : res_main + (size_t)u.pm * 256 * 1024;
        bf16_t* dst = xb + (size_t)u.pm * 256 * 1024;
        const int col0 = u.pn * 256 + wc * 64 + 16 * fq; const float* gp = gate + bi * 6144 + col0;
        f32x4 gv[2][2];
#pragma unroll
        for (int bj = 0; bj < 2; ++bj)
#pragma unroll
            for (int n = 0; n < 2; ++n) gv[bj][n] = *(const f32x4*)(gp + bj * 8 + n * 4);
#pragma unroll
        for (int ai = 0; ai < 2; ++ai)
#pragma unroll
            for (int m = 0; m < 4; ++m) { const size_t ro = (size_t)(ai * 128 + wr * 64 + m * 16 + fr) * 1024 + col0;
#pragma unroll
                for (int bj = 0; bj < 2; ++bj) { f32x4 r0, r1;
                    if (RES_F32) { r0 = __builtin_nontemporal_load((const f32x4*)(res + ro + bj * 8)); r1 = __builtin_nontemporal_load((const f32x4*)(res + ro + bj * 8 + 4)); }
                    else { const u32x4 q = *(const u32x4*)(dst + ro + bj * 8);
                        r0[0] = __uint_as_float(q.x << 16); r0[1] = __uint_as_float(q.x & 0xffff0000u); r0[2] = __uint_as_float(q.y << 16); r0[3] = __uint_as_float(q.y & 0xffff0000u);
                        r1[0] = __uint_as_float(q.z << 16); r1[1] = __uint_as_float(q.z & 0xffff0000u); r1[2] = __uint_as_float(q.w << 16); r1[3] = __uint_as_float(q.w & 0xffff0000u); }
                    const f32x4 x0 = r0 + gv[bj][0] * acc[ai][bj][m][0], x1 = r1 + gv[bj][1] * acc[ai][bj][m][1];
                    u32x4 o; o.x = cvt_pk_bf16(x0[0], x0[1]); o.y = cvt_pk_bf16(x0[2], x0[3]); o.z = cvt_pk_bf16(x1[0], x1[1]); o.w = cvt_pk_bf16(x1[2], x1[3]); *(u32x4*)(dst + ro + bj * 8) = o; } }
    }
};
struct EpiGU {
    static constexpr bool PERM = false, AFTER_DRAIN = false;
    bf16_t* act;
    __device__ __forceinline__ void operator()(const f32x4 (&acc)[2][2][4][2], const Unit& u, int wr, int wc, int fr, int fq) const {
        const int row0 = u.pm * 256 + wr * 64 + fr, col0 = u.pn * 128 + wc * 32 + 8 * fq;
#pragma unroll
        for (int ai = 0; ai < 2; ++ai)
#pragma unroll
            for (int m = 0; m < 4; ++m) { bf16_t* rowp = act + (size_t)(row0 + ai * 128 + m * 16) * DFF + col0;
                float v[8];
#pragma unroll
                for (int n = 0; n < 2; ++n)
#pragma unroll
                    for (int e = 0; e < 4; ++e) v[n * 4 + e] = silu_f(acc[ai][0][m][n][e]) * acc[ai][1][m][n][e];
                u32x4 w; w.x = cvt_pk_bf16(v[0], v[1]); w.y = cvt_pk_bf16(v[2], v[3]); w.z = cvt_pk_bf16(v[4], v[5]); w.w = cvt_pk_bf16(v[6], v[7]);
                *(u32x4*)rowp = w; }
    }
};
struct EpiFn {
    static constexpr bool PERM = false, AFTER_DRAIN = false;
    bf16_t* mix; int rowbase, Lr;
    __device__ __forceinline__ void operator()(const f32x4 (&acc)[2][2][4][2], const Unit& u, int wr, int wc, int fr, int fq) const {
        const int row0 = rowbase + u.pn * Lr + u.pm * 256 + wr * 64 + fr, col0 = 256 + wc * 32 + 4 * fq;
#pragma unroll
        for (int ai = 0; ai < 2; ++ai)
#pragma unroll
            for (int m = 0; m < 4; ++m) { bf16_t* rowp = mix + (size_t)(row0 + ai * 128 + m * 16) * 1024 + col0;
#pragma unroll
                for (int bj = 0; bj < 2; ++bj)
#pragma unroll
                    for (int n = 0; n < 2; ++n) { const f32x4 v = acc[ai][bj][m][n]; u32x2 w; w.x = cvt_pk_bf16(v[0], v[1]); w.y = cvt_pk_bf16(v[2], v[3]); *(u32x2*)(rowp + bj * 128 + n * 16) = w; } }
    }
};

template <class Epi> __device__ __forceinline__ void run_gemm(int wid_s, unsigned char* smem, const bf16_t* A, const bf16_t* Bt, int M, int N, int K, const Epi& E) {
    pg8::Gemm g; g.A = A; g.Bt = Bt; g.M = M; g.N = N; g.K = K; g.wid_s = wid_s; g.ld = K;
    pg8::StaticOrder S; S.init(M, N, (int)gridDim.x, (int)blockIdx.x);
    pg8::gemm_phase<Epi, pg8::StaticOrder, false>((PG8_LAS unsigned char*)smem, g, S, E, nullptr);
}

struct EpiCtxAtomic {
    static constexpr bool PERM = false, AFTER_DRAIN = false;
    float* dst; const float* gate;
    __device__ __forceinline__ void operator()(const f32x4 (&acc)[2][2][4][2], const Unit& u, int wr, int wc, int fr, int fq) const {
        const int col0 = u.pn * 256 + wc * 32 + 4 * fq; float* d0 = dst + (size_t)u.pm * 256 * 1024;
        f32x4 gv[2][2];
#pragma unroll
        for (int bj = 0; bj < 2; ++bj)
#pragma unroll
            for (int n = 0; n < 2; ++n) gv[bj][n] = *(const f32x4*)(gate + col0 + bj * 128 + n * 16);
#pragma unroll
        for (int ai = 0; ai < 2; ++ai)
#pragma unroll
            for (int m = 0; m < 4; ++m) { float* rp = d0 + (size_t)(ai * 128 + wr * 64 + m * 16 + fr) * 1024 + col0;
#pragma unroll
                for (int bj = 0; bj < 2; ++bj)
#pragma unroll
                    for (int n = 0; n < 2; ++n) { const f32x4 v = gv[bj][n] * acc[ai][bj][m][n];
#pragma unroll
                        for (int e = 0; e < 4; ++e) __hip_atomic_fetch_add(rp + bj * 128 + n * 16 + e, v[e], __ATOMIC_RELAXED, __HIP_MEMORY_SCOPE_AGENT); } }
    }
};
template <class Epi> __device__ __forceinline__ void run_gemm_splitk(int wid_s, unsigned char* smem, const bf16_t* A, const bf16_t* Bt, int M, int N, int Kfull, int Kchunk, const Epi& E) {
    pg8::Gemm g; g.A = A; g.Bt = Bt; g.M = M; g.N = N; g.K = Kchunk; g.wid_s = wid_s; g.ld = Kfull;
    pg8::SplitOrder S; S.init(M, N, Kfull / Kchunk, (int)gridDim.x, (int)blockIdx.x);
    pg8::gemm_phase<Epi, pg8::SplitOrder, false>((PG8_LAS unsigned char*)smem, g, S, E, nullptr);
}

#ifdef PROBE_SEL
#define PREP_MARK(k) do { if (MODE == 0 && blockIdx.x == 5 && my_tid(wid_s) == 0) __hip_atomic_store(p.BAR + 96 + (k), (unsigned)__builtin_amdgcn_s_memrealtime(), __ATOMIC_RELAXED, __HIP_MEMORY_SCOPE_AGENT); } while (0)
#else
#define PREP_MARK(k) do {} while (0)
#endif
template <int MODE> __device__ void prep_phase(const Params& p, int wid_s, unsigned char* smem) {
    int tid_ = my_tid(wid_s); const int tid = tid_, lane = tid & 63, w = tid >> 6;
    float* tab = (float*)smem;
    float* tab64 = (float*)(smem + 16384);
    float* sv = (float*)(smem + 20480);
    float* red = (float*)(smem + 40960);
    const int bidx = MODE == 0 ? (int)blockIdx.x : (int)blockIdx.x - 16, nb = MODE == 0 ? (int)gridDim.x : (int)gridDim.x - 16;
    if (bidx < 0) return;
    for (int i = tid; i < 4096; i += 512) tab[i] = cospif((float)i * (1.0f / 2048.0f));
    if (tid < 64) tab64[tid] = cospif((float)tid * (1.0f / 32.0f));
    for (int i = tid; i < 5120; i += 512) { const int v = i >> 10, k = i & 1023; const float xv = v < 4 ? p.c[v * 1024 + k] : p.c_ctx[k]; sv[i] = xv / (1.0f + expf(-xv)); }
    __syncthreads();
    PREP_MARK(40);
    if (MODE != 1) {
        const int nl = lane, kg = w, lw = MODE == 0 ? 0 : 1;
#define WT_DESC(r, sp, ld, dst) do { \
            if ((r) < 704) { const int nt = (r) >> 4, kt = (r) & 15, n = nt * 64 + nl, k0 = kt * 64 + kg * 8; const int np = (n >= 1280 && n < 2304) ? ((n & ~31) + pg8::perm32(n & 31)) : n; const int src = np < 768 ? np : np - 256; \
                ld = 2560; sp = p.w_in + (size_t)lw * 1024 * 2560 + (size_t)k0 * 2560 + src; dst = p.WIN + (size_t)lw * NPROJ * 1024 + (size_t)n * 1024 + k0; } \
            else if ((r) < 960) { const int rr = (r) - 704, nt = rr >> 4, kt = rr & 15, n = nt * 64 + nl, k0 = kt * 64 + kg * 8; \
                ld = 1024; sp = p.w_out + (size_t)lw * 1024 * 1024 + (size_t)k0 * 1024 + ((n & ~255) + perm256(n & 255)); dst = p.WOUT + (size_t)lw * 1024 * 1024 + (size_t)n * 1024 + k0; } \
            else if ((r) < 2368) { const int rr = (r) - 960, nt = rr >> 4, kt = rr & 15, n = nt * 64 + nl, k0 = kt * 64 + kg * 8; \
                const int pn = n >> 8, lc = n & 255, bj = lc >> 7, wc = (lc >> 5) & 3, nn = (lc >> 4) & 1, fq = (lc >> 2) & 3, e4 = lc & 3; \
                const int j = 128 * pn + 32 * wc + 8 * fq + 4 * nn + e4; \
                ld = DFF; sp = (bj ? p.w_up : p.w_gate) + (size_t)lw * 1024 * DFF + (size_t)k0 * DFF + j; dst = p.WGU + (size_t)lw * 5632 * 1024 + (size_t)n * 1024 + k0; } \
            else { const int rr = (r) - 2368, nt = rr / 44, kt = rr % 44, n = nt * 64 + nl, k0 = kt * 64 + kg * 8; \
                ld = 1024; sp = p.w_down + (size_t)lw * DFF * 1024 + (size_t)k0 * 1024 + ((n & ~255) + perm256(n & 255)); dst = p.WDN + (size_t)lw * 1024 * DFF + (size_t)n * DFF + k0; } } while (0)
        for (int r0 = bidx; r0 < 3072; r0 += 4 * nb) {
            const float* sp[4]; int ld[4]; bf16_t* dd[4]; bool ok[4]; float v[4][8];
#pragma unroll
            for (int i = 0; i < 4; ++i) { const int r = r0 + i * nb; ok[i] = r < 3072 && !(r >= 192 && r < 320); sp[i] = p.w_out; ld[i] = 0; dd[i] = nullptr;
                if (r < 3072) WT_DESC(r, sp[i], ld[i], dd[i]); }
#pragma unroll
            for (int i = 0; i < 4; ++i)
#pragma unroll
                for (int e = 0; e < 8; ++e) v[i][e] = ok[i] ? __builtin_nontemporal_load(sp[i] + (size_t)e * ld[i]) : 0.f;
#pragma unroll
            for (int i = 0; i < 4; ++i) if (ok[i]) { u32x4 o; o.x = cvt_pk_bf16(v[i][0], v[i][1]); o.y = cvt_pk_bf16(v[i][2], v[i][3]); o.z = cvt_pk_bf16(v[i][4], v[i][5]); o.w = cvt_pk_bf16(v[i][6], v[i][7]); *(u32x4*)dd[i] = o; }
        }
#undef WT_DESC
        for (int ft = (MODE == 0 ? bidx - 128 : bidx); ft >= 0 && ft < 128; ft += nb) {
            const int r = 192 + ft, nt = r >> 4, kt = r & 15, n = nt * 64 + nl, k0 = kt * 64 + kg * 8; const float* W = p.w_in + (size_t)lw * 1024 * 2560;
            int cp = n - 768; const bool isq = cp >= 256; cp &= 255; const int g = cp >> 6, j = cp & 63;
            float v[8];
#pragma unroll
            for (int e = 0; e < 8; ++e) v[e] = 0.f;
#pragma unroll 8
            for (int m = 0; m < 64; ++m) { int idx = (j * m) & 63; if (isq) idx = (idx - 16) & 63; const float tv = tab64[idx];
#pragma unroll
                for (int e = 0; e < 8; ++e) v[e] += W[(size_t)(k0 + e) * 2560 + 768 + g * 64 + m] * tv; }
            u32x4 o; o.x = cvt_pk_bf16(v[0], v[1]); o.y = cvt_pk_bf16(v[2], v[3]); o.z = cvt_pk_bf16(v[4], v[5]); o.w = cvt_pk_bf16(v[6], v[7]);
            *(u32x4*)(p.WIN + (size_t)lw * NPROJ * 1024 + (size_t)n * 1024 + k0) = o;
        }
    }
    __syncthreads(); PREP_MARK(41);
    if (MODE == 0) for (int i = blockIdx.x * 512 + tid; i < 2048; i += gridDim.x * 512) p.NRM[i] = 0.f;
    if (MODE != 2) for (int task = (MODE == 0 ? 0 : 96) + bidx; task < (MODE == 0 ? 96 : 192); task += nb) {
        const int l = task / 96, n = (task % 96) * 64 + lane;
        float a0 = 0.f, a1 = 0.f, a2 = 0.f, a3 = 0.f, a4 = 0.f;
        const float* W = p.w_mod + (size_t)l * 1024 * 6144 + n;
#pragma unroll 16
        for (int kk = 0; kk < 128; ++kk) { const int k = w * 128 + kk; const float wv = __builtin_nontemporal_load(W + (size_t)k * 6144);
            a0 += sv[k] * wv; a1 += sv[1024 + k] * wv; a2 += sv[2048 + k] * wv; a3 += sv[3072 + k] * wv; a4 += sv[4096 + k] * wv; }
        red[(w * 5 + 0) * 64 + lane] = a0; red[(w * 5 + 1) * 64 + lane] = a1; red[(w * 5 + 2) * 64 + lane] = a2; red[(w * 5 + 3) * 64 + lane] = a3; red[(w * 5 + 4) * 64 + lane] = a4;
        __syncthreads();
        if (w < 5) { float s = p.b_mod[l * 6144 + n]; for (int ww = 0; ww < 8; ++ww) s += red[(ww * 5 + w) * 64 + lane]; p.MOD[(size_t)(l * 5 + w) * 6144 + n] = s; }
        __syncthreads();
    }
    __syncthreads(); PREP_MARK(42);
    if (MODE == 0) {
        const int gw = blockIdx.x * 8 + w, nw = gridDim.x * 8;
        for (int pid = gw; pid < 8448; pid += nw) {
            int l, t, L; float* outp;
            if (pid < 8192) { l = pid >> 12; t = pid & 4095; L = 4096; outp = p.H2F + (size_t)pid * 64; } else { l = 0; t = pid - 8192; L = 256; outp = p.H2C + (size_t)t * 64; }
            const float tt = (float)t / (float)(L - 1), wa = 6.283185307179586f * (float)t / (float)L;
            const float* w1 = p.filt_w1 + l * 33 * 64; const float* w2 = p.filt_w2 + l * 64 * 64;
            float a = p.filt_b1[l * 64 + lane] + tt * w1[lane];
            for (int bnd = 0; bnd < 16; ++bnd) { const float f = 1e-4f + (float)bnd * ((15.0f - 1e-4f) / 15.0f); const float rev2 = f * ((float)(2 * t) / (float)L);
                a += cospif(rev2) * w1[(1 + bnd) * 64 + lane] - sinpif(rev2) * w1[(17 + bnd) * 64 + lane]; }
            const float h1 = sinf(p.filt_freq[l * 128 + lane] * a);
            float a2 = p.filt_b2[l * 64 + lane];
            for (int i = 0; i < 64; ++i) a2 += __int_as_float(__builtin_amdgcn_ds_bpermute(i << 2, __float_as_int(h1))) * w2[i * 64 + lane];
            outp[lane] = sinf(p.filt_freq[l * 128 + 64 + lane] * a2);
        }
    }
    __syncthreads(); PREP_MARK(43);
    if (MODE == 0) {
        const size_t gt = (size_t)blockIdx.x * 512 + tid, gs = (size_t)gridDim.x * 512;
        for (size_t idx = gt; idx < (size_t)128 * 128; idx += gs) {
            const int m = (int)(idx >> 7), k = (int)(idx & 127), ri = m >> 6, k1 = m & 63, pq = k >> 6, n1 = k & 63, ii = (k1 * n1) & 63;
            const float c = tab64[ii], sn = tab64[(ii - 16) & 63];
            p.FM1[idx] = f2bf(ri == 0 ? (pq == 0 ? c : -sn) : (pq == 0 ? -sn : -c));
        }
        for (size_t idx = gt; idx < (size_t)64 * 128; idx += gs) {
            const int k2 = (int)(idx >> 7), k = (int)(idx & 127), ri = k >> 6, n2 = k & 63, ii = (k2 * n2) & 63;
            p.FM2[idx] = f2bf((ri == 0 ? tab64[ii] : tab64[(ii - 16) & 63]) * (1.0f / 512.0f));
        }
        for (size_t idx = gt; idx < (size_t)256 * 64; idx += gs) {
            const int k = (int)(idx >> 6), kk0 = (int)(idx & 63) * 8; float v[8];
#pragma unroll
            for (int e = 0; e < 8; ++e) { const int kk = kk0 + e, n = kk & 255, ii = ((k * n) & 255) * 16; v[e] = (kk < 256 ? tab[ii] : -tab[(ii - 1024) & 4095]) * (1.0f / 128.0f); }
            u32x4 o; o.x = cvt_pk_bf16(v[0], v[1]); o.y = cvt_pk_bf16(v[2], v[3]); o.z = cvt_pk_bf16(v[4], v[5]); o.w = cvt_pk_bf16(v[6], v[7]);
            *(u32x4*)(p.DFTC + idx * 8) = o;
        }
    }
}

__device__ __forceinline__ void split_bf16x8(const f32x4 a, const f32x4 b, bf16x8& hi, bf16x8& lo) {
    union { u32x4 u; bf16x8 v; } ph, pl;
    ph.u.x = cvt_pk_bf16(a[0], a[1]); ph.u.y = cvt_pk_bf16(a[2], a[3]); ph.u.z = cvt_pk_bf16(b[0], b[1]); ph.u.w = cvt_pk_bf16(b[2], b[3]);
    pl.u.x = cvt_pk_bf16(a[0] - __uint_as_float(ph.u.x << 16), a[1] - __uint_as_float(ph.u.x & 0xffff0000u));
    pl.u.y = cvt_pk_bf16(a[2] - __uint_as_float(ph.u.y << 16), a[3] - __uint_as_float(ph.u.y & 0xffff0000u));
    pl.u.z = cvt_pk_bf16(b[0] - __uint_as_float(ph.u.z << 16), b[1] - __uint_as_float(ph.u.z & 0xffff0000u));
    pl.u.w = cvt_pk_bf16(b[2] - __uint_as_float(ph.u.w << 16), b[3] - __uint_as_float(ph.u.w & 0xffff0000u));
    hi = ph.v; lo = pl.v;
}
__device__ void taps_phase(const Params& p, int wid_s, int l, int bstart) {
    if ((int)blockIdx.x < bstart) return;
    int tid_ = my_tid(wid_s); const int tid = tid_, lane = tid & 63, w = tid >> 6, n = lane & 15, g = lane >> 4;
    const float min_decay = -4.605170185988091f / 1.5f, max_decay = -4.605170185988091f / 0.3f;
    for (int wt = ((int)blockIdx.x - bstart) * 8 + w; wt < 2048; wt += ((int)gridDim.x - bstart) * 8) {
        const int ct = wt >> 5, tq = wt & 31;
        const int col = ct * 16 + n, c = col & 255, dir = (col >> 8) & 1, o = col >> 9;
        bf16x8 Bh[2], Bl[2];
#pragma unroll
        for (int ks = 0; ks < 2; ++ks) { f32x4 x0, x1; const float* wp = p.filt_w3 + (size_t)(l * 64 + 32 * ks + 8 * g) * 1024 + col;
#pragma unroll
            for (int e = 0; e < 4; ++e) { x0[e] = wp[(size_t)e * 1024]; x1[e] = wp[(size_t)(4 + e) * 1024]; }
            split_bf16x8(x0, x1, Bh[ks], Bl[ks]); }
        const float delta = fabsf(min_decay + (float)c * ((max_decay - min_decay) / 255.0f)), dl2 = -delta * (1.4426950408889634f / 4095.0f);
        bf16_t* outp = p.TAPS + ((size_t)((l * 2 + o) * 256 + c)) * 8192 + dir * 4096;
        float asum = 0.f;
        for (int tt = 0; tt < 8; ++tt) {
            const int tb = tq * 128 + tt * 16;
            const float* hp = p.H2F + ((size_t)l * 4096 + tb + n) * 64 + 8 * g;
            f32x4 acc = {0.f, 0.f, 0.f, 0.f};
#pragma unroll
            for (int ks = 0; ks < 2; ++ks) { const f32x4 a0 = *(const f32x4*)(hp + 32 * ks), a1 = *(const f32x4*)(hp + 32 * ks + 4); bf16x8 Ah, Al; split_bf16x8(a0, a1, Ah, Al);
                acc = __builtin_amdgcn_mfma_f32_16x16x32_bf16(Ah, Bh[ks], acc, 0, 0, 0); acc = __builtin_amdgcn_mfma_f32_16x16x32_bf16(Al, Bh[ks], acc, 0, 0, 0); acc = __builtin_amdgcn_mfma_f32_16x16x32_bf16(Ah, Bl[ks], acc, 0, 0, 0); }
            float v[4];
#pragma unroll
            for (int e = 0; e < 4; ++e) { const int t = tb + 4 * g + e; v[e] = acc[e] * __builtin_amdgcn_exp2f((float)t * dl2); if (!(dir == 1 && t == 0)) asum += fabsf(v[e]); }
            u32x2 pk; pk.x = cvt_pk_bf16(v[0], v[1]); pk.y = cvt_pk_bf16(v[2], v[3]);
            *(u32x2*)(outp + tb + 4 * g) = pk;
        }
        asum += shx(asum, 16, lane); asum += shx(asum, 32, lane);
        if (g == 0) __hip_atomic_fetch_add(p.NRM + l * 1024 + col, asum, __ATOMIC_RELAXED, __HIP_MEMORY_SCOPE_AGENT);
    }
}

__device__ void norm_phase(const Params& p, int wid_s, int l, int which, int Mrows, bool from_input) {
    int tid_ = my_tid(wid_s); const int tid = tid_, lane = tid & 63, w = tid >> 6;
    const float* gam = (which ? p.norm2_g : p.norm1_g) + l * 1024;
    const int moff = which ? 3072 : 0;
    for (int row0 = (blockIdx.x * 8 + w) * 4; row0 < Mrows; row0 += gridDim.x * 32) {
        f32x4 v[4][4];
#pragma unroll
        for (int rr = 0; rr < 4; ++rr) { const int row = row0 + rr; const bool isctx = row >= MMAIN;
            if (from_input) { const float* src = isctx ? p.ctx + (size_t)(row - MMAIN) * 1024 : p.x + (size_t)row * 1024;
#pragma unroll
                for (int i = 0; i < 4; ++i) v[rr][i] = *(const f32x4*)(src + i * 256 + lane * 4);
            } else { const bf16_t* src = p.XB + (size_t)row * 1024;
#pragma unroll
                for (int i = 0; i < 4; ++i) { const u32x2 q = *(const u32x2*)(src + i * 256 + lane * 4); v[rr][i][0] = __uint_as_float(q.x << 16); v[rr][i][1] = __uint_as_float(q.x & 0xffff0000u); v[rr][i][2] = __uint_as_float(q.y << 16); v[rr][i][3] = __uint_as_float(q.y & 0xffff0000u); } } }
#pragma unroll
        for (int rr = 0; rr < 4; ++rr) { const int row = row0 + rr; const bool isctx = row >= MMAIN; const int bi = isctx ? 4 : (row >> 12);
            float ss = 0.f;
#pragma unroll
            for (int i = 0; i < 4; ++i) ss += v[rr][i][0] * v[rr][i][0] + v[rr][i][1] * v[rr][i][1] + v[rr][i][2] * v[rr][i][2] + v[rr][i][3] * v[rr][i][3];
#pragma unroll
            for (int o = 32; o >= 1; o >>= 1) ss += shx(ss, o, lane);
            const float rstd = rsqrtf(ss * (1.0f / 1024.0f) + 1e-6f);
            const float* mod = p.MOD + (size_t)(l * 5 + bi) * 6144 + moff;
#pragma unroll
            for (int i = 0; i < 4; ++i) { const int col = i * 256 + lane * 4;
                const f32x4 g = *(const f32x4*)(gam + col), sh = *(const f32x4*)(mod + col), sc = *(const f32x4*)(mod + 1024 + col);
                f32x4 y = v[rr][i] * rstd * g * (sc + 1.0f) + sh;
                u32x2 o; o.x = cvt_pk_bf16(y[0], y[1]); o.y = cvt_pk_bf16(y[2], y[3]);
                *(u32x2*)(p.HB + (size_t)row * 1024 + col) = o; } }
    }
}
__device__ void final_norm(const Params& p, int wid_s) {
    int tid_ = my_tid(wid_s); const int tid = tid_, lane = tid & 63, w = tid >> 6;
    for (int row0 = (blockIdx.x * 8 + w) * 4; row0 < MMAIN; row0 += gridDim.x * 32) {
        f32x4 v[4][4];
#pragma unroll
        for (int rr = 0; rr < 4; ++rr)
#pragma unroll
            for (int i = 0; i < 4; ++i) { const u32x2 q = __builtin_nontemporal_load((const u32x2*)(p.XB + (size_t)(row0 + rr) * 1024 + i * 256 + lane * 4)); v[rr][i][0] = __uint_as_float(q.x << 16); v[rr][i][1] = __uint_as_float(q.x & 0xffff0000u); v[rr][i][2] = __uint_as_float(q.y << 16); v[rr][i][3] = __uint_as_float(q.y & 0xffff0000u); }
#pragma unroll
        for (int rr = 0; rr < 4; ++rr) { const int row = row0 + rr; float* src = p.out + (size_t)row * 1024; float ss = 0.f;
#pragma unroll
            for (int i = 0; i < 4; ++i) ss += v[rr][i][0] * v[rr][i][0] + v[rr][i][1] * v[rr][i][1] + v[rr][i][2] * v[rr][i][2] + v[rr][i][3] * v[rr][i][3];
#pragma unroll
            for (int o = 32; o >= 1; o >>= 1) ss += shx(ss, o, lane);
            const float rstd = rsqrtf(ss * (1.0f / 1024.0f) + 1e-6f);
#pragma unroll
            for (int i = 0; i < 4; ++i) { const int col = i * 256 + lane * 4; const f32x4 g = *(const f32x4*)(p.final_g + col); *(f32x4*)(src + col) = v[rr][i] * rstd * g; }
#ifdef PROBE_SEL
            if (row == 0 && lane == 0) { const unsigned ta = __hip_atomic_load(p.BAR + 96 + PROBE_A, __ATOMIC_RELAXED, __HIP_MEMORY_SCOPE_AGENT), tb = __hip_atomic_load(p.BAR + 96 + PROBE_SEL, __ATOMIC_RELAXED, __HIP_MEMORY_SCOPE_AGENT); src[0] += (float)(tb - ta) * 1e-4f * PROBE_SCALE; }
#endif
        }
    }
}

__device__ __forceinline__ float short_conv_at(const bf16_t* base, int t, int L, float w0, float w1, float w2, float bb) {
    const float um = t > 0 ? bf2f(base[t - 1]) : 0.f, u0 = bf2f(base[t]), up = t < L - 1 ? bf2f(base[t + 1]) : 0.f;
    return um * w0 + u0 * w1 + up * w2 + bb;
}
template <int L> __device__ void hyena_naive(const Params& p, int wid_s, int l, int c, unsigned char* smem) {
    constexpr bool ISCTX = (L == CTXL); constexpr int NI = (L + 511) / 512;
    int tid_ = my_tid(wid_s); const int tid = tid_, lane = tid & 63, w = tid >> 6;
    float* Kf = (float*)smem;
    float* Uf = (float*)(smem + 32768);
    float* red = (float*)(smem + 32768 + 65536);
    const bf16_t* hy = ISCTX ? p.HYUC : p.HYU;
    const float* H2 = ISCTX ? p.H2C : p.H2F + (size_t)l * 4096 * 64;
    const float* cw = p.hy_conv_w + l * 3 * 768; const float* cb = p.hy_conv_b + l * 768;
    const float min_decay = -4.605170185988091f / 1.5f, max_decay = -4.605170185988091f / 0.3f;
    const float delta = fabsf(min_decay + (float)c * ((max_decay - min_decay) / 255.0f));
    const int rowbase = ISCTX ? MMAIN : 0;
    for (int o = 0; o < 2; ++o) {
        float part = 0.f;
        const float* w3 = p.filt_w3 + (size_t)l * 64 * 1024 + o * 512 + c;
        for (int t = tid; t < L; t += 512) {
            const f32x4* hr = (const f32x4*)(H2 + (size_t)t * 64); float kf = 0.f, kb = 0.f;
#pragma unroll
            for (int j4 = 0; j4 < 16; ++j4) { const f32x4 hv = hr[j4];
#pragma unroll
                for (int jj = 0; jj < 4; ++jj) { kf += hv[jj] * w3[(4 * j4 + jj) * 1024]; kb += hv[jj] * w3[(4 * j4 + jj) * 1024 + 256]; } }
            const float dec = expf(-((float)t / (float)(L - 1)) * delta); kf *= dec; kb *= dec;
            Kf[L + t] = kf; part += fabsf(kf);
            if (t >= 1) { Kf[L - t] = kb; part += fabsf(kb); } else Kf[0] = 0.f;
        }
#pragma unroll
        for (int s = 32; s >= 1; s >>= 1) part += shx(part, s, lane);
        if (lane == 0) red[w] = part;
        if (o == 0) {
            const int ch = 512 + c; const float w0 = cw[ch], w1 = cw[768 + ch], w2 = cw[1536 + ch], bb = cb[ch];
            for (int idx = tid; idx < 4 * L; idx += 512) { const int b = idx / L, s = idx % L; Uf[s * 4 + b] = short_conv_at(hy + (size_t)(b * 768 + ch) * L, s, L, w0, w1, w2, bb); }
        }
        __syncthreads();
        float nrm = 0.f;
#pragma unroll
        for (int i = 0; i < 8; ++i) nrm += red[i];
        const float inv = 1.0f / nrm;
        float acc[NI][4];
#pragma unroll
        for (int i = 0; i < NI; ++i) { acc[i][0] = 0.f; acc[i][1] = 0.f; acc[i][2] = 0.f; acc[i][3] = 0.f; }
        if (tid < L) {
            const float* kp = Kf + L + tid;
#pragma unroll 8
            for (int s = 0; s < L; ++s) { const f32x4 u4 = *(const f32x4*)(Uf + s * 4);
#pragma unroll
                for (int i = 0; i < NI; ++i) { const float kv = kp[i * 512 - s]; acc[i][0] += kv * u4[0]; acc[i][1] += kv * u4[1]; acc[i][2] += kv * u4[2]; acc[i][3] += kv * u4[3]; } }
        }
        __syncthreads();
        if (tid < L) {
            const float sk = p.hy_skip[(l * 2 + o) * 256 + c];
            const int ch = o == 0 ? c : 256 + c; const float w0 = cw[ch], w1 = cw[768 + ch], w2 = cw[1536 + ch], bb = cb[ch];
#pragma unroll
            for (int i = 0; i < NI; ++i) { const int t = tid + i * 512;
#pragma unroll
                for (int b = 0; b < 4; ++b) { const float y = acc[i][b] * inv + sk * Uf[t * 4 + b];
                    const float xg = short_conv_at(hy + (size_t)(b * 768 + ch) * L, t, L, w0, w1, w2, bb);
                    if (o == 0) Uf[t * 4 + b] = xg * y; else p.HB[(size_t)(rowbase + b * L + t) * 1024 + c] = f2bf(xg * y); } }
        }
        __syncthreads();
    }
}


constexpr int HK_COPY = 8256, HK_OFF = 4128, HU_BLK = 136, HU_SB = 5280, HK_BYTES = 4 * HK_COPY * 2  , HU_BYTES = 4 * HU_SB * 2  ;
__device__ __forceinline__ int hy_swz(int idx) { return idx ^ ((((idx >> 9) & 3) << 2) | (((idx >> 7) & 1) << 4)); }
__device__ __forceinline__ int hu_idx(int b, int t) { return b * HU_SB + ((t >> 7) + 3) * HU_BLK + (t & 127); }

__device__ __forceinline__ void hyena_conv_mfma(const bf16_t* KC, const bf16_t* UU, float* Yf, int lane, int w) {
    const int qh = w & 1, ks = w >> 1, n = lane & 15, g = lane >> 4;
    f32x4 acc[8][4];
#pragma unroll
    for (int a = 0; a < 8; ++a)
#pragma unroll
        for (int qq = 0; qq < 4; ++qq) acc[a][qq] = (f32x4){0.f, 0.f, 0.f, 0.f};
    const int abase = HK_OFF + 32 * ks + 8 * g - 8 * n;
    const int bbase = (n & 3) * HU_SB + ((n >> 2) + 3) * HU_BLK + 32 * ks + 8 * g;
    for (int D = 16 * qh - 31; D <= 16 * qh + 15; ++D) {
        bf16x8 A[8];
#pragma unroll
        for (int a = 0; a < 8; ++a) { const bf16_t* ap = KC + (a & 3) * HK_COPY + abase - 128 * D - (a & 4);
            if (a < 4) A[a] = *(const bf16x8*)ap;
            else { union { u32x2 h[2]; bf16x8 v; } t; t.h[0] = *(const u32x2*)ap; t.h[1] = *(const u32x2*)(ap + 4); A[a] = t.v; } }
        bf16x8 B[4];
#pragma unroll
        for (int qq = 0; qq < 4; ++qq) B[qq] = *(const bf16x8*)(UU + bbase + min(max(4 * (4 * qh + qq) - D, -3), 31) * HU_BLK);
#pragma unroll
        for (int qq = 0; qq < 4; ++qq) { const int q = 4 * qh + qq;
            if (D >= 4 * q - 31 && D <= 4 * q + 3) {
#pragma unroll
                for (int a = 0; a < 8; ++a) acc[a][qq] = __builtin_amdgcn_mfma_f32_16x16x32_bf16(A[a], B[qq], acc[a][qq], 0, 0, 0);
            } }
    }
    __syncthreads();
    const int Il = n >> 2, b = n & 3;
    const int L3 = Il | ((g & 1) << 2), lbase = 8192 * qh + 512 * Il + 128 * g + b;
    int xa[8];
#pragma unroll
    for (int a = 0; a < 8; ++a) xa[a] = lbase + ((a ^ L3) << 2);
    for (int r = 0; r < 4; ++r) {
        if (ks == r) {
#pragma unroll
            for (int a = 0; a < 8; ++a) { float* yp = Yf + xa[a];
#pragma unroll
                for (int qq = 0; qq < 4; ++qq)
#pragma unroll
                    for (int e = 0; e < 4; ++e) { if (r == 0) yp[2048 * qq + 32 * e] = acc[a][qq][e]; else yp[2048 * qq + 32 * e] += acc[a][qq][e]; } }
        }
        __syncthreads();
    }
}

#ifdef PROBE_SEL
#define PROBE_MARK(k) do { if (l == 0 && c == 0 && my_tid(wid_s) == 0) { __hip_atomic_store(p.BAR + 96 + (k), (unsigned)__builtin_amdgcn_s_memrealtime(), __ATOMIC_RELAXED, __HIP_MEMORY_SCOPE_AGENT); } } while (0)
#else
#define PROBE_MARK(k) do {} while (0)
#endif
__device__ __forceinline__ void short_conv8(const bf16_t* base, int t0, int L, float w0, float w1, float w2, float bb, float (&o)[8]) {
    const u32x4 v = *(const u32x4*)(base + t0);
    const float um = t0 > 0 ? bf2f(base[t0 - 1]) : 0.f, up = t0 + 8 < L ? bf2f(base[t0 + 8]) : 0.f;
    float x[10]; x[0] = um; x[9] = up;
#pragma unroll
    for (int e = 0; e < 4; ++e) { x[1 + 2 * e] = __uint_as_float(v[e] << 16); x[2 + 2 * e] = __uint_as_float(v[e] & 0xffff0000u); }
#pragma unroll
    for (int e = 0; e < 8; ++e) o[e] = x[e] * w0 + x[e + 1] * w1 + x[e + 2] * w2 + bb;
}

__device__ void hyena_mfma(const Params& p, int wid_s, int l, int c, unsigned char* smem) {
    int tid_ = my_tid(wid_s); const int tid = tid_, lane = tid & 63, w = tid >> 6;
    bf16_t* KC = (bf16_t*)smem; bf16_t* UU = (bf16_t*)(smem + HK_BYTES); float* Yf = (float*)smem; float* red = (float*)(smem + HK_BYTES + HU_BYTES);
    constexpr int L = SEQL;
    const bf16_t* hy = p.HYU; const float* H2 = p.H2F + (size_t)l * 4096 * 64;
    const float* cw = p.hy_conv_w + l * 3 * 768; const float* cb = p.hy_conv_b + l * 768;
    const float min_decay = -4.605170185988091f / 1.5f, max_decay = -4.605170185988091f / 0.3f;
    const float delta = fabsf(min_decay + (float)c * ((max_decay - min_decay) / 255.0f));
    u32x4 zero4 = (u32x4){0u, 0u, 0u, 0u}; asm volatile("" : "+v"(zero4));
    PROBE_MARK(0);
    for (int i = tid; i < (HK_BYTES + HU_BYTES) / 16; i += 512) ((u32x4*)smem)[i] = zero4;
    __syncthreads();
#define HY_COPIES(ord) do { const bf16_t* tp = p.TAPS + ((size_t)((l * 2 + (ord)) * 256 + c)) * 8192; \
        for (int i = tid; i < 1024; i += 512) { const u32x4 v = *(const u32x4*)(tp + i * 8); const int dir = i >> 9, tq = (i & 511) * 8; \
            _Pragma("unroll") for (int e = 0; e < 8; ++e) { const bf16_t val = (bf16_t)((e & 1) ? (v[e >> 1] >> 16) : (v[e >> 1] & 0xffffu)); const int t = tq + e; \
                if (dir == 0) { _Pragma("unroll") for (int s4 = 0; s4 < 4; ++s4) KC[s4 * HK_COPY + HK_OFF + s4 - t] = val; } \
                else if (t >= 1) { _Pragma("unroll") for (int s4 = 0; s4 < 4; ++s4) KC[s4 * HK_COPY + HK_OFF + s4 + t] = val; } } } } while (0)
    HY_COPIES(0);
    { int t0 = tid * 8; asm volatile("" : "+v"(t0));
      const int ch = 512 + c; const float w0 = cw[ch], w1 = cw[768 + ch], w2 = cw[1536 + ch], bb = cb[ch];
#pragma unroll
      for (int b = 0; b < 4; ++b) { float o[8]; short_conv8(hy + (size_t)(b * 768 + ch) * L, t0, L, w0, w1, w2, bb, o);
          u32x4 pk; pk.x = cvt_pk_bf16(o[0], o[1]); pk.y = cvt_pk_bf16(o[2], o[3]); pk.z = cvt_pk_bf16(o[4], o[5]); pk.w = cvt_pk_bf16(o[6], o[7]);
          *(u32x4*)(UU + hu_idx(b, t0)) = pk; } }
    __syncthreads();
    const float inv1 = 1.0f / (p.NRM[l * 1024 + c] + p.NRM[l * 1024 + 256 + c]), inv2 = 1.0f / (p.NRM[l * 1024 + 512 + c] + p.NRM[l * 1024 + 768 + c]);
    PROBE_MARK(1);
    hyena_conv_mfma(KC, UU, Yf, lane, w);
    PROBE_MARK(2);
    { int t0 = tid * 8; asm volatile("" : "+v"(t0));
      const float sk = p.hy_skip[(l * 2 + 0) * 256 + c]; const int ch = c; const float w0 = cw[ch], w1 = cw[768 + ch], w2 = cw[1536 + ch], bb = cb[ch];
#pragma unroll
      for (int b = 0; b < 4; ++b) { float xg[8]; short_conv8(hy + (size_t)(b * 768 + ch) * L, t0, L, w0, w1, w2, bb, xg);
          float yv[8];
#pragma unroll
          for (int e = 0; e < 8; ++e) yv[e] = Yf[hy_swz((t0 + e) * 4) + b];
          const u32x4 uq = *(const u32x4*)(UU + hu_idx(b, t0)); float uf[8];
#pragma unroll
          for (int e = 0; e < 4; ++e) { uf[2 * e] = __uint_as_float(uq[e] << 16); uf[2 * e + 1] = __uint_as_float(uq[e] & 0xffff0000u); }
          float z[8];
#pragma unroll
          for (int e = 0; e < 8; ++e) z[e] = xg[e] * (yv[e] * inv1 + sk * uf[e]);
          u32x4 pk; pk.x = cvt_pk_bf16(z[0], z[1]); pk.y = cvt_pk_bf16(z[2], z[3]); pk.z = cvt_pk_bf16(z[4], z[5]); pk.w = cvt_pk_bf16(z[6], z[7]);
          *(u32x4*)(UU + hu_idx(b, t0)) = pk; } }
    __syncthreads();
    PROBE_MARK(3);
    for (int i = tid; i < HK_BYTES / 16; i += 512) ((u32x4*)smem)[i] = zero4;
    __syncthreads();
    HY_COPIES(1);
#undef HY_COPIES
    __syncthreads();
    PROBE_MARK(4);
    hyena_conv_mfma(KC, UU, Yf, lane, w);
    PROBE_MARK(5);
    { int t0 = tid * 8; asm volatile("" : "+v"(t0));
      const float sk = p.hy_skip[(l * 2 + 1) * 256 + c]; const int ch = 256 + c; const float w0 = cw[ch], w1 = cw[768 + ch], w2 = cw[1536 + ch], bb = cb[ch];
#pragma unroll
      for (int b = 0; b < 4; ++b) { float xg[8]; short_conv8(hy + (size_t)(b * 768 + ch) * L, t0, L, w0, w1, w2, bb, xg);
          float yv[8];
#pragma unroll
          for (int e = 0; e < 8; ++e) yv[e] = Yf[hy_swz((t0 + e) * 4) + b];
          const u32x4 uq = *(const u32x4*)(UU + hu_idx(b, t0)); float uf[8];
#pragma unroll
          for (int e = 0; e < 4; ++e) { uf[2 * e] = __uint_as_float(uq[e] << 16); uf[2 * e + 1] = __uint_as_float(uq[e] & 0xffff0000u); }
#pragma unroll
          for (int e = 0; e < 8; ++e) p.HB[(size_t)(b * L + t0 + e) * 1024 + c] = f2bf(xg[e] * (yv[e] * inv2 + sk * uf[e])); } }
    __syncthreads();
    PROBE_MARK(6);
}


constexpr int FN_PITCH = 136, FN_BUF = 256 * FN_PITCH * 2  ;
__device__ void fnet_task(const Params& p, int wid_s, int task, unsigned char* smem) {
    int tid_ = my_tid(wid_s); const int tid = tid_, lane = tid & 63, w = tid >> 6, n = lane & 15, g = lane >> 4;
    const int b = task >> 6, cg = task & 63;
    const int l = 0, c = (task == 50) ? 0 : 1; PROBE_MARK(30);
    bf16_t* In = (bf16_t*)smem; bf16_t* Tb = (bf16_t*)(smem + FN_BUF); bf16_t* Yb = (bf16_t*)smem;
    {
        const bf16_t* src = p.FNB + (size_t)(b * 256 + 4 * cg) * 8192;
#pragma unroll
        for (int i = 0; i < 8; ++i) { const int ch = tid + 512 * i;
            const int cl = ch >> 10, pq = (ch >> 9) & 1, n1 = (ch >> 3) & 63, n20 = (ch & 7) * 8;
            const u32x4 v = *(const u32x4*)(src + (size_t)cl * 8192 + pq * 4096 + n1 * 64 + n20);
            bf16_t* dst = In + (cl * 64 + n20) * FN_PITCH + pq * 64 + n1;
#pragma unroll
            for (int e = 0; e < 4; ++e) { dst[(2 * e) * FN_PITCH] = (bf16_t)(v[e] & 0xffffu); dst[(2 * e + 1) * FN_PITCH] = (bf16_t)(v[e] >> 16); } }
    }
    __syncthreads();
    {
        f32x4 acc[8][2];
#pragma unroll
        for (int mt = 0; mt < 8; ++mt) { acc[mt][0] = (f32x4){0.f, 0.f, 0.f, 0.f}; acc[mt][1] = (f32x4){0.f, 0.f, 0.f, 0.f}; }
        bf16x8 Af[2][8];
#pragma unroll
        for (int mt = 0; mt < 8; ++mt) Af[0][mt] = *(const bf16x8*)(p.FM1 + (16 * mt + n) * 128 + 8 * g);
#pragma unroll
        for (int ks = 0; ks < 4; ++ks) {
            bf16x8 Bf[2];
#pragma unroll
            for (int j = 0; j < 2; ++j) Bf[j] = *(const bf16x8*)(In + (16 * (2 * w + j) + n) * FN_PITCH + 32 * ks + 8 * g);
            if (ks < 3) {
#pragma unroll
                for (int mt = 0; mt < 8; ++mt) Af[(ks + 1) & 1][mt] = *(const bf16x8*)(p.FM1 + (16 * mt + n) * 128 + 32 * (ks + 1) + 8 * g); }
#pragma unroll
            for (int mt = 0; mt < 8; ++mt) {
                acc[mt][0] = __builtin_amdgcn_mfma_f32_16x16x32_bf16(Af[ks & 1][mt], Bf[0], acc[mt][0], 0, 0, 0); acc[mt][1] = __builtin_amdgcn_mfma_f32_16x16x32_bf16(Af[ks & 1][mt], Bf[1], acc[mt][1], 0, 0, 0); }
        }
#pragma unroll
        for (int j = 0; j < 2; ++j) { const int nn = 16 * (2 * w + j) + n, cl = nn >> 6, n2 = nn & 63;
#pragma unroll
            for (int kt = 0; kt < 4; ++kt)
#pragma unroll
                for (int e = 0; e < 4; ++e) { const int k1 = 16 * kt + 4 * g + e; const float ph = (float)(k1 * n2) * (1.0f / 4096.0f);
                    const float cph = __builtin_amdgcn_cosf(ph), sph = __builtin_amdgcn_sinf(ph);
                    const float tr = acc[kt][j][e], ti = acc[kt + 4][j][e];
                    bf16_t* dst = Tb + (cl * 64 + k1) * FN_PITCH + n2;
                    dst[0] = f2bf(cph * tr + sph * ti); dst[64] = f2bf(cph * ti - sph * tr); } }
    }
    __syncthreads();
    {
        f32x4 acc[4][2];
#pragma unroll
        for (int mt = 0; mt < 4; ++mt) { acc[mt][0] = (f32x4){0.f, 0.f, 0.f, 0.f}; acc[mt][1] = (f32x4){0.f, 0.f, 0.f, 0.f}; }
        bf16x8 Af[4][4];
#pragma unroll
        for (int ks = 0; ks < 4; ++ks)
#pragma unroll
            for (int mt = 0; mt < 4; ++mt) Af[ks][mt] = *(const bf16x8*)(p.FM2 + (16 * mt + n) * 128 + 32 * ks + 8 * g);
#pragma unroll
        for (int ks = 0; ks < 4; ++ks) {
            bf16x8 Bf[2];
#pragma unroll
            for (int j = 0; j < 2; ++j) Bf[j] = *(const bf16x8*)(Tb + (16 * (2 * w + j) + n) * FN_PITCH + 32 * ks + 8 * g);
#pragma unroll
            for (int mt = 0; mt < 4; ++mt) {
                acc[mt][0] = __builtin_amdgcn_mfma_f32_16x16x32_bf16(Af[ks][mt], Bf[0], acc[mt][0], 0, 0, 0); acc[mt][1] = __builtin_amdgcn_mfma_f32_16x16x32_bf16(Af[ks][mt], Bf[1], acc[mt][1], 0, 0, 0); }
        }
#pragma unroll
        for (int j = 0; j < 2; ++j) { const int nn = 16 * (2 * w + j) + n, cl = nn >> 6, k1 = nn & 63;
#pragma unroll
            for (int mt = 0; mt < 4; ++mt)
#pragma unroll
                for (int e = 0; e < 4; ++e) { const int k2 = 16 * mt + 4 * g + e; Yb[(k1 + 64 * k2) * 4 + cl] = f2bf(acc[mt][j][e]); } }
    }
    __syncthreads();
#pragma unroll
    for (int i = 0; i < 8; ++i) { const int k = tid + 512 * i; *(u32x2*)(p.HB + (size_t)(b * SEQL + k) * 1024 + 256 + 4 * cg) = *(const u32x2*)(Yb + k * 4); }
    __syncthreads();
    PROBE_MARK(31);
}

template <bool LOCAL> __device__ void attn_wave(const Params& p, int wid_s, int l, int b, int r, int h, int qt, const float* rpbl  ) {
    int tid_ = my_tid(wid_s); const int lane = tid_ & 63, q = lane & 15, g = lane >> 4;
    const int qrow = LOCAL ? (b * SEQL + r * 64 + qt * 16 + q) : (MMAIN + b * CTXL + qt * 16 + q);
    constexpr int T0 = LOCAL ? 0 : 16;
    bf16x8 Qf[2];
#pragma unroll
    for (int ds = 0; ds < 2; ++ds) Qf[ds] = *(const bf16x8*)(p.QK + (size_t)qrow * 1024 + h * 64 + ds * 32 + 8 * g);
    const int c = (LOCAL && b == 1 && r == 11 && h == 4 && qt == 0) ? 0 : 1; PROBE_MARK(10);
    f32x4 S[32];
    const int c0 = qt == 0 ? 0 : (qt == 1 ? 8 : (qt == 2 ? 24 : 32));
    const int rs = min(max(r - 4, 0), 56);
    const int ki = 8 * (q >> 2) + (q & 3);
    const bf16_t* kloc = p.QK + (size_t)(b * SEQL + rs * 64 + c0 + ki) * 1024 + 512 + h * 64 + 8 * g;
    const bf16_t* kctx = p.QK + (size_t)(MMAIN + b * CTXL + ki) * 1024 + 512 + h * 64 + 8 * g;
#pragma unroll
    for (int tb = T0; tb < 32; tb += 8) {
        bf16x8 kf[8][2];
#pragma unroll
        for (int j = 0; j < 8; ++j) { const int T = tb + j, hh = T & 1;
            const bf16_t* kp = (T < 16) ? kloc + (size_t)((T >> 1) * 64 + 4 * hh) * 1024 : kctx + (size_t)(32 * ((T - 16) >> 1) + 4 * hh) * 1024;
            kf[j][0] = *(const bf16x8*)kp; kf[j][1] = *(const bf16x8*)(kp + 32); }
        __builtin_amdgcn_sched_barrier(0);
#pragma unroll
        for (int j = 0; j < 8; ++j) { f32x4 a = {0.f, 0.f, 0.f, 0.f};
            a = __builtin_amdgcn_mfma_f32_16x16x32_bf16(kf[j][0], Qf[0], a, 0, 0, 0); a = __builtin_amdgcn_mfma_f32_16x16x32_bf16(kf[j][1], Qf[1], a, 0, 0, 0); S[tb + j] = a; }
        __builtin_amdgcn_sched_barrier(0);
    }
    PROBE_MARK(11);
    float mx = -1e30f;
    if (LOCAL) {
        const int qc = qt * 16 + q, cs = min(max(qc - 8, 0), 48);
#pragma unroll
        for (int T = 0; T < 16; ++T) { const int kr = T >> 1, hh = T & 1; const int brow = (rs + kr - r + 7) * 31;
#pragma unroll
            for (int e = 0; e < 4; ++e) { const int kc = c0 + 8 * g + 4 * hh + e; const bool valid = (kc >= cs) && (kc < cs + 16);
                const int bidx = min(max(kc - qc + 15, 0), 30);
                const float sval = valid ? S[T][e] * 0.125f + rpbl[brow + bidx] : -1e30f; S[T][e] = sval; mx = fmaxf(mx, sval); } }
    }
#pragma unroll
    for (int T = 16; T < 32; ++T)
#pragma unroll
        for (int e = 0; e < 4; ++e) { const float sval = S[T][e] * 0.125f; S[T][e] = sval; mx = fmaxf(mx, sval); }
    mx = fmaxf(mx, shx(mx, 16, lane)); mx = fmaxf(mx, shx(mx, 32, lane));
    float sum = 0.f;
    bf16x8 Pf[16];
#pragma unroll
    for (int ch = T0 / 2; ch < 16; ++ch) {
        float pv[8];
#pragma unroll
        for (int e = 0; e < 4; ++e) { pv[e] = __expf(S[2 * ch][e] - mx); pv[4 + e] = __expf(S[2 * ch + 1][e] - mx); }
#pragma unroll
        for (int e = 0; e < 8; ++e) sum += pv[e];
        union { u32x4 u; bf16x8 v; } pf;
        pf.u.x = cvt_pk_bf16(pv[0], pv[1]); pf.u.y = cvt_pk_bf16(pv[2], pv[3]); pf.u.z = cvt_pk_bf16(pv[4], pv[5]); pf.u.w = cvt_pk_bf16(pv[6], pv[7]);
        Pf[ch] = pf.v;
    }
    sum += shx(sum, 16, lane); sum += shx(sum, 32, lane);
    const float inv = 1.0f / sum;
    PROBE_MARK(12);
    f32x4 O[4];
#pragma unroll
    for (int dt = 0; dt < 4; ++dt) O[dt] = (f32x4){0.f, 0.f, 0.f, 0.f};
    const bf16_t* vloc = p.VT + ((size_t)(b * 512 + h * 64 + q) * SEQL + rs * 64 + c0 + 8 * g);
    const bf16_t* vctx = p.VTC + ((size_t)(b * 512 + h * 64 + q) * CTXL + 8 * g);
#pragma unroll
    for (int cb = T0 / 2; cb < 16; cb += 4) {
        bf16x8 vf[4][4];
#pragma unroll
        for (int j = 0; j < 4; ++j)
#pragma unroll
            for (int dt = 0; dt < 4; ++dt) { const int ch = cb + j;
                const bf16_t* vp = (ch < 8) ? vloc + (size_t)(16 * dt) * SEQL + ch * 64 : vctx + (size_t)(16 * dt) * CTXL + 32 * (ch - 8);
                vf[j][dt] = *(const bf16x8*)vp; }
        __builtin_amdgcn_sched_barrier(0);
#pragma unroll
        for (int j = 0; j < 4; ++j)
#pragma unroll
            for (int dt = 0; dt < 4; ++dt) O[dt] = __builtin_amdgcn_mfma_f32_16x16x32_bf16(vf[j][dt], Pf[cb + j], O[dt], 0, 0, 0);
        __builtin_amdgcn_sched_barrier(0);
    }
#pragma unroll
    for (int dt = 0; dt < 4; ++dt) { u32x2 o; o.x = cvt_pk_bf16(O[dt][0] * inv, O[dt][1] * inv); o.y = cvt_pk_bf16(O[dt][2] * inv, O[dt][3] * inv);
        *(u32x2*)(p.HB + (size_t)qrow * 1024 + 512 + h * 64 + 16 * dt + 4 * g) = o; }
    PROBE_MARK(13);
}

__device__ __forceinline__ void attn_ld(const bf16_t* kp, const bf16_t* vp, size_t vstride, bf16x8 (&kf)[2][2], bf16x8 (&vf)[4]) {
#pragma unroll
    for (int hh = 0; hh < 2; ++hh)
#pragma unroll
        for (int ds = 0; ds < 2; ++ds) kf[hh][ds] = *(const bf16x8*)(kp + (size_t)hh * 4 * 1024 + ds * 32);
#pragma unroll
    for (int dt = 0; dt < 4; ++dt) vf[dt] = *(const bf16x8*)(vp + (size_t)dt * 16 * vstride);
}
__device__ void attn_wave4(const Params& p, int wid_s, int l, int b, int h, int qt, int rg, const float* rpbl) {
    int tid_ = my_tid(wid_s); const int lane = tid_ & 63, q = lane & 15, g = lane >> 4;
    const int r0 = rg * 4, c0 = qt == 0 ? 0 : (qt == 1 ? 8 : (qt == 2 ? 24 : 32)), qc = qt * 16 + q, cs = min(max(qc - 8, 0), 48);
    int rsj[4];
#pragma unroll
    for (int j = 0; j < 4; ++j) rsj[j] = min(max(r0 + j - 4, 0), 56);
    const int rs0 = rsj[0], nl = rsj[3] + 8 - rs0, nch = nl + 8;
    bf16x8 Qf[4][2];
#pragma unroll
    for (int j = 0; j < 4; ++j)
#pragma unroll
        for (int ds = 0; ds < 2; ++ds) Qf[j][ds] = *(const bf16x8*)(p.QK + (size_t)(b * SEQL + (r0 + j) * 64 + qt * 16 + q) * 1024 + h * 64 + ds * 32 + 8 * g);
    int bidx[8];
#pragma unroll
    for (int hh = 0; hh < 2; ++hh)
#pragma unroll
        for (int e = 0; e < 4; ++e) { const int kc = c0 + 8 * g + 4 * hh + e; bidx[hh * 4 + e] = (kc >= cs && kc < cs + 16) ? (kc - qc + 15) : 31; }
    const float SC = 0.125f * 1.4426950408889634f;
    float m[4], ls[4]; f32x4 O[4][4];
#pragma unroll
    for (int j = 0; j < 4; ++j) { m[j] = -1e30f; ls[j] = 0.f;
#pragma unroll
        for (int dt = 0; dt < 4; ++dt) O[j][dt] = (f32x4){0.f, 0.f, 0.f, 0.f}; }
    const int ki = 8 * (q >> 2) + (q & 3);
    const bf16_t* kloc = p.QK + (size_t)(b * SEQL + c0 + ki) * 1024 + 512 + h * 64 + 8 * g;
    const bf16_t* kctx = p.QK + (size_t)(MMAIN + b * CTXL + ki) * 1024 + 512 + h * 64 + 8 * g;
    const bf16_t* vloc = p.VT + ((size_t)(b * 512 + h * 64 + q) * SEQL + c0 + 8 * g);
    const bf16_t* vctx = p.VTC + ((size_t)(b * 512 + h * 64 + q) * CTXL + 8 * g);
    bf16x8 kf[2][2], vf[4], kfn[2][2], vfn[4];
    attn_ld(kloc + (size_t)rs0 * 64 * 1024, vloc + rs0 * 64, SEQL, kf, vf);
    for (int i = 0; i < nch; ++i) {
        const int i1 = i + 1;
        if (i1 < nch) { if (i1 < nl) attn_ld(kloc + (size_t)(rs0 + i1) * 64 * 1024, vloc + (rs0 + i1) * 64, SEQL, kfn, vfn);
                        else attn_ld(kctx + (size_t)(i1 - nl) * 32 * 1024, vctx + (i1 - nl) * 32, CTXL, kfn, vfn); }
        const bool isloc = i < nl; const int kr = rs0 + i;
#pragma unroll
        for (int j = 0; j < 4; ++j) {
            if (!isloc || (kr >= rsj[j] && kr < rsj[j] + 8)) {
                f32x4 s0 = {0.f, 0.f, 0.f, 0.f}, s1 = {0.f, 0.f, 0.f, 0.f};
                s0 = __builtin_amdgcn_mfma_f32_16x16x32_bf16(kf[0][0], Qf[j][0], s0, 0, 0, 0); s0 = __builtin_amdgcn_mfma_f32_16x16x32_bf16(kf[0][1], Qf[j][1], s0, 0, 0, 0);
                s1 = __builtin_amdgcn_mfma_f32_16x16x32_bf16(kf[1][0], Qf[j][0], s1, 0, 0, 0); s1 = __builtin_amdgcn_mfma_f32_16x16x32_bf16(kf[1][1], Qf[j][1], s1, 0, 0, 0);
                float sv[8];
                if (isloc) { const float* rb = rpbl + (kr - (r0 + j) + 7) * 32;
#pragma unroll
                    for (int e = 0; e < 4; ++e) { sv[e] = s0[e] * SC + rb[bidx[e]]; sv[4 + e] = s1[e] * SC + rb[bidx[4 + e]]; }
                } else {
#pragma unroll
                    for (int e = 0; e < 4; ++e) { sv[e] = s0[e] * SC; sv[4 + e] = s1[e] * SC; }
                }
                float cmax = fmaxf(fmaxf(fmaxf(sv[0], sv[1]), fmaxf(sv[2], sv[3])), fmaxf(fmaxf(sv[4], sv[5]), fmaxf(sv[6], sv[7])));
                cmax = fmaxf(cmax, shx(cmax, 16, lane)); cmax = fmaxf(cmax, shx(cmax, 32, lane));
                const float mn = fmaxf(m[j], cmax); const bool moved = __builtin_amdgcn_ballot_w64(mn > m[j]) != 0ull;
                float pv[8], psum = 0.f;
#pragma unroll
                for (int e = 0; e < 8; ++e) { pv[e] = __builtin_amdgcn_exp2f(sv[e] - mn); psum += pv[e]; }
                if (moved) { const float alpha = __builtin_amdgcn_exp2f(m[j] - mn); m[j] = mn; ls[j] *= alpha;
#pragma unroll
                    for (int dt = 0; dt < 4; ++dt) O[j][dt] *= alpha; }
                ls[j] += psum;
                union { u32x4 u; bf16x8 v; } pf;
                pf.u.x = cvt_pk_bf16(pv[0], pv[1]); pf.u.y = cvt_pk_bf16(pv[2], pv[3]); pf.u.z = cvt_pk_bf16(pv[4], pv[5]); pf.u.w = cvt_pk_bf16(pv[6], pv[7]);
#pragma unroll
                for (int dt = 0; dt < 4; ++dt) O[j][dt] = __builtin_amdgcn_mfma_f32_16x16x32_bf16(vf[dt], pf.v, O[j][dt], 0, 0, 0);
            }
        }
#pragma unroll
        for (int hh = 0; hh < 2; ++hh)
#pragma unroll
            for (int ds = 0; ds < 2; ++ds) kf[hh][ds] = kfn[hh][ds];
#pragma unroll
        for (int dt = 0; dt < 4; ++dt) vf[dt] = vfn[dt];
    }
#pragma unroll
    for (int j = 0; j < 4; ++j) { float lt = ls[j]; lt += shx(lt, 16, lane); lt += shx(lt, 32, lane); const float inv = 1.0f / lt;
        bf16_t* op = p.HB + (size_t)(b * SEQL + (r0 + j) * 64 + qt * 16 + q) * 1024 + 512 + h * 64 + 4 * g;
#pragma unroll
        for (int dt = 0; dt < 4; ++dt) { u32x2 o; o.x = cvt_pk_bf16(O[j][dt][0] * inv, O[j][dt][1] * inv); o.y = cvt_pk_bf16(O[j][dt][2] * inv, O[j][dt][3] * inv); *(u32x2*)(op + 16 * dt) = o; } }
}
__device__ void attn_block_main(const Params& p, int wid_s, int l, int bt, unsigned char* smem) {
    int tid_ = my_tid(wid_s); const int tid = tid_, w = tid >> 6;
    float* rp = (float*)smem;
    const int wt = bt * 8 + w, qt = wt & 3, rg = (wt >> 2) & 15, h = (wt >> 6) & 7, b = wt >> 9;
    { const int c = (bt == 100 && l == 0) ? 0 : 1; PROBE_MARK(8); }
    if (tid < 480) { const int rr = tid >> 5, cc = tid & 31; rp[tid] = cc < 31 ? p.na_rpb[(size_t)(l * 8 + h) * 465 + rr * 31 + cc] * 1.4426950408889634f : -1e30f; }
    __syncthreads();
    attn_wave4(p, wid_s, l, b, h, qt, rg, rp);
    __syncthreads(); { const int c = (bt == 100 && l == 0) ? 0 : 1; PROBE_MARK(9); }
}
__device__ void attn_block_ctx(const Params& p, int wid_s, int l, int bt, unsigned char* smem) {
    int tid_ = my_tid(wid_s); const int tid = tid_, w = tid >> 6;
    const int wt = bt * 8 + w, qt = wt & 15, h = (wt >> 4) & 7, b = wt >> 7;
    attn_wave<false>(p, wid_s, l, b, 0, h, qt, (const float*)smem);
}

__global__ __launch_bounds__(512, 2) void mega_kernel(Params p) {
    extern __shared__ __attribute__((aligned(16))) unsigned char smem[];
    if (p.BAR == nullptr) cg::this_grid().sync();
    const int wid_s = __builtin_amdgcn_readfirstlane((int)(threadIdx.x >> 6));
#ifndef NO_PREP
    if (threadIdx.x == 0) { *(volatile LAS unsigned*)(smem + LDS_CTL) = 0u; *(volatile LAS unsigned*)(smem + LDS_CTL + 4) = 0u; }
    __syncthreads();
    const XcdBarrier xb = xcd_barrier_post(p.BAR, (volatile LAS unsigned*)(smem + LDS_CTL));
#ifdef PROBE_SEL
#define PHASE_MARK(k) do { if (blockIdx.x == 0 && my_tid(wid_s) == 0) __hip_atomic_store(p.BAR + 96 + (k), (unsigned)__builtin_amdgcn_s_memrealtime(), __ATOMIC_RELAXED, __HIP_MEMORY_SCOPE_AGENT); } while (0)
#else
#define PHASE_MARK(k) do {} while (0)
#endif
    int phase_ctr = 16;
#define GSYNC() do { xcd_barrier(xb, wid_s); PHASE_MARK(phase_ctr); ++phase_ctr; } while (0)
    prep_phase<0>(p, wid_s, smem);
#endif
    xcd_barrier(xb, wid_s);
    PHASE_MARK(15);
#ifdef REP_SYNC
    for (int i = 0; i < 10; ++i) GSYNC();
#endif
    for (int l = 0; l < 2; ++l) {
        const int Mff = (l == 0) ? MALL : MMAIN;
        const float* modl = p.MOD + (size_t)l * 5 * 6144;
        norm_phase(p, wid_s, l, 0, MALL, l == 0);
        if (l == 0) taps_phase(p, wid_s, 0, 0);
#ifdef REP_NORM
        norm_phase(p, wid_s, l, 0, MALL, l == 0);
#endif
        GSYNC();
        { EpiIn E; E.hyu = p.HYU; E.hyuc = p.HYUC; E.fnb = p.FNB; E.fnbc = p.FNBC; E.qk = p.QK; E.vt = p.VT; E.vtc = p.VTC;
          run_gemm(wid_s, smem, p.HB, p.WIN + (size_t)l * NPROJ * 1024, MALL, NPROJ, 1024, E);
#ifdef REP_IN
          __syncthreads(); run_gemm(wid_s, smem, p.HB, p.WIN + (size_t)l * NPROJ * 1024, MALL, NPROJ, 1024, E);
#endif
 }
        GSYNC();
        if (l == 0) { EpiFn E; E.mix = p.HB; E.rowbase = MMAIN; E.Lr = CTXL; run_gemm(wid_s, smem, p.DFTC, p.FNBC, CTXL, 1024, 512, E); }
        {
            unsigned* qctr = p.BAR + 64 * l;
            const int ntot = (l == 0) ? 1088 : 768;
            for (;;) {
                __syncthreads();
                if (my_tid(wid_s) == 0) *(volatile LAS unsigned*)(smem + LDS_CTL + 8) = __hip_atomic_fetch_add(qctr, 1u, __ATOMIC_RELAXED, __HIP_MEMORY_SCOPE_AGENT);
                __syncthreads();
                const int task = __builtin_amdgcn_readfirstlane((int)*(volatile LAS unsigned*)(smem + LDS_CTL + 8));
                if (task >= ntot) break;
                if (task < 256) hyena_mfma(p, wid_s, l, task, smem);
                else if (task < 512) attn_block_main(p, wid_s, l, task - 256, smem);
                else if (task < 768) fnet_task(p, wid_s, task - 512, smem);
                else if (task < 1024) hyena_naive<CTXL>(p, wid_s, l, task - 768, smem);
                else attn_block_ctx(p, wid_s, l, task - 1024, smem);
            }
        }
        GSYNC();
        if (l == 0) { EpiResT<true> E; E.res_main = p.x; E.res_ctx = p.ctx; E.xb = p.XB; E.gate = modl + 2048;
          run_gemm(wid_s, smem, p.HB, p.WOUT + (size_t)l * 1024 * 1024, Mff, 1024, 1024, E); }
        else { EpiResT<false> E; E.res_main = nullptr; E.res_ctx = nullptr; E.xb = p.XB; E.gate = modl + 2048;
          run_gemm(wid_s, smem, p.HB, p.WOUT + (size_t)l * 1024 * 1024, Mff, 1024, 1024, E); }
        if (l == 0) taps_phase(p, wid_s, 1, 16);
        GSYNC();
        norm_phase(p, wid_s, l, 1, Mff, false);
        GSYNC();
        { EpiGU E; E.act = p.ACT; run_gemm(wid_s, smem, p.HB, p.WGU + (size_t)l * 5632 * 1024, Mff, 5632, 1024, E);
#ifdef REP_GU
          __syncthreads(); run_gemm(wid_s, smem, p.HB, p.WGU + (size_t)l * 5632 * 1024, Mff, 5632, 1024, E);
#endif
 }
        GSYNC();
        { EpiResT<false> E; E.res_main = nullptr; E.res_ctx = nullptr; E.xb = p.XB; E.gate = modl + 5120;
          run_gemm(wid_s, smem, p.ACT, p.WDN + (size_t)l * 1024 * DFF, Mff, 1024, DFF, E); }
        if (l == 0) { __syncthreads(); prep_phase<2>(p, wid_s, smem); __syncthreads(); prep_phase<1>(p, wid_s, smem); }
        GSYNC();
    }
    final_norm(p, wid_s);
}

extern "C" void kernel_launch(void* const* d_in, const int* in_sizes, int n_in, void* d_out, int out_size, void* d_ws, size_t ws_size, hipStream_t stream) {
    (void)in_sizes; (void)n_in; (void)out_size;
    static int grid_blocks = 0;
    if (!grid_blocks) {
        int dev = 0, cus = 0, per_cu = 0;
        hipGetDevice(&dev);
        hipDeviceGetAttribute(&cus, hipDeviceAttributeMultiprocessorCount, dev);
        hipFuncSetAttribute((const void*)mega_kernel, hipFuncAttributeMaxDynamicSharedMemorySize, LDS_BYTES);
        hipOccupancyMaxActiveBlocksPerMultiprocessor(&per_cu, mega_kernel, 512, LDS_BYTES);
        if (per_cu < 1) per_cu = 1;
        if (per_cu > 1) per_cu = 1;
        grid_blocks = cus * per_cu;
    }
    Params p{};
    const float* const* in = (const float* const*)d_in;
    p.x = in[0]; p.c = in[1]; p.ctx = in[2]; p.c_ctx = in[3]; p.w_mod = in[4]; p.b_mod = in[5]; p.norm1_g = in[6]; p.norm2_g = in[7]; p.w_in = in[8]; p.w_out = in[9];
    p.hy_conv_w = in[10]; p.hy_conv_b = in[11]; p.filt_w1 = in[12]; p.filt_b1 = in[13]; p.filt_freq = in[14]; p.filt_w2 = in[15]; p.filt_b2 = in[16]; p.filt_w3 = in[17];
    p.hy_skip = in[18]; p.na_rpb = in[19]; p.w_gate = in[20]; p.w_up = in[21]; p.w_down = in[22]; p.final_g = in[23];
    p.out = (float*)d_out;
    unsigned char* ws = (unsigned char*)d_ws; size_t off = 0;
    auto take = [&](size_t bytes) { unsigned char* r = ws + off; off += (bytes + 255) & ~(size_t)255; return r; };
    p.WIN = (bf16_t*)take((size_t)2 * NPROJ * 1024 * 2);
    p.WOUT = (bf16_t*)take((size_t)2 * 1024 * 1024 * 2);
    p.WGU = (bf16_t*)take((size_t)2 * 5632 * 1024 * 2);
    p.WDN = (bf16_t*)take((size_t)2 * 1024 * DFF * 2);
    p.DFT = nullptr;
    p.FM1 = (bf16_t*)take((size_t)128 * 128 * 2);
    p.FM2 = (bf16_t*)take((size_t)64 * 128 * 2);
    p.DFTC = (bf16_t*)take((size_t)256 * 512 * 2);
    p.MOD = (float*)take((size_t)2 * 5 * 6144 * 4);
    p.H2F = (float*)take((size_t)2 * 4096 * 64 * 4);
    p.H2C = (float*)take((size_t)256 * 64 * 4);
    p.XRC = nullptr;
    p.XB = (bf16_t*)take((size_t)MALL * 1024 * 2);
    p.HB = (bf16_t*)take((size_t)MALL * 1024 * 2);
    p.TAPS2 = nullptr;
    p.TAPS = (bf16_t*)take((size_t)2 * 2 * 256 * 8192 * 2);
    p.NRM = (float*)take((size_t)2048 * 4);
    p.BAR = (unsigned*)take((size_t)XCD_BAR_WORDS * 4);
    unsigned char* big = ws + off;
    p.ACT = (bf16_t*)big;
    size_t boff = 0;
    auto takeb = [&](size_t bytes) { unsigned char* r = big + boff; boff += (bytes + 255) & ~(size_t)255; return r; };
    p.HYU = (bf16_t*)takeb((size_t)NB * 768 * SEQL * 2);
    p.HYUC = (bf16_t*)takeb((size_t)NB * 768 * CTXL * 2);
    p.FNB = (bf16_t*)takeb((size_t)1024 * 8192 * 2);
    p.FNBC = (bf16_t*)takeb((size_t)1024 * 512 * 2);
    p.QK = (bf16_t*)takeb((size_t)MALL * 1024 * 2);
    p.VT = (bf16_t*)takeb((size_t)NB * 512 * SEQL * 2);
    p.VTC = (bf16_t*)takeb((size_t)NB * 512 * CTXL * 2);
    const size_t actb = (size_t)MALL * DFF * 2;
    const size_t need = off + (boff > actb ? boff : actb);
    if (need > ws_size) { fprintf(stderr, "workspace too small: need %zu have %zu\n", need, ws_size); return; }
    hipMemsetAsync(p.BAR, 0, (size_t)XCD_BAR_WORDS * 4, stream);
    void* args[] = {&p};
    hipError_t e = hipLaunchCooperativeKernel((const void*)mega_kernel, dim3(grid_blocks), dim3(512), args, LDS_BYTES, stream);
    if (e != hipSuccess) fprintf(stderr, "cooperative launch failed: %s (grid %d)\n", hipGetErrorString(e), grid_blocks);
}
```
